# Optimizing an MI355X kernel written in HIP

```python
import jax, jax.numpy as jnp
from jax import lax
import numpy as np

D_MODEL = 1024
BATCH = 16
SEQ = 2048
DEPTH = 4

PLE_DIM = 256
N_MIXERS = 2
N_GLA_LAYERS = (DEPTH + 1) // 2
N_POOL_LAYERS = DEPTH // 2
EPS = 1e-6

GLA_HEADS = 4
GLA_KEY_DIM = D_MODEL // 2
GLA_VAL_DIM = D_MODEL
GLA_HEAD_K = GLA_KEY_DIM // GLA_HEADS
GLA_HEAD_V = GLA_VAL_DIM // GLA_HEADS
GLA_GATE_RANK = 16
GLA_GATE_NORMALIZER = 16.0
GLA_CHUNK = 64
GLA_IN_DIM = 2 * GLA_KEY_DIM + 2 * GLA_VAL_DIM + GLA_GATE_RANK

POOL_GROUPS = 4
POOL_WINDOWS = (2, 4, 8, 16)
POOL_GROUP_DIM = D_MODEL // POOL_GROUPS

MOE_GROUPS = 8
MOE_EXPERTS_PER_GROUP = 8
MOE_N_EXPERTS = MOE_GROUPS * MOE_EXPERTS_PER_GROUP
MOE_TOP_K = 2
MOE_D_FF = (3 * D_MODEL) // 8
MOE_BLOCK = 256

kernel_name = "hybrid_gla_pool_hmoe_ple"


def rmsnorm(x, g):
    xf = x.astype(jnp.float32)
    y = xf * lax.rsqrt(jnp.mean(xf * xf, axis=-1, keepdims=True) + EPS) * g.astype(jnp.float32)
    return y.astype(x.dtype)


def gla_chunked(q, k, v, gk):
    B, H, S, dk = q.shape
    dv = v.shape[-1]
    C = GLA_CHUNK
    N = S // C
    q, k, gk = (t.astype(jnp.float32).reshape(B, H, N, C, dk) for t in (q, k, gk))
    v = v.astype(jnp.float32).reshape(B, H, N, C, dv)
    b = jnp.cumsum(gk, axis=3)
    b_last = b[:, :, :, -1:, :]
    q_dec = q * jnp.exp(b)
    k_inv = k * jnp.exp(-b)
    k_end = k * jnp.exp(b_last - b)
    causal = jnp.tril(jnp.ones((C, C), dtype=bool))
    attn = jnp.where(causal, jnp.einsum('bhnik,bhnjk->bhnij', q_dec, k_inv), 0.0)
    o_intra = jnp.einsum('bhnij,bhnjv->bhniv', attn, v)
    kv = jnp.einsum('bhnck,bhncv->bhnkv', k_end, v)
    decay = jnp.exp(b_last[:, :, :, 0, :])

    def step(state, inp):
        q_c, kv_c, d_c = inp
        o_c = jnp.einsum('bhck,bhkv->bhcv', q_c, state)
        return d_c[..., None] * state + kv_c, o_c

    xs = (jnp.moveaxis(q_dec, 2, 0), jnp.moveaxis(kv, 2, 0), jnp.moveaxis(decay, 2, 0))
    _, o_inter = lax.scan(step, jnp.zeros((B, H, dk, dv), jnp.float32), xs)
    o = o_intra + jnp.moveaxis(o_inter, 0, 2)
    return o.reshape(B, H, S, dv)


def gla_mixer(xn, w_in, w_gk, b_gk, norm_g, w_out):
    B, S, _ = xn.shape
    proj = xn @ w_in
    K, V = GLA_KEY_DIM, GLA_VAL_DIM
    q, k, v, r, lr = jnp.split(proj, [K, 2 * K, 2 * K + V, 2 * K + 2 * V], axis=-1)
    gk = jax.nn.log_sigmoid((lr @ w_gk + b_gk).astype(jnp.float32)) / GLA_GATE_NORMALIZER

    def heads(t, dh):
        return t.reshape(B, S, GLA_HEADS, dh).transpose(0, 2, 1, 3)

    o = gla_chunked(heads(q, GLA_HEAD_K) * (GLA_HEAD_K ** -0.5), heads(k, GLA_HEAD_K),
                    heads(v, GLA_HEAD_V), heads(gk, GLA_HEAD_K))
    o = o.transpose(0, 2, 1, 3)
    o = rmsnorm(o, norm_g) * jax.nn.silu(r.reshape(B, S, GLA_HEADS, GLA_HEAD_V).astype(jnp.float32))
    return o.reshape(B, S, V).astype(xn.dtype) @ w_out


def pool_mixer(xn, w, b, scale):
    B, S, D = xn.shape
    xg = xn.astype(jnp.float32).reshape(B, S, POOL_GROUPS, POOL_GROUP_DIM)
    cs = jnp.concatenate([jnp.zeros((B, 1, POOL_GROUPS, POOL_GROUP_DIM), jnp.float32),
                          jnp.cumsum(xg, axis=1)], axis=1)
    win = jnp.array(POOL_WINDOWS, dtype=jnp.int32)
    t = jnp.arange(S, dtype=jnp.int32)[:, None]
    lo = jnp.maximum(t + 1 - win, 0)
    cnt = jnp.minimum(t + 1, win).astype(jnp.float32)
    grp = jnp.arange(POOL_GROUPS, dtype=jnp.int32)[None, :]
    window_sum = cs[:, 1:] - cs[:, lo, grp, :]
    pooled = (window_sum / cnt[None, :, :, None] - xg).astype(xn.dtype)
    y = jnp.einsum('bsgc,gcd->bsgd', pooled, w) + b
    return y.reshape(B, S, D) * scale


def hier_moe(xn, w_coarse, b_coarse, w_fine, b_fine, w_gate, w_up, w_down):
    B, S, D = xn.shape
    T = B * S
    xf = xn.reshape(T, D)
    lc = (xf @ w_coarse).astype(jnp.float32) + b_coarse.astype(jnp.float32)
    pc = jax.nn.softmax(lc, axis=-1)
    _, g_top = lax.top_k(lc, 1)
    p_g = jnp.take_along_axis(pc, g_top, axis=1)
    lf = ((xf @ w_fine).astype(jnp.float32) + b_fine.astype(jnp.float32))
    lf = lf.reshape(T, MOE_GROUPS, MOE_EXPERTS_PER_GROUP)
    lf_sel = jnp.take_along_axis(lf, g_top[:, :, None], axis=1)[:, 0]
    top_v, top_i = lax.top_k(lf_sel, MOE_TOP_K)
    weight = p_g * jax.nn.softmax(top_v, axis=-1)
    expert_id = g_top * MOE_EXPERTS_PER_GROUP + top_i

    A = T * MOE_TOP_K
    e_flat = expert_id.reshape(A).astype(jnp.int32)
    w_flat = weight.reshape(A)
    tok_flat = jnp.repeat(jnp.arange(T, dtype=jnp.int32), MOE_TOP_K)
    order = jnp.argsort(e_flat)
    se, st, sw = e_flat[order], tok_flat[order], w_flat[order]
    counts = jax.ops.segment_sum(jnp.ones((A,), jnp.int32), e_flat, num_segments=MOE_N_EXPERTS)
    starts = jnp.cumsum(counts) - counts
    padded = ((counts + MOE_BLOCK - 1) // MOE_BLOCK) * MOE_BLOCK
    pends = jnp.cumsum(padded)
    pstarts = pends - padded
    dest = pstarts[se] + jnp.arange(A, dtype=jnp.int32) - starts[se]
    n_blocks = -(-A // MOE_BLOCK) + MOE_N_EXPERTS
    P = n_blocks * MOE_BLOCK
    buf_tok = jnp.full((P,), T, jnp.int32).at[dest].set(st)
    buf_w = jnp.zeros((P,), jnp.float32).at[dest].set(sw)
    block_start = jnp.arange(n_blocks, dtype=jnp.int32) * MOE_BLOCK
    block_e = jnp.minimum(jnp.searchsorted(pends, block_start, side='right'),
                          MOE_N_EXPERTS - 1).astype(jnp.int32)
    x_pad = jnp.concatenate([xf, jnp.zeros((1, D), xf.dtype)], axis=0)
    xb = x_pad[buf_tok].reshape(n_blocks, MOE_BLOCK, D)

    def expert_block(args):
        xblk, e = args
        h = jax.nn.silu(xblk @ w_gate[e]) * (xblk @ w_up[e])
        return h @ w_down[e]

    yb = lax.map(expert_block, (xb, block_e)).reshape(P, D)
    yb = yb * buf_w[:, None].astype(yb.dtype)
    out = jnp.zeros((T + 1, D), yb.dtype).at[buf_tok].add(yb)[:T]
    return out.reshape(B, S, D).astype(xn.dtype)


def setup_inputs(seed: int = 0) -> dict:
    key = jax.random.key(seed)
    ks = jax.random.split(key, 24)
    f32 = jnp.float32

    def nrm(k, shape, fan_in):
        return jax.random.normal(k, shape, f32) * (fan_in ** -0.5)

    def gain(k, shape):
        return 1.0 + 0.02 * jax.random.normal(k, shape, f32)

    def bias(k, shape):
        return 0.01 * jax.random.normal(k, shape, f32)

    return {
        "x": jax.random.normal(ks[0], (BATCH, SEQ, D_MODEL), f32),
        "p": jax.random.normal(ks[1], (DEPTH, BATCH, SEQ, PLE_DIM), f32),
        "norm_mix": gain(ks[2], (DEPTH, D_MODEL)),
        "norm_ffn": gain(ks[3], (DEPTH, D_MODEL)),
        "norm_ple": gain(ks[4], (DEPTH, D_MODEL)),
        "norm_final": gain(ks[5], (D_MODEL,)),
        "gla_w_in": nrm(ks[6], (N_GLA_LAYERS, D_MODEL, GLA_IN_DIM), D_MODEL),
        "gla_w_gk": nrm(ks[7], (N_GLA_LAYERS, GLA_GATE_RANK, GLA_KEY_DIM), GLA_GATE_RANK),
        "gla_b_gk": bias(ks[8], (N_GLA_LAYERS, GLA_KEY_DIM)),
        "gla_norm": gain(ks[9], (N_GLA_LAYERS, GLA_HEAD_V)),
        "gla_w_out": nrm(ks[10], (N_GLA_LAYERS, GLA_VAL_DIM, D_MODEL), GLA_VAL_DIM),
        "pool_w": nrm(ks[11], (N_POOL_LAYERS, POOL_GROUPS, POOL_GROUP_DIM, POOL_GROUP_DIM), POOL_GROUP_DIM),
        "pool_b": bias(ks[12], (N_POOL_LAYERS, POOL_GROUPS, POOL_GROUP_DIM)),
        "pool_scale": gain(ks[13], (N_POOL_LAYERS, D_MODEL)),
        "moe_w_coarse": nrm(ks[14], (DEPTH, D_MODEL, MOE_GROUPS), D_MODEL),
        "moe_b_coarse": bias(ks[15], (DEPTH, MOE_GROUPS)),
        "moe_w_fine": nrm(ks[16], (DEPTH, D_MODEL, MOE_N_EXPERTS), D_MODEL),
        "moe_b_fine": bias(ks[17], (DEPTH, MOE_N_EXPERTS)),
        "moe_w_gate": nrm(ks[18], (DEPTH, MOE_N_EXPERTS, D_MODEL, MOE_D_FF), D_MODEL),
        "moe_w_up": nrm(ks[19], (DEPTH, MOE_N_EXPERTS, D_MODEL, MOE_D_FF), D_MODEL),
        "moe_w_down": nrm(ks[20], (DEPTH, MOE_N_EXPERTS, MOE_D_FF, D_MODEL), MOE_D_FF),
        "ple_w_gate": nrm(ks[21], (DEPTH, D_MODEL, D_MODEL), D_MODEL),
        "ple_w_proj": nrm(ks[22], (DEPTH, PLE_DIM, D_MODEL), PLE_DIM),
    }


def reference(x, p, norm_mix, norm_ffn, norm_ple, norm_final, gla_w_in, gla_w_gk, gla_b_gk, gla_norm,
              gla_w_out, pool_w, pool_b, pool_scale, moe_w_coarse, moe_b_coarse, moe_w_fine, moe_b_fine,
              moe_w_gate, moe_w_up, moe_w_down, ple_w_gate, ple_w_proj):
    h = x
    for i in range(DEPTH):
        j = i // N_MIXERS
        xn = rmsnorm(h, norm_mix[i])
        if i % N_MIXERS == 0:
            h = h + gla_mixer(xn, gla_w_in[j], gla_w_gk[j], gla_b_gk[j], gla_norm[j], gla_w_out[j])
        else:
            h = h + pool_mixer(xn, pool_w[j], pool_b[j], pool_scale[j])
        h = h + hier_moe(rmsnorm(h, norm_ffn[i]), moe_w_coarse[i], moe_b_coarse[i], moe_w_fine[i],
                         moe_b_fine[i], moe_w_gate[i], moe_w_up[i], moe_w_down[i])
        gate = jax.nn.sigmoid(rmsnorm(h, norm_ple[i]) @ ple_w_gate[i])
        h = h + gate * (p[i] @ ple_w_proj[i])
    return rmsnorm(h, norm_final)
```

```cpp
#include <hip/hip_runtime.h>
#include <stdint.h>
#include <stdio.h>
namespace nv {
constexpr int T = 32768, D = 1024, SEQ = 2048, NB = 16, PLE = 256, DFF = 384, NE = 64, GIN = 3088;
constexpr int CAP = 65536;
constexpr float EPS = 1e-6f;

__device__ __forceinline__ float wsum(float v) {
#pragma unroll
    for (int o = 32; o; o >>= 1) v += __shfl_xor(v, o);
    return v;
}
__device__ __forceinline__ float sigmoidf_(float x) { return 1.f / (1.f + __expf(-x)); }
__device__ __forceinline__ float siluf_(float x) { return x * sigmoidf_(x); }

__global__ void __launch_bounds__(256) k_rmsnorm(const float* __restrict__ in, const float* __restrict__ g, float* __restrict__ out, int rows, int d) {
    const int row = blockIdx.x * 4 + (threadIdx.x >> 6), lane = threadIdx.x & 63;
    if (row >= rows) return;
    const float* x = in + (size_t)row * d;
    float s = 0.f;
    for (int c = lane; c < d; c += 64) { const float v = x[c]; s += v * v; }
    s = wsum(s);
    const float rs = 1.0f / sqrtf(s / (float)d + EPS);
    for (int c = lane; c < d; c += 64) out[(size_t)row * d + c] = x[c] * rs * g[c];
}

struct MoeArgs { const int* cnt; const int* list; };
template <int MODE>
__global__ void __launch_bounds__(256) k_sgemm(const float* __restrict__ A, int lda, const float* __restrict__ W, int ldw, float* __restrict__ C, int ldc,
                                               int M, int N, int K, int accumulate, MoeArgs ma, size_t wstride) {
    __shared__ float As[16][68];
    __shared__ float Bs[16][68];
    __shared__ int s_e, s_i0, s_base, s_valid;
    const int tid = threadIdx.x, tx = tid & 15, ty = tid >> 4;
    const int n0 = blockIdx.x * 64;
    int m0 = blockIdx.y * 64, valid = 64, e = 0, i0 = 0, base = 0;
    if (MODE != 0) {
        if (tid == 0) {
            int tile = blockIdx.y, acc_t = 0, acc_b = 0, fe = -1, fi = 0, fb = 0, fv = 0;
            for (int x = 0; x < NE; ++x) {
                const int c = ma.cnt[x], nt = (c + 63) / 64;
                if (fe < 0 && tile < acc_t + nt) { fe = x; fi = (tile - acc_t) * 64; fb = acc_b; fv = c - fi < 64 ? c - fi : 64; }
                acc_t += nt; acc_b += c;
            }
            s_e = fe; s_i0 = fi; s_base = fb; s_valid = fv;
        }
        __syncthreads();
        e = s_e; i0 = s_i0; base = s_base; valid = s_valid;
        if (e < 0) return;
        W += (size_t)e * wstride;
    }
    float acc[4][4];
#pragma unroll
    for (int i = 0; i < 4; ++i)
#pragma unroll
        for (int j = 0; j < 4; ++j) acc[i][j] = 0.f;
    const int ar = tid >> 2, ak = (tid & 3) * 4;
    const float* arow = nullptr;
    if (ar < valid) {
        if (MODE == 0) arow = A + (size_t)(m0 + ar) * lda;
        else if (MODE == 1) arow = A + (size_t)(ma.list[(size_t)e * CAP + i0 + ar] >> 1) * lda;
        else arow = A + (size_t)(base + i0 + ar) * lda;
    }
    const int bk = tid >> 4, bn = (tid & 15) * 4;
    for (int k0 = 0; k0 < K; k0 += 16) {
        float4 av = make_float4(0.f, 0.f, 0.f, 0.f);
        if (arow) av = *(const float4*)(arow + k0 + ak);
        As[ak + 0][ar] = av.x; As[ak + 1][ar] = av.y; As[ak + 2][ar] = av.z; As[ak + 3][ar] = av.w;
        float bv[4];
#pragma unroll
        for (int j = 0; j < 4; ++j) { const int n = n0 + bn + j; bv[j] = (n < N) ? W[(size_t)(k0 + bk) * ldw + n] : 0.f; }
#pragma unroll
        for (int j = 0; j < 4; ++j) Bs[bk][bn + j] = bv[j];
        __syncthreads();
#pragma unroll
        for (int kk = 0; kk < 16; ++kk) {
            float a[4], b[4];
#pragma unroll
            for (int i = 0; i < 4; ++i) a[i] = As[kk][ty * 4 + i];
#pragma unroll
            for (int j = 0; j < 4; ++j) b[j] = Bs[kk][tx * 4 + j];
#pragma unroll
            for (int i = 0; i < 4; ++i)
#pragma unroll
                for (int j = 0; j < 4; ++j) acc[i][j] += a[i] * b[j];
        }
        __syncthreads();
    }
#pragma unroll
    for (int i = 0; i < 4; ++i) {
        const int r = ty * 4 + i;
        if (r >= valid) continue;
        size_t orow;
        if (MODE == 0) orow = (size_t)(m0 + r);
        else if (MODE == 1) orow = (size_t)(base + i0 + r);
        else orow = (size_t)ma.list[(size_t)e * CAP + i0 + r];
#pragma unroll
        for (int j = 0; j < 4; ++j) {
            const int n = n0 + tx * 4 + j;
            if (n < N) { float* p = C + orow * ldc + n; *p = accumulate ? (*p + acc[i][j]) : acc[i][j]; }
        }
    }
}

__global__ void __launch_bounds__(256) k_gla(const float* __restrict__ proj, const float* __restrict__ wgk, const float* __restrict__ bgk, float* __restrict__ o) {
    const int b = blockIdx.x >> 2, h = blockIdx.x & 3, c = threadIdx.x;
    __shared__ float sq[2][128], sk[2][128], se[2][128];
    float S[128];
#pragma unroll
    for (int k = 0; k < 128; ++k) S[k] = 0.f;
    for (int t = 0; t < SEQ; ++t) {
        const float* row = proj + (size_t)(b * SEQ + t) * GIN;
        const int pb = t & 1;
        if (c < 128) {
            float z = bgk[h * 128 + c];
#pragma unroll
            for (int r = 0; r < 16; ++r) z += row[3072 + r] * wgk[r * 512 + h * 128 + c];
            const float gk = (fminf(z, 0.f) - log1pf(expf(-fabsf(z)))) * (1.0f / 16.0f);
            se[pb][c] = expf(gk); sq[pb][c] = row[h * 128 + c] * 0.08838834764831845f; sk[pb][c] = row[512 + h * 128 + c];
        }
        const float v = row[1024 + h * 256 + c];
        __syncthreads();
        float acc = 0.f;
#pragma unroll
        for (int k = 0; k < 128; ++k) { S[k] = se[pb][k] * S[k] + sk[pb][k] * v; acc += sq[pb][k] * S[k]; }
        o[(size_t)(b * SEQ + t) * D + h * 256 + c] = acc;
    }
}
__global__ void __launch_bounds__(256) k_gla_post(const float* __restrict__ o, const float* __restrict__ proj, const float* __restrict__ g, float* __restrict__ og) {
    const int idx = blockIdx.x * 4 + (threadIdx.x >> 6), lane = threadIdx.x & 63;
    const int t = idx >> 2, h = idx & 3;
    const float* x = o + (size_t)t * D + h * 256;
    float v[4], s = 0.f;
#pragma unroll
    for (int j = 0; j < 4; ++j) { v[j] = x[lane + 64 * j]; s += v[j] * v[j]; }
    s = wsum(s);
    const float rs = 1.0f / sqrtf(s / 256.f + EPS);
#pragma unroll
    for (int j = 0; j < 4; ++j) { const int c = lane + 64 * j; const float r = proj[(size_t)t * GIN + 2048 + h * 256 + c]; og[(size_t)t * D + h * 256 + c] = v[j] * rs * g[c] * siluf_(r); }
}
__global__ void __launch_bounds__(256) k_pool(const float* __restrict__ xn, float* __restrict__ pooled) {
    const size_t i = (size_t)blockIdx.x * 256 + threadIdx.x;
    const int t = (int)(i / D), ch = (int)(i % D), g = ch >> 8, w = 2 << g, ts = t % SEQ;
    const int lo = ts + 1 - w > 0 ? ts + 1 - w : 0;
    float s = 0.f;
    for (int u = lo; u <= ts; ++u) s += xn[(size_t)(t - ts + u) * D + ch];
    pooled[i] = s / (float)(ts + 1 - lo) - xn[i];
}
__global__ void __launch_bounds__(256) k_pool_post(float* __restrict__ h, const float* __restrict__ y, const float* __restrict__ b, const float* __restrict__ sc) {
    const size_t i = (size_t)blockIdx.x * 256 + threadIdx.x; const int ch = (int)(i % D);
    h[i] += (y[i] + b[ch]) * sc[ch];
}
__global__ void __launch_bounds__(256) k_route(const float* __restrict__ xn, const float* __restrict__ wc, const float* __restrict__ bc, const float* __restrict__ wf, const float* __restrict__ bf,
                                               int* __restrict__ cnt, int* __restrict__ list, float* __restrict__ wts) {
    __shared__ float sl[4][80];
    const int w = threadIdx.x >> 6, lane = threadIdx.x & 63, t = blockIdx.x * 4 + w;
    const float* x = xn + (size_t)t * D;
    float lf = bf[lane], lc = (lane < 8) ? bc[lane] : 0.f;
    for (int k = 0; k < D; ++k) { const float xv = x[k]; lf += xv * wf[(size_t)k * 64 + lane]; if (lane < 8) lc += xv * wc[(size_t)k * 8 + lane]; }
    sl[w][8 + lane] = lf; if (lane < 8) sl[w][lane] = lc;
    __syncthreads();
    if (lane == 0) {
        int g = 0; float m = sl[w][0];
        for (int j = 1; j < 8; ++j) if (sl[w][j] > m) { m = sl[w][j]; g = j; }
        float den = 0.f; for (int j = 0; j < 8; ++j) den += expf(sl[w][j] - m);
        const float pg = 1.f / den;
        const float* f = &sl[w][8 + g * 8];
        int i0 = 0; float v0 = f[0];
        for (int j = 1; j < 8; ++j) if (f[j] > v0) { v0 = f[j]; i0 = j; }
        int i1 = -1; float v1 = 0.f;
        for (int j = 0; j < 8; ++j) if (j != i0 && (i1 < 0 || f[j] > v1)) { v1 = f[j]; i1 = j; }
        const float e1 = expf(v1 - v0), w0 = pg / (1.f + e1), w1 = pg * e1 / (1.f + e1);
        const int ea = g * 8 + i0, eb = g * 8 + i1;
        int pa = atomicAdd(&cnt[ea], 1); list[(size_t)ea * CAP + pa] = t * 2; wts[t * 2] = w0;
        int pb = atomicAdd(&cnt[eb], 1); list[(size_t)eb * CAP + pb] = t * 2 + 1; wts[t * 2 + 1] = w1;
    }
}
__global__ void __launch_bounds__(256) k_silu_mul(const float* __restrict__ g, const float* __restrict__ u, float* __restrict__ h, size_t n) {
    const size_t i = (size_t)blockIdx.x * 256 + threadIdx.x; if (i < n) h[i] = siluf_(g[i]) * u[i];
}
__global__ void __launch_bounds__(256) k_moe_combine(float* __restrict__ h, const float* __restrict__ y, const float* __restrict__ wts) {
    const size_t i = (size_t)blockIdx.x * 256 + threadIdx.x; const size_t t = i / D, c = i % D;
    h[i] += wts[2 * t] * y[(2 * t) * D + c] + wts[2 * t + 1] * y[(2 * t + 1) * D + c];
}
__global__ void __launch_bounds__(256) k_ple_post(float* __restrict__ h, const float* __restrict__ g, const float* __restrict__ p) {
    const size_t i = (size_t)blockIdx.x * 256 + threadIdx.x; h[i] += sigmoidf_(g[i]) * p[i];
}

static void sgemm0(hipStream_t st, const float* A, int lda, const float* W, int ldw, float* C, int ldc, int M, int N, int K, int acc) {
    MoeArgs ma{nullptr, nullptr};
    hipLaunchKernelGGL(k_sgemm<0>, dim3((N + 63) / 64, M / 64), dim3(256), 0, st, A, lda, W, ldw, C, ldc, M, N, K, acc, ma, (size_t)0);
}

static void forward(void* const* d_in, float* d_out, unsigned char* ws, hipStream_t st) {
    const float* x = (const float*)d_in[0]; const float* p = (const float*)d_in[1];
    const float* norm_mix = (const float*)d_in[2]; const float* norm_ffn = (const float*)d_in[3]; const float* norm_ple = (const float*)d_in[4]; const float* norm_final = (const float*)d_in[5];
    const float* gla_w_in = (const float*)d_in[6]; const float* gla_w_gk = (const float*)d_in[7]; const float* gla_b_gk = (const float*)d_in[8]; const float* gla_norm = (const float*)d_in[9];
    const float* gla_w_out = (const float*)d_in[10]; const float* pool_w = (const float*)d_in[11]; const float* pool_b = (const float*)d_in[12]; const float* pool_scale = (const float*)d_in[13];
    const float* moe_wc = (const float*)d_in[14]; const float* moe_bc = (const float*)d_in[15]; const float* moe_wf = (const float*)d_in[16]; const float* moe_bf = (const float*)d_in[17];
    const float* moe_wg = (const float*)d_in[18]; const float* moe_wu = (const float*)d_in[19]; const float* moe_wd = (const float*)d_in[20];
    const float* ple_wg = (const float*)d_in[21]; const float* ple_wp = (const float*)d_in[22];
    const size_t MiB = 1u << 20;
    size_t off = 0;
    auto take = [&](size_t bytes) { unsigned char* r = ws + off; off += (bytes + 255) & ~(size_t)255; return r; };
    int* cnt = (int*)take(4 * 64 * 4 + 1024);
    float* h = (float*)take((size_t)T * D * 4);
    float* xn = (float*)take((size_t)T * D * 4);
    float* proj = (float*)take((size_t)T * GIN * 4);
    float* obuf = (float*)take((size_t)T * D * 4);
    float* og = (float*)take((size_t)T * D * 4);
    float* Hb = (float*)take((size_t)2 * T * DFF * 4);
    float* Y = (float*)take((size_t)2 * T * D * 4);
    int* list = (int*)take((size_t)NE * CAP * 4);
    float* wts = (float*)take((size_t)2 * T * 4);
    (void)MiB;
    hipMemsetAsync(cnt, 0, 4 * 64 * 4, st);
    hipMemcpyAsync(h, x, (size_t)T * D * 4, hipMemcpyDeviceToDevice, st);
    const int EB = (int)((size_t)T * D / 256);
    for (int i = 0; i < 4; ++i) {
        const int j = i >> 1;
        hipLaunchKernelGGL(k_rmsnorm, dim3(T / 4), dim3(256), 0, st, h, norm_mix + i * D, xn, T, D);
        if ((i & 1) == 0) {
            sgemm0(st, xn, D, gla_w_in + (size_t)j * D * GIN, GIN, proj, GIN, T, GIN, D, 0);
            hipLaunchKernelGGL(k_gla, dim3(64), dim3(256), 0, st, proj, gla_w_gk + (size_t)j * 16 * 512, gla_b_gk + j * 512, obuf);
            hipLaunchKernelGGL(k_gla_post, dim3(T), dim3(256), 0, st, obuf, proj, gla_norm + j * 256, og);
            sgemm0(st, og, D, gla_w_out + (size_t)j * D * D, D, h, D, T, D, D, 1);
        } else {
            hipLaunchKernelGGL(k_pool, dim3(EB), dim3(256), 0, st, xn, og);
            for (int g = 0; g < 4; ++g) sgemm0(st, og + g * 256, D, pool_w + ((size_t)j * 4 + g) * 256 * 256, 256, obuf + g * 256, D, T, 256, 256, 0);
            hipLaunchKernelGGL(k_pool_post, dim3(EB), dim3(256), 0, st, h, obuf, pool_b + j * D, pool_scale + j * D);
        }
        hipLaunchKernelGGL(k_rmsnorm, dim3(T / 4), dim3(256), 0, st, h, norm_ffn + i * D, xn, T, D);
        int* cn = cnt + i * 64;
        hipLaunchKernelGGL(k_route, dim3(T / 4), dim3(256), 0, st, xn, moe_wc + (size_t)i * D * 8, moe_bc + i * 8, moe_wf + (size_t)i * D * 64, moe_bf + i * 64, cn, list, wts);
        MoeArgs ma{cn, list};
        float* G = proj; float* U = proj + (size_t)2 * T * DFF;
        const int MT = 2 * T / 64 + NE;
        hipLaunchKernelGGL(k_sgemm<1>, dim3(DFF / 64, MT), dim3(256), 0, st, xn, D, moe_wg + (size_t)i * NE * D * DFF, DFF, G, DFF, 0, DFF, D, 0, ma, (size_t)D * DFF);
        hipLaunchKernelGGL(k_sgemm<1>, dim3(DFF / 64, MT), dim3(256), 0, st, xn, D, moe_wu + (size_t)i * NE * D * DFF, DFF, U, DFF, 0, DFF, D, 0, ma, (size_t)D * DFF);
        hipLaunchKernelGGL(k_silu_mul, dim3((unsigned)(((size_t)2 * T * DFF + 255) / 256)), dim3(256), 0, st, G, U, Hb, (size_t)2 * T * DFF);
        hipLaunchKernelGGL(k_sgemm<2>, dim3(D / 64, MT), dim3(256), 0, st, Hb, DFF, moe_wd + (size_t)i * NE * DFF * D, D, Y, D, 0, D, DFF, 0, ma, (size_t)DFF * D);
        hipLaunchKernelGGL(k_moe_combine, dim3(EB), dim3(256), 0, st, h, Y, wts);
        hipLaunchKernelGGL(k_rmsnorm, dim3(T / 4), dim3(256), 0, st, h, norm_ple + i * D, xn, T, D);
        sgemm0(st, xn, D, ple_wg + (size_t)i * D * D, D, obuf, D, T, D, D, 0);
        sgemm0(st, p + (size_t)i * T * PLE, PLE, ple_wp + (size_t)i * PLE * D, D, og, D, T, D, PLE, 0);
        hipLaunchKernelGGL(k_ple_post, dim3(EB), dim3(256), 0, st, h, obuf, og);
    }
    hipLaunchKernelGGL(k_rmsnorm, dim3(T / 4), dim3(256), 0, st, h, norm_final, d_out, T, D);
}
}
extern "C" void kernel_launch(void* const* d_in, const int* in_sizes, int n_in, void* d_out, int out_size, void* d_ws, size_t ws_size, hipStream_t stream) {
    (void)in_sizes; (void)n_in; (void)out_size; (void)ws_size;
    nv::forward(d_in, (float*)d_out, (unsigned char*)d_ws, stream);
}
```

```cpp
#include <hip/hip_runtime.h>
#include <stdint.h>
#include <stdio.h>
#include <string.h>
namespace fk {
#define LAS __attribute__((address_space(3)))
#define GAS __attribute__((address_space(1)))
typedef unsigned short bf16_t;
typedef short bf16x8 __attribute__((ext_vector_type(8)));
typedef float f32x4 __attribute__((ext_vector_type(4)));
typedef float f32x2 __attribute__((ext_vector_type(2)));
typedef unsigned u32x4 __attribute__((ext_vector_type(4)));
typedef unsigned u32x2 __attribute__((ext_vector_type(2)));

constexpr int T = 32768, D = 1024, SEQ = 2048, NB = 16, DFF = 384, NE = 64, PLE = 256, GIN = 3088, NPROJ = 3072;
constexpr int CAP = 65536;
constexpr float EPS = 1e-6f;
constexpr int NWAVES = 8, NTHREADS = 512;

constexpr size_t MiB = (size_t)1 << 20;
constexpr size_t WS_CTL = 0, CTL_ZERO_BYTES = 1 * MiB;
constexpr size_t WS_WIN = 2 * MiB;
constexpr size_t WS_WLR = 14 * MiB;
constexpr size_t WS_WOUT = 15 * MiB;
constexpr size_t WS_WPOOL = 19 * MiB;
constexpr size_t WS_WR = 20 * MiB;
constexpr size_t WS_WPG = 22 * MiB;
constexpr size_t WS_WPP = 30 * MiB;
constexpr size_t WS_WGU = 32 * MiB;
constexpr size_t WS_WD = 416 * MiB;
constexpr size_t WS_PB = 608 * MiB;
constexpr size_t WS_HB = 672 * MiB;
constexpr size_t WS_PROJ = 736 * MiB;
constexpr size_t WS_OG = 928 * MiB;
constexpr size_t WS_PP = 992 * MiB;
constexpr size_t WS_H2 = 1056 * MiB;
constexpr size_t WS_Y = 1116 * MiB;
constexpr size_t WS_LIST = 1244 * MiB;
constexpr size_t WS_RS = 1260 * MiB;
constexpr size_t WS_LR = 1261 * MiB;
constexpr size_t WS_SSP = 1263 * MiB;
constexpr size_t WS_WTS = 1267 * MiB;
constexpr size_t WS_END = 1268 * MiB;
constexpr int CW_BAR = 4096;
constexpr int CW_CNT = 8192;

constexpr int STAGE_BYTES = 131072;
constexpr int TAB_OFF = STAGE_BYTES;
constexpr int MAXU = 6;
constexpr int TABA_OFF = TAB_OFF + 512, TABB_OFF = TABA_OFF + MAXU * 1024;
constexpr int MISC_OFF = TABB_OFF + MAXU * 1024;
constexpr int LDS_BYTES = MISC_OFF + 256;
static_assert(LDS_BYTES <= 160 * 1024, "LDS");

#define LDS_WAIT() asm volatile("s_waitcnt lgkmcnt(0)" ::: "memory")
#define VM_WAIT() asm volatile("s_waitcnt vmcnt(0)" ::: "memory")
typedef __bf16 bf16x2_t __attribute__((ext_vector_type(2)));
__device__ __forceinline__ unsigned cvt_pk_bf16(float lo, float hi) { const bf16x2_t b = __builtin_convertvector((f32x2){lo, hi}, bf16x2_t); return __builtin_bit_cast(unsigned, b); }
__device__ __forceinline__ float bf_lo(unsigned w) { return __uint_as_float(w << 16); }
__device__ __forceinline__ float bf_hi(unsigned w) { return __uint_as_float(w & 0xffff0000u); }
__device__ __forceinline__ float wave_sum(float v) {
#pragma unroll
    for (int o = 1; o < 64; o <<= 1) v += __shfl_xor(v, o);
    return v;
}
__device__ __forceinline__ float fsigmoid(float x) { return __builtin_amdgcn_rcpf(1.0f + __expf(-x)); }
__device__ __forceinline__ float fsilu(float x) { return x * fsigmoid(x); }

#define XB_TMO      128
#define XB_XCNT(j)  (256  + 64 * (j))
#define XB_XSUB(j)  (1280 + 64 * (j))
#define XB_XGEN(j)  (2304 + 64 * (j))
#define XB_TOP      3328
#define XB_TOPGEN   3392
#define XCD_BAR_WORDS 3456
#define XB_SPIN_CAP (1u << 18)
__device__ __forceinline__ unsigned xb_ld(unsigned* p)              { return __hip_atomic_load(p, __ATOMIC_RELAXED, __HIP_MEMORY_SCOPE_AGENT); }
__device__ __forceinline__ unsigned xb_add(unsigned* p, unsigned v) { return __hip_atomic_fetch_add(p, v, __ATOMIC_RELAXED, __HIP_MEMORY_SCOPE_AGENT); }
__device__ __forceinline__ unsigned xb_xcc_id() { return (unsigned)__builtin_amdgcn_s_getreg((3 << 11) | 20) & 0xFu; }
#define XB_SPIN(cond, bar) do { unsigned _sp = 0; while (cond) { __builtin_amdgcn_s_sleep(1); \
    if ((++_sp & 255u) == 0u) { if (xb_ld(&(bar)[XB_TMO])) break; if (_sp > XB_SPIN_CAP) { atomicAdd(&(bar)[XB_TMO], 1u); break; } } } } while (0)
struct XcdBarrier { unsigned* bar; unsigned x; volatile LAS unsigned* st; };
__device__ __forceinline__ XcdBarrier xcd_barrier_post(unsigned* bar, volatile LAS unsigned* st) {
    XcdBarrier b; b.bar = bar; b.x = xb_xcc_id(); b.st = st;
    if (threadIdx.x == 0) (void)xb_add(&bar[XB_XCNT(b.x)], 1u);
    return b;
}
__device__ __forceinline__ void xcd_barrier_complete(unsigned* bar, unsigned x, unsigned& nloc, unsigned& nx) {
    const unsigned G = gridDim.x * gridDim.y * gridDim.z;
    unsigned sum, cnt, mine, sp = 0u;
    for (;;) {
        sum = 0u; cnt = 0u; mine = 0u;
#pragma unroll
        for (unsigned j = 0; j < 16; ++j) { const unsigned c = xb_ld(&bar[XB_XCNT(j)]); sum += c; cnt += (c > 0u) ? 1u : 0u; mine = (j == x) ? c : mine; }
        if (sum == G) break;
        __builtin_amdgcn_s_sleep(1);
        if ((++sp & 255u) == 0u) { if (xb_ld(&bar[XB_TMO])) break; if (sp > XB_SPIN_CAP) { atomicAdd(&bar[XB_TMO], 1u); break; } }
    }
    nloc = mine > 0u ? mine : 1u; nx = cnt > 0u ? cnt : 1u;
}
__device__ __forceinline__ void xcd_barrier(const XcdBarrier& b) {
    asm volatile("s_waitcnt vmcnt(0)" ::: "memory");
    __syncthreads();
    if (threadIdx.x == 0) {
        unsigned* bar = b.bar;
        __builtin_amdgcn_s_waitcnt(0);
        unsigned nloc = b.st[0], nx = b.st[1];
        if (nloc == 0u) { xcd_barrier_complete(bar, b.x, nloc, nx); b.st[0] = nloc; b.st[1] = nx; }
        const unsigned old = xb_add(&bar[XB_XSUB(b.x)], 1u);
        const unsigned gen = old / nloc;
        if (old + 1u == (gen + 1u) * nloc) {
            __builtin_amdgcn_fence(__ATOMIC_RELEASE, "agent");
            asm volatile("s_waitcnt vmcnt(0)" ::: "memory");
            const unsigned og = xb_add(&bar[XB_TOP], 1u);
            const unsigned tg = og / nx;
            if (og + 1u == (tg + 1u) * nx) xb_add(&bar[XB_TOPGEN], 1u);
            else XB_SPIN(xb_ld(&bar[XB_TOPGEN]) == tg, bar);
            __builtin_amdgcn_fence(__ATOMIC_ACQUIRE, "agent");
            xb_add(&bar[XB_XGEN(b.x)], 1u);
            asm volatile("s_waitcnt vmcnt(0)" ::: "memory");
        } else {
            XB_SPIN(xb_ld(&bar[XB_XGEN(b.x)]) == gen, bar);
            __builtin_amdgcn_fence(__ATOMIC_ACQUIRE, "agent");
            asm volatile("s_waitcnt vmcnt(0)" ::: "memory");
        }
    }
    __syncthreads();
}

constexpr int BM = 256, BK = 64, HALF = 128, HTB = HALF * BK * 2, NXCD = 8, WGM = 8;
__device__ __forceinline__ int lds_byte(int r, int c) { const int st = (r >> 4) * 2 + (c >> 5), rr = r & 15, cc = c & 31, ob = rr * 64 + cc * 2; return st * 1024 + (ob ^ (((ob >> 9) & 1) << 5)); }
__device__ __forceinline__ void stage_rc(int b, int& R, int& C) { const int st = b / 1024, sb = b % 1024, swz = sb ^ (((sb >> 9) & 1) << 5); R = (st >> 1) * 16 + swz / 64; C = (st & 1) * 32 + (swz % 64) / 2; }
__device__ __forceinline__ int perm32(int rho) { const int n = rho >> 4, i = rho & 15; return 8 * (i >> 2) + 4 * n + (i & 3); }

struct Unit { int pm, pn, ui, aux; };

struct DenseSched {
    static constexpr bool GATHER = false;
    const bf16_t* A; const bf16_t* Bt; int lda, K, acol_per_pn;
    int nM, nN, nwg, G, c;
    __device__ __forceinline__ void init(const bf16_t* A_, int lda_, const bf16_t* Bt_, int M, int N, int K_, int G_, int c_, int acol_per_pn_) {
        A = A_; Bt = Bt_; lda = lda_; K = K_; acol_per_pn = acol_per_pn_; nM = M / BM; nN = N / BM; nwg = nM * nN; G = G_; c = c_; }
    __device__ __forceinline__ bool next(int i, Unit& u) const {
        const long L = (long)i * G + c; if (L >= nwg) return false;
        int wgid = (int)L; { const int q = nwg / NXCD, r = nwg % NXCD, xcd = wgid % NXCD, off = wgid / NXCD; wgid = (xcd < r ? xcd * (q + 1) : r * (q + 1) + (xcd - r) * q) + off; }
        const int nig = WGM * nN, gid = wgid / nig, fm = gid * WGM, gsz = (nM - fm) < WGM ? (nM - fm) : WGM;
        u.pm = fm + ((wgid % nig) % gsz); u.pn = (wgid % nig) / gsz; u.ui = i; u.aux = 0; return true;
    }
    __device__ __forceinline__ const char* a_base(const Unit& u) const { return (const char*)A + ((size_t)u.pm * BM * lda + (size_t)u.pn * acol_per_pn) * 2; }
    __device__ __forceinline__ const char* b_base(const Unit& u) const { return (const char*)Bt + (size_t)u.pn * BM * K * 2; }
    __device__ __forceinline__ void rows(const Unit&, LAS unsigned char*, unsigned (&)[4]) const {}
};
template <bool UP> struct MoeSched {
    static constexpr bool GATHER = UP;
    static constexpr int NTN = UP ? 3 : 4;
    const bf16_t* A; const bf16_t* W; int G, c, ntiles;
    const LAS int* tpre;
    __device__ __forceinline__ bool next(int i, Unit& u) const {
        const int L = i * G + c; if (L >= ntiles * NTN || i >= MAXU) return false;
        const int tile = L / NTN;
        u.pm = tile; u.pn = L - tile * NTN; u.ui = i; u.aux = __builtin_amdgcn_readfirstlane(tpre[80 + i]); return true;
    }
    __device__ __forceinline__ bool next_search(int i, Unit& u) const {
        const int L = i * G + c; if (L >= ntiles * NTN || i >= MAXU) return false;
        const int tile = L / NTN; int e = 0;
        for (int x = 1; x < NE; ++x) e += (tpre[x] <= tile) ? 1 : 0;
        u.pm = tile; u.pn = L - tile * NTN; u.ui = i; u.aux = e; return true;
    }
    __device__ __forceinline__ const char* a_base(const Unit& u) const { return UP ? (const char*)A : (const char*)A + (size_t)u.pm * BM * DFF * 2; }
    __device__ __forceinline__ const char* b_base(const Unit& u) const {
        return UP ? (const char*)W + ((size_t)u.aux * 768 + (size_t)u.pn * BM) * D * 2 : (const char*)W + ((size_t)u.aux * D + (size_t)u.pn * BM) * DFF * 2; }
    __device__ __forceinline__ void rows(const Unit& u, LAS unsigned char* lds_all, unsigned (&v)[4]) const {
        if (UP) { const LAS unsigned* tab = (const LAS unsigned*)(lds_all + TABA_OFF) + u.ui * 256;
#pragma unroll
            for (int i = 0; i < 2; ++i) { int R, C; int tx = threadIdx.x; asm volatile("" : "+v"(tx)); stage_rc(tx * 16 + i * 8192, R, C);
                v[i] = tab[R] + (unsigned)C * 2u; v[2 + i] = tab[HALF + R] + (unsigned)C * 2u; } }
    }
};

#define PG8_SA(b, h) (((b) * 2 + (h)) * HTB)
#define PG8_SB(b, h) ((4 + (b) * 2 + (h)) * HTB)
__device__ __forceinline__ void glds16(const void* gbase, unsigned voff, unsigned lds_dst) {
    unsigned keep;
    asm volatile("s_mov_b32 %0, m0\n\ts_mov_b32 m0, %3\n\ts_nop 0\n\tglobal_load_lds_dwordx4 %1, %2\n\ts_mov_b32 m0, %0" : "=&s"(keep) : "v"(voff), "s"(gbase), "s"(lds_dst) : "memory");
}
#define PG8_STAGE2(bufoff, gbase, o0, o1) do { glds16((gbase), (o0), (unsigned)(bufoff) + ldsw); glds16((gbase), (o1), (unsigned)(bufoff) + ldsw + 8192u); } while (0)
#define PG8_LDA(dst, b, h) do { _Pragma("unroll") for (int m = 0; m < 4; ++m) _Pragma("unroll") for (int k = 0; k < 2; ++k) dst[m][k] = *(const LAS bf16x8*)(lds + PG8_SA(b, h) + aoff + m * 2048 + k * 1024); } while (0)
#define PG8_LDB(dst, b, h) do { _Pragma("unroll") for (int n = 0; n < 2; ++n) _Pragma("unroll") for (int k = 0; k < 2; ++k) dst[n][k] = *(const LAS bf16x8*)(lds + PG8_SB(b, h) + boff + n * 2048 + k * 1024); } while (0)
#define PG8_MMA(ai, bj, At, Bt) do { __builtin_amdgcn_s_setprio(1); _Pragma("unroll") for (int m = 0; m < 4; ++m) _Pragma("unroll") for (int n = 0; n < 2; ++n) _Pragma("unroll") for (int k = 0; k < 2; ++k) \
        acc[ai][bj][m][n] = __builtin_amdgcn_mfma_f32_16x16x32_bf16(Bt[n][k], At[m][k], acc[ai][bj][m][n], 0, 0, 0); __builtin_amdgcn_s_setprio(0); } while (0)
#define PG8_WAIT_V(n) asm volatile("s_waitcnt vmcnt(" #n ")" ::: "memory")
#define PG8_WAIT_L(n) asm volatile("s_waitcnt lgkmcnt(" #n ")" ::: "memory")
#define PG8_BAR __builtin_amdgcn_s_barrier()
#define PG8_SCHED __builtin_amdgcn_sched_barrier(0)

template <class Epi, class Sched>
__device__ __forceinline__ void gemm_phase(LAS unsigned char* lds_all, const int K, const int lda, const Sched& S, const Epi& E) {
    LAS unsigned char* lds = lds_all;
    int tid_ = threadIdx.x; asm volatile("" : "+v"(tid_));
    const int tid = tid_, wid = __builtin_amdgcn_readfirstlane(tid >> 6), lane = tid & 63, wr = wid >> 2, wc = wid & 3, fr = lane & 15, fq = lane >> 4;
    const int nt = K / BK;
    unsigned vB[2], vA[4];
#pragma unroll
    for (int i = 0; i < 2; ++i) { int Rr, Cc; stage_rc(tid * 16 + i * 8192, Rr, Cc); const int Rb = Epi::PERM ? ((Rr & ~31) + perm32(Rr & 31)) : Rr;
        vB[i] = (unsigned)(Rb * K + Cc) * 2u; vA[i] = (unsigned)(Rr * lda + Cc) * 2u; vA[2 + i] = vA[i] + (unsigned)(HALF * lda) * 2u; }
    const size_t kstep = (size_t)(BK * 2);
    const size_t hstepB = (size_t)HALF * K * 2;
    const unsigned ldsw = (unsigned)wid * 1024u;
    const int aoff = lds_byte(wr * 64 + fr, fq * 8), boff = lds_byte(wc * 32 + fr, fq * 8);
    Unit cur, nxt; int ui = 0;
    if (!S.next(0, cur)) return;
    f32x4 acc[2][2][4][2];
#pragma unroll
    for (int a = 0; a < 2; ++a)
#pragma unroll
        for (int b = 0; b < 2; ++b)
#pragma unroll
            for (int m = 0; m < 4; ++m)
#pragma unroll
                for (int n = 0; n < 2; ++n) acc[a][b][m][n] = (f32x4){0.f, 0.f, 0.f, 0.f};
    bf16x8 At[4][2], B0[2][2], B1[2][2];
    const char* cA = S.a_base(cur); const char* cB = S.b_base(cur);
    if constexpr (Sched::GATHER) S.rows(cur, lds_all, vA);
    PG8_STAGE2(PG8_SB(0, 0), cB, vB[0], vB[1]); PG8_STAGE2(PG8_SB(0, 1), cB + hstepB, vB[0], vB[1]); PG8_STAGE2(PG8_SA(0, 0), cA, vA[0], vA[1]); PG8_STAGE2(PG8_SA(0, 1), cA, vA[2], vA[3]);
    if (wr == 1) PG8_BAR;
    PG8_WAIT_V(2); PG8_BAR;
    PG8_STAGE2(PG8_SB(1, 0), cB + kstep, vB[0], vB[1]); PG8_STAGE2(PG8_SA(1, 0), cA + kstep, vA[0], vA[1]); PG8_STAGE2(PG8_SB(1, 1), cB + hstepB + kstep, vB[0], vB[1]);
    PG8_WAIT_V(6); PG8_BAR;
    for (;;) {
        const bool has_next = S.next(ui + 1, nxt);
        const char* nA = has_next ? S.a_base(nxt) : cA; const char* nB = has_next ? S.b_base(nxt) : cB;
#pragma unroll 1
        for (int t = 0; t < nt; t += 2) {
            const bool last = (t == nt - 2);
            const char* a1 = cA + (size_t)(t + 1) * kstep;
            const char* a2 = last ? nA : cA + (size_t)(t + 2) * kstep; const char* b2 = last ? nB : cB + (size_t)(t + 2) * kstep;
            const char* a3 = a2 + kstep; const char* b3 = b2 + kstep;
            PG8_LDB(B0, 0, 0); PG8_LDB(B1, 0, 1); PG8_SCHED; PG8_LDA(At, 0, 0); PG8_STAGE2(PG8_SA(1, 1), a1, vA[2], vA[3]);
            PG8_WAIT_V(8); PG8_WAIT_L(0); PG8_BAR; PG8_MMA(0, 0, At, B0); PG8_MMA(0, 1, At, B1); PG8_BAR; PG8_SCHED;
            if constexpr (Sched::GATHER) { if (last && has_next) S.rows(nxt, lds_all, vA); }
            PG8_LDA(At, 0, 1); PG8_STAGE2(PG8_SB(0, 0), b2, vB[0], vB[1]); PG8_STAGE2(PG8_SB(0, 1), b2 + hstepB, vB[0], vB[1]); PG8_STAGE2(PG8_SA(0, 0), a2, vA[0], vA[1]);
            PG8_WAIT_V(8); PG8_WAIT_L(0); PG8_BAR; PG8_MMA(1, 0, At, B0); PG8_MMA(1, 1, At, B1); PG8_BAR; PG8_SCHED;
            PG8_LDB(B0, 1, 0); PG8_LDB(B1, 1, 1); PG8_SCHED; PG8_LDA(At, 1, 0); PG8_STAGE2(PG8_SA(0, 1), a2, vA[2], vA[3]);
            PG8_WAIT_V(8); PG8_WAIT_L(0); PG8_BAR; PG8_MMA(0, 0, At, B0); PG8_MMA(0, 1, At, B1); PG8_BAR; PG8_SCHED;
            PG8_LDA(At, 1, 1); PG8_STAGE2(PG8_SB(1, 0), b3, vB[0], vB[1]); PG8_STAGE2(PG8_SB(1, 1), b3 + hstepB, vB[0], vB[1]); PG8_STAGE2(PG8_SA(1, 0), a3, vA[0], vA[1]);
            PG8_WAIT_V(8); PG8_WAIT_L(0); PG8_BAR; PG8_MMA(1, 0, At, B0); PG8_MMA(1, 1, At, B1); PG8_BAR; PG8_SCHED;
        }
        if (wr == 0) PG8_BAR;
        E(acc, cur, wr, wc, fr, fq, lds_all);
        if (!has_next) break;
#pragma unroll
        for (int a = 0; a < 2; ++a)
#pragma unroll
            for (int b = 0; b < 2; ++b)
#pragma unroll
                for (int m = 0; m < 4; ++m)
#pragma unroll
                    for (int n = 0; n < 2; ++n) acc[a][b][m][n] = (f32x4){0.f, 0.f, 0.f, 0.f};
        cur = nxt; cA = nA; cB = nB; ++ui;
        if (wr == 1) PG8_BAR;
    }
    PG8_WAIT_V(0);
    PG8_BAR;
}

__device__ __forceinline__ u32x4 pack8(const f32x4 v0, const f32x4 v1) { u32x4 w; w.x = cvt_pk_bf16(v0[0], v0[1]); w.y = cvt_pk_bf16(v0[2], v0[3]); w.z = cvt_pk_bf16(v1[0], v1[1]); w.w = cvt_pk_bf16(v1[2], v1[3]); return w; }

struct EpiBf16Rs {
    static constexpr bool PERM = true;
    bf16_t* O; int ldc; const float* rs;
    __device__ __forceinline__ void operator()(const f32x4 (&acc)[2][2][4][2], const Unit& u, int wr, int wc, int fr, int fq, LAS unsigned char*) const {
        const int row0 = u.pm * BM + wr * 64 + fr, col0 = u.pn * BM + wc * 32 + 8 * fq;
#pragma unroll
        for (int ai = 0; ai < 2; ++ai)
#pragma unroll
            for (int m = 0; m < 4; ++m) { const int row = row0 + ai * HALF + m * 16; const float s = rs ? rs[row] : 1.0f; bf16_t* rowp = O + (size_t)row * ldc + col0;
#pragma unroll
                for (int bj = 0; bj < 2; ++bj) *(u32x4*)(rowp + bj * HALF) = pack8(acc[ai][bj][m][0] * s, acc[ai][bj][m][1] * s); }
    }
};
struct EpiResid {
    static constexpr bool PERM = false;
    const float* hin; float* out;
    __device__ __forceinline__ void operator()(const f32x4 (&acc)[2][2][4][2], const Unit& u, int wr, int wc, int fr, int fq, LAS unsigned char*) const {
        const int row0 = u.pm * BM + wr * 64 + fr, col0 = u.pn * BM + wc * 32 + 4 * fq;
#pragma unroll
        for (int ai = 0; ai < 2; ++ai)
#pragma unroll
            for (int m = 0; m < 4; ++m) { const size_t off = (size_t)(row0 + ai * HALF + m * 16) * D + col0;
#pragma unroll
                for (int bj = 0; bj < 2; ++bj)
#pragma unroll
                    for (int n = 0; n < 2; ++n) { const f32x4 b = *(const f32x4*)(hin + off + bj * HALF + n * 16); *(f32x4*)(out + off + bj * HALF + n * 16) = b + acc[ai][bj][m][n]; } }
    }
};
struct EpiPool {
    static constexpr bool PERM = false;
    const float* hin; float* out; const float* bias; const float* sc;
    __device__ __forceinline__ void operator()(const f32x4 (&acc)[2][2][4][2], const Unit& u, int wr, int wc, int fr, int fq, LAS unsigned char*) const {
        const int row0 = u.pm * BM + wr * 64 + fr, col0 = u.pn * BM + wc * 32 + 4 * fq;
#pragma unroll
        for (int bj = 0; bj < 2; ++bj)
#pragma unroll
            for (int n = 0; n < 2; ++n) { const f32x4 bv = *(const f32x4*)(bias + col0 + bj * HALF + n * 16), sv = *(const f32x4*)(sc + col0 + bj * HALF + n * 16);
#pragma unroll
                for (int ai = 0; ai < 2; ++ai)
#pragma unroll
                    for (int m = 0; m < 4; ++m) { const size_t off = (size_t)(row0 + ai * HALF + m * 16) * D + col0 + bj * HALF + n * 16;
                        const f32x4 b = *(const f32x4*)(hin + off); *(f32x4*)(out + off) = b + (acc[ai][bj][m][n] + bv) * sv; } }
    }
};
struct EpiPle {
    static constexpr bool PERM = false;
    const float* hin; float* out; const float* rs; const bf16_t* pp;
    __device__ __forceinline__ void operator()(const f32x4 (&acc)[2][2][4][2], const Unit& u, int wr, int wc, int fr, int fq, LAS unsigned char*) const {
        const int row0 = u.pm * BM + wr * 64 + fr, col0 = u.pn * BM + wc * 32 + 4 * fq;
#pragma unroll
        for (int ai = 0; ai < 2; ++ai)
#pragma unroll
            for (int m = 0; m < 4; ++m) { const int row = row0 + ai * HALF + m * 16; const size_t off = (size_t)row * D + col0; const float s = rs[row];
#pragma unroll
                for (int bj = 0; bj < 2; ++bj)
#pragma unroll
                    for (int n = 0; n < 2; ++n) { const f32x4 b = *(const f32x4*)(hin + off + bj * HALF + n * 16); const u32x2 pw = *(const u32x2*)(pp + off + bj * HALF + n * 16);
                        const f32x4 a = acc[ai][bj][m][n] * s; f32x4 o;
                        o[0] = b[0] + fsigmoid(a[0]) * bf_lo(pw.x); o[1] = b[1] + fsigmoid(a[1]) * bf_hi(pw.x); o[2] = b[2] + fsigmoid(a[2]) * bf_lo(pw.y); o[3] = b[3] + fsigmoid(a[3]) * bf_hi(pw.y);
                        *(f32x4*)(out + off + bj * HALF + n * 16) = o; } }
    }
};
struct EpiUp {
    static constexpr bool PERM = true;
    bf16_t* H;
    __device__ __forceinline__ void operator()(const f32x4 (&acc)[2][2][4][2], const Unit& u, int wr, int wc, int fr, int fq, LAS unsigned char* lds_all) const {
        const LAS float* rst = (const LAS float*)(lds_all + TABB_OFF) + u.ui * 256;
        const int r0 = wr * 64 + fr, col0 = u.pn * HALF + wc * 32 + 8 * fq;
#pragma unroll
        for (int ai = 0; ai < 2; ++ai)
#pragma unroll
            for (int m = 0; m < 4; ++m) { const int r = r0 + ai * HALF + m * 16; const float s = rst[r];
                f32x4 h0, h1;
#pragma unroll
                for (int j = 0; j < 4; ++j) { h0[j] = fsilu(acc[ai][0][m][0][j] * s) * (acc[ai][1][m][0][j] * s); h1[j] = fsilu(acc[ai][0][m][1][j] * s) * (acc[ai][1][m][1][j] * s); }
                *(u32x4*)(H + ((size_t)u.pm * BM + r) * DFF + col0) = pack8(h0, h1); }
    }
};
struct EpiDown {
    static constexpr bool PERM = true;
    bf16_t* Y;
    __device__ __forceinline__ void operator()(const f32x4 (&acc)[2][2][4][2], const Unit& u, int wr, int wc, int fr, int fq, LAS unsigned char* lds_all) const {
        const LAS int* at = (const LAS int*)(lds_all + TABA_OFF) + u.ui * 256; const LAS float* wt = (const LAS float*)(lds_all + TABB_OFF) + u.ui * 256;
        const int r0 = wr * 64 + fr, col0 = u.pn * BM + wc * 32 + 8 * fq;
#pragma unroll
        for (int ai = 0; ai < 2; ++ai)
#pragma unroll
            for (int m = 0; m < 4; ++m) { const int r = r0 + ai * HALF + m * 16; const int a = at[r]; const float w = wt[r];
                if (a >= 0) { bf16_t* rowp = Y + (size_t)a * D + col0;
#pragma unroll
                    for (int bj = 0; bj < 2; ++bj) *(u32x4*)(rowp + bj * HALF) = pack8(acc[ai][bj][m][0] * w, acc[ai][bj][m][1] * w); } }
    }
};
template <int MODE>
__device__ __forceinline__ void cvt_item(const float* __restrict__ src, int ldsrc, int col0, int K, int N, bf16_t* __restrict__ dst, int row0, const float* __restrict__ kscale, int kmod, float scalar,
                                         size_t lo_off, LAS float* scr, int item, int lane) {
    const int nblk = (N + 31) / 32, kb = item / nblk, nb = item - kb * nblk, k0 = 64 * kb, n0 = 32 * nb;
    {
        const int lr = lane >> 3, lc = (lane & 7) * 4;
#pragma unroll
        for (int i = 0; i < 8; ++i) { const int kk = lr + 8 * i; float v[4];
            if (n0 + lc + 3 < N) { const f32x4 t = *(const f32x4*)(src + (size_t)(k0 + kk) * ldsrc + col0 + n0 + lc); v[0] = t[0]; v[1] = t[1]; v[2] = t[2]; v[3] = t[3]; }
            else {
#pragma unroll
                for (int j = 0; j < 4; ++j) v[j] = (n0 + lc + j < N) ? src[(size_t)(k0 + kk) * ldsrc + col0 + n0 + lc + j] : 0.f; }
            const float g = (kscale ? kscale[(k0 + kk) % kmod] : 1.0f) * scalar;
#pragma unroll
            for (int j = 0; j < 4; ++j) scr[kk * 33 + lc + j] = v[j] * g; }
    }
    LDS_WAIT(); asm volatile("" ::: "memory");
    const int c = lane & 7;
#pragma unroll
    for (int j = 0; j < 4; ++j) { const int n = (lane >> 3) + 8 * j; const LAS float* s = scr + (8 * c) * 33 + n;
        float f[8];
#pragma unroll
        for (int q = 0; q < 8; ++q) f[q] = s[q * 33];
        if (n0 + n < N) {
            const int nn = n0 + n;
            int drow = row0 + nn;
            if (MODE == 1) drow = (nn >> 7) * 256 + (nn & 127);
            if (MODE == 2) drow = (nn >> 7) * 256 + 128 + (nn & 127);
            u32x4 o; o.x = cvt_pk_bf16(f[0], f[1]); o.y = cvt_pk_bf16(f[2], f[3]); o.z = cvt_pk_bf16(f[4], f[5]); o.w = cvt_pk_bf16(f[6], f[7]);
            *(u32x4*)(dst + (size_t)drow * K + k0 + 8 * c) = o;
            if (MODE == 3) { float l[8];
#pragma unroll
                for (int q = 0; q < 4; ++q) { l[2 * q] = f[2 * q] - bf_lo(((unsigned*)&o)[q]); l[2 * q + 1] = f[2 * q + 1] - bf_hi(((unsigned*)&o)[q]); }
                u32x4 p; p.x = cvt_pk_bf16(l[0], l[1]); p.y = cvt_pk_bf16(l[2], l[3]); p.z = cvt_pk_bf16(l[4], l[5]); p.w = cvt_pk_bf16(l[6], l[7]);
                *(u32x4*)(dst + lo_off + (size_t)drow * K + k0 + 8 * c) = p; }
        }
    }
    LDS_WAIT(); asm volatile("" ::: "memory");
}
template <int MODE>
__device__ __forceinline__ void cvt_matrix(const float* src, int ldsrc, int col0, int K, int N, bf16_t* dst, int row0, const float* kscale, int kmod, float scalar, size_t lo_off,
                                           LAS float* scr, int gw, int NGW, int lane) {
    const int nitems = (K / 64) * ((N + 31) / 32);
    for (int it = gw; it < nitems; it += NGW) cvt_item<MODE>(src, ldsrc, col0, K, N, dst, row0, kscale, kmod, scalar, lo_off, scr, it, lane);
}

struct Ptrs {
    const float* in[23]; float* out; unsigned char* ws; int ph_lo, ph_hi;
};

typedef const __attribute__((address_space(4))) Ptrs CPtrs;
__device__ __forceinline__ CPtrs* kargs() { CPtrs* p = (CPtrs*)__builtin_amdgcn_kernarg_segment_ptr(); asm volatile("" : "+s"(p)); return p; }

__device__ __forceinline__ void prologue(CPtrs& P, LAS unsigned char* lds, int vcu, int G, int wave, int lane) {
    LAS float* scr = (LAS float*)(lds + wave * 8448);
    const int gw = vcu * NWAVES + wave, NGW = G * NWAVES;
    unsigned char* ws = P.ws;
    const float* norm_mix = P.in[2]; const float* norm_ffn = P.in[3]; const float* norm_ple = P.in[4];
    {
        const float* wg = P.in[18]; const float* wu = P.in[19]; const float* wd = P.in[20];
        const int total = 4 * NE * 576;
        for (int it = gw; it < total; it += NGW) {
            const int le = it / 576, r = it - le * 576, which = r / 192, rr = r - which * 192, layer = le >> 6;
            bf16_t* gu = (bf16_t*)(ws + WS_WGU) + (size_t)le * 768 * D; bf16_t* dn = (bf16_t*)(ws + WS_WD) + (size_t)le * D * DFF;
            if (which == 0) cvt_item<1>(wg + (size_t)le * D * DFF, DFF, 0, D, DFF, gu, 0, norm_ffn + layer * D, D, 1.0f, 0, scr, rr, lane);
            else if (which == 1) cvt_item<2>(wu + (size_t)le * D * DFF, DFF, 0, D, DFF, gu, 0, norm_ffn + layer * D, D, 1.0f, 0, scr, rr, lane);
            else cvt_item<0>(wd + (size_t)le * DFF * D, D, 0, DFF, D, dn, 0, nullptr, 1, 1.0f, 0, scr, rr, lane);
        }
    }
    int rot = 0;
#define ROT() ((gw + NGW - (rot++ * 397) % NGW) % NGW)
    for (int j = 0; j < 2; ++j) {
        const float* win = P.in[6] + (size_t)j * D * GIN;
        bf16_t* wt = (bf16_t*)(ws + WS_WIN) + (size_t)j * NPROJ * D;
        cvt_matrix<0>(win, GIN, 0, D, 512, wt, 0, norm_mix + (2 * j) * D, D, 0.08838834764831845f, 0, scr, ROT(), NGW, lane);
        cvt_matrix<0>(win, GIN, 512, D, 2560, wt, 512, norm_mix + (2 * j) * D, D, 1.0f, 0, scr, ROT(), NGW, lane);
        cvt_matrix<3>(win, GIN, 3072, D, 16, (bf16_t*)(ws + WS_WLR) + (size_t)j * 2 * 16 * D, 0, norm_mix + (2 * j) * D, D, 1.0f, (size_t)16 * D, scr, ROT(), NGW, lane);
        cvt_matrix<0>(P.in[10] + (size_t)j * D * D, D, 0, D, D, (bf16_t*)(ws + WS_WOUT) + (size_t)j * D * D, 0, P.in[9] + j * 256, 256, 1.0f, 0, scr, ROT(), NGW, lane);
        for (int g = 0; g < 4; ++g)
            cvt_matrix<0>(P.in[11] + ((size_t)j * 4 + g) * 256 * 256, 256, 0, 256, 256, (bf16_t*)(ws + WS_WPOOL) + ((size_t)j * 4 + g) * 256 * 256, 0, norm_mix + (2 * j + 1) * D + g * 256, 256, 1.0f, 0, scr, ROT(), NGW, lane);
    }
    for (int i = 0; i < 4; ++i) {
        bf16_t* wr = (bf16_t*)(ws + WS_WR) + (size_t)i * 2 * 80 * D;
        cvt_matrix<3>(P.in[14] + (size_t)i * D * 8, 8, 0, D, 8, wr, 0, norm_ffn + i * D, D, 1.0f, (size_t)80 * D, scr, ROT(), NGW, lane);
        cvt_matrix<3>(P.in[16] + (size_t)i * D * 64, 64, 0, D, 64, wr, 8, norm_ffn + i * D, D, 1.0f, (size_t)80 * D, scr, ROT(), NGW, lane);
        cvt_matrix<0>(P.in[21] + (size_t)i * D * D, D, 0, D, D, (bf16_t*)(ws + WS_WPG) + (size_t)i * D * D, 0, norm_ple + i * D, D, 1.0f, 0, scr, ROT(), NGW, lane);
        cvt_matrix<0>(P.in[22] + (size_t)i * PLE * D, D, 0, PLE, D, (bf16_t*)(ws + WS_WPP) + (size_t)i * D * PLE, 0, nullptr, 1, 1.0f, 0, scr, ROT(), NGW, lane);
        for (int idx = gw * 64 + lane; idx < 2 * 8 * D / 8; idx += NGW * 64) { const int hl = idx / (8 * D / 8), rem = idx - hl * (8 * D / 8);
            *(u32x4*)(wr + (size_t)hl * 80 * D + (size_t)72 * D + (size_t)rem * 8) = (u32x4){0u, 0u, 0u, 0u}; }
    }
#undef ROT
    {
        const float* p = P.in[1]; bf16_t* pb = (bf16_t*)(ws + WS_PB);
        const size_t n8 = (size_t)4 * T * PLE / 8;
        for (size_t i = (size_t)gw * 64 + lane; i < n8; i += (size_t)NGW * 64) {
            const f32x4 a = *(const f32x4*)(p + i * 8), b = *(const f32x4*)(p + i * 8 + 4);
            *(u32x4*)(pb + i * 8) = pack8(a, b); }
    }
}

constexpr int NPB_STRIDE = 288;
template <int MODE>
__device__ __forceinline__ void np_pass(LAS unsigned char* lds, const float* __restrict__ hin, float* __restrict__ hout, bf16_t* __restrict__ hb, float* __restrict__ rs,
                                        const bf16_t* __restrict__ Wsm  , float* __restrict__ lr, const bf16_t* __restrict__ Y,
                                        const float* __restrict__ bc, const float* __restrict__ bfine, unsigned* cnt, int* __restrict__ list, float* __restrict__ wts,
                                        int G, int wave, int lane) {
    constexpr int NR = (MODE == 1) ? 80 : 16, NT = NR / 16;
    constexpr int BUFB = 2 * NR * NPB_STRIDE;
    int tid_ = threadIdx.x; asm volatile("" : "+v"(tid_));
    const int tid = tid_, r = lane & 15, g = lane >> 4;
    for (int blk = blockIdx.x; blk < T / 128; blk += G) {
        const int row0 = blk * 128 + wave * 16;
        const float* hrow = hin + (size_t)(row0 + r) * D + 8 * g;
        float ss = 0.f;
        if constexpr (MODE == 2) {
            const bf16_t* y0 = Y + (size_t)(2 * (row0 + r)) * D + 8 * g; const bf16_t* y1 = y0 + D;
            float* orow = hout + (size_t)(row0 + r) * D + 8 * g; bf16_t* brow = hb + (size_t)(row0 + r) * D + 8 * g;
#pragma unroll 4
            for (int kk = 0; kk < 32; ++kk) {
                f32x4 a = *(const f32x4*)(hrow + 32 * kk), b = *(const f32x4*)(hrow + 32 * kk + 4);
                const u32x4 p = *(const u32x4*)(y0 + 32 * kk), q = *(const u32x4*)(y1 + 32 * kk);
                a[0] += bf_lo(p.x) + bf_lo(q.x); a[1] += bf_hi(p.x) + bf_hi(q.x); a[2] += bf_lo(p.y) + bf_lo(q.y); a[3] += bf_hi(p.y) + bf_hi(q.y);
                b[0] += bf_lo(p.z) + bf_lo(q.z); b[1] += bf_hi(p.z) + bf_hi(q.z); b[2] += bf_lo(p.w) + bf_lo(q.w); b[3] += bf_hi(p.w) + bf_hi(q.w);
                *(f32x4*)(orow + 32 * kk) = a; *(f32x4*)(orow + 32 * kk + 4) = b;
                *(u32x4*)(brow + 32 * kk) = pack8(a, b);
                ss += (a[0] * a[0] + a[1] * a[1]) + (a[2] * a[2] + a[3] * a[3]) + (b[0] * b[0] + b[1] * b[1]) + (b[2] * b[2] + b[3] * b[3]);
            }
            ss += __shfl_xor(ss, 16); ss += __shfl_xor(ss, 32);
            if (lane < 16) rs[row0 + lane] = 1.0f / sqrtf(ss * (1.0f / D) + EPS);
        } else {
            f32x4 acc[NT];
#pragma unroll
            for (int i = 0; i < NT; ++i) acc[i] = (f32x4){0.f, 0.f, 0.f, 0.f};
            bf16_t* brow = hb + (size_t)(row0 + r) * D + 8 * g;
            constexpr int PPT = (2 * NR * 16) / NTHREADS;
            static_assert(PPT * NTHREADS == 2 * NR * 16, "pieces");
            u32x4 breg[PPT];
            const unsigned goff0 = (unsigned)(tid >> 4) * (unsigned)(D * 2) + (unsigned)(tid & 15) * 16u, loff0 = (unsigned)(tid >> 4) * (unsigned)NPB_STRIDE + (unsigned)(tid & 15) * 16u;
            auto bload = [&](int c) {
                const char* gb = (const char*)Wsm + c * 256;
#pragma unroll
                for (int i = 0; i < PPT; ++i) breg[i] = *(const u32x4*)(gb + (goff0 + (unsigned)(i * 32 * D * 2)));
            };
            auto bstore = [&](int buf) {
#pragma unroll
                for (int i = 0; i < PPT; ++i) *(LAS u32x4*)(lds + buf * BUFB + loff0 + i * 32 * NPB_STRIDE) = breg[i];
            };
            bload(0); bstore(0);
            f32x4 hva[4][2], hvb[4][2];
#pragma unroll
            for (int kk = 0; kk < 4; ++kk) { hva[kk][0] = *(const f32x4*)(hrow + 32 * kk); hva[kk][1] = *(const f32x4*)(hrow + 32 * kk + 4); }
            __syncthreads();
            auto compute = [&](const f32x4 (&hv)[4][2], int c, int cb) {
#pragma unroll
                for (int kk = 0; kk < 4; ++kk) {
                    const f32x4 a = hv[kk][0], b = hv[kk][1];
                    ss += (a[0] * a[0] + a[1] * a[1]) + (a[2] * a[2] + a[3] * a[3]) + (b[0] * b[0] + b[1] * b[1]) + (b[2] * b[2] + b[3] * b[3]);
                    const u32x4 hi = pack8(a, b);
                    *(u32x4*)(brow + 128 * c + 32 * kk) = hi;
                    f32x4 la, lb;
                    la[0] = a[0] - bf_lo(hi.x); la[1] = a[1] - bf_hi(hi.x); la[2] = a[2] - bf_lo(hi.y); la[3] = a[3] - bf_hi(hi.y);
                    lb[0] = b[0] - bf_lo(hi.z); lb[1] = b[1] - bf_hi(hi.z); lb[2] = b[2] - bf_lo(hi.w); lb[3] = b[3] - bf_hi(hi.w);
                    const u32x4 lo = pack8(la, lb);
                    const bf16x8 ah = __builtin_bit_cast(bf16x8, hi), al = __builtin_bit_cast(bf16x8, lo);
#pragma unroll
                    for (int nt = 0; nt < NT; ++nt) {
                        const bf16x8 bh = *(const LAS bf16x8*)(lds + cb * BUFB + (nt * 16 + r) * NPB_STRIDE + (32 * kk + 8 * g) * 2);
                        const bf16x8 bl = *(const LAS bf16x8*)(lds + cb * BUFB + (NR + nt * 16 + r) * NPB_STRIDE + (32 * kk + 8 * g) * 2);
                        acc[nt] = __builtin_amdgcn_mfma_f32_16x16x32_bf16(ah, bh, acc[nt], 0, 0, 0);
                        acc[nt] = __builtin_amdgcn_mfma_f32_16x16x32_bf16(al, bh, acc[nt], 0, 0, 0);
                        acc[nt] = __builtin_amdgcn_mfma_f32_16x16x32_bf16(ah, bl, acc[nt], 0, 0, 0);
                    }
                }
            };
#pragma unroll 1
            for (int c = 0; c < 8; c += 2) {
                bload(c + 1);
#pragma unroll
                for (int kk = 0; kk < 4; ++kk) { hvb[kk][0] = *(const f32x4*)(hrow + 128 * (c + 1) + 32 * kk); hvb[kk][1] = *(const f32x4*)(hrow + 128 * (c + 1) + 32 * kk + 4); }
                compute(hva, c, 0);
                bstore(1);
                __syncthreads();
                if (c + 2 < 8) { bload(c + 2);
#pragma unroll
                    for (int kk = 0; kk < 4; ++kk) { hva[kk][0] = *(const f32x4*)(hrow + 128 * (c + 2) + 32 * kk); hva[kk][1] = *(const f32x4*)(hrow + 128 * (c + 2) + 32 * kk + 4); } }
                compute(hvb, c + 1, 1);
                if (c + 2 < 8) bstore(0);
                __syncthreads();
            }
            ss += __shfl_xor(ss, 16); ss += __shfl_xor(ss, 32);
            const float rsv = 1.0f / sqrtf(ss * (1.0f / D) + EPS);
            if (lane < 16) rs[row0 + lane] = rsv;
            float rsr[4];
#pragma unroll
            for (int j = 0; j < 4; ++j) rsr[j] = __shfl(rsv, 4 * g + j);
            if constexpr (MODE == 0) {
#pragma unroll
                for (int j = 0; j < 4; ++j) lr[(size_t)(row0 + 4 * g + j) * 16 + r] = acc[0][j] * rsr[j];
            } else {
                LAS float* slog = (LAS float*)(lds) + wave * 16 * 80;
                LAS int* hist = (LAS int*)(lds + 8 * 16 * 80 * 4);
#pragma unroll
                for (int nt = 0; nt < NT; ++nt) { const int n = nt * 16 + r; const float bias = (n < 8) ? bc[n] : ((n < 72) ? bfine[n - 8] : 0.f);
#pragma unroll
                    for (int j = 0; j < 4; ++j) slog[(4 * g + j) * 80 + n] = acc[nt][j] * rsr[j] + bias; }
                if (tid < 64) hist[tid] = 0;
                __syncthreads();
                int ea = 0, eb = 0, pa = 0, pb = 0; float w0 = 0.f, w1 = 0.f;
                if (lane < 16) {
                    const LAS float* L = slog + lane * 80;
                    int gq = 0; float m = L[0];
#pragma unroll
                    for (int j = 1; j < 8; ++j) { const float v = L[j]; if (v > m) { m = v; gq = j; } }
                    float den = 0.f;
#pragma unroll
                    for (int j = 0; j < 8; ++j) den += __expf(L[j] - m);
                    const float pg = 1.0f / den;
                    const LAS float* f = L + 8 + gq * 8;
                    int i0 = 0; float v0 = f[0];
#pragma unroll
                    for (int j = 1; j < 8; ++j) { const float v = f[j]; if (v > v0) { v0 = v; i0 = j; } }
                    int i1 = -1; float v1 = 0.f;
#pragma unroll
                    for (int j = 0; j < 8; ++j) { const float v = f[j]; if (j != i0 && (i1 < 0 || v > v1)) { v1 = v; i1 = j; } }
                    const float e1 = __expf(v1 - v0); w0 = pg / (1.0f + e1); w1 = pg * e1 / (1.0f + e1);
                    ea = gq * 8 + i0; eb = gq * 8 + i1;
                    pa = atomicAdd((int*)&hist[ea], 1); pb = atomicAdd((int*)&hist[eb], 1);
                }
                __syncthreads();
                if (tid < 64) { const int c = hist[tid]; hist[64 + tid] = c ? (int)atomicAdd(cnt + tid, (unsigned)c) : 0; }
                __syncthreads();
                if (lane < 16) { const int t = row0 + lane;
                    list[(size_t)ea * CAP + hist[64 + ea] + pa] = 2 * t; wts[2 * t] = w0;
                    list[(size_t)eb * CAP + hist[64 + eb] + pb] = 2 * t + 1; wts[2 * t + 1] = w1; }
                __syncthreads();
            }
        }
    }
}

constexpr int GS128 = 288, GS64 = 160;
constexpr int G_QD = 0, G_KI = G_QD + 64 * GS128, G_KE = G_KI + 64 * GS128, G_VT = G_KE + 128 * GS64, G_AT = G_VT + 64 * GS64, G_ST = G_AT + 64 * GS64,
              G_DEC = G_ST + 2 * 64 * GS128, G_SEG = G_DEC + 512, G_END = G_SEG + 2 * 8 * 128 * 4;
static_assert(G_END <= STAGE_BYTES, "GLA LDS");
__device__ __forceinline__ bf16x8 ldfrag(const LAS unsigned char* img, int stride, int row, int kbyte) { return *(const LAS bf16x8*)(img + row * stride + kbyte); }

__device__ __forceinline__ void gla_phase(LAS unsigned char* lds, const bf16_t* __restrict__ proj, const float* __restrict__ lr, const float* __restrict__ wgk, const float* __restrict__ bgk,
                                          bf16_t* __restrict__ og, float* __restrict__ ssp, int vcu, int G, int wave, int lane) {
    int tid_ = threadIdx.x; asm volatile("" : "+v"(tid_));
    const int tid = tid_, r = lane & 15, g = lane >> 4;
    const int cp = lane;
    for (int unit = vcu; unit < NB * 4 * 4; unit += G) {
        const int b = unit >> 4, hd = (unit >> 2) & 3, cs = unit & 3;
        const size_t t0 = (size_t)b * SEQ;
        float wg0[16], wg1[16];
#pragma unroll
        for (int q = 0; q < 16; ++q) { const f32x2 w = *(const f32x2*)(wgk + q * 512 + hd * 128 + 2 * cp); wg0[q] = w.x; wg1[q] = w.y; }
        const f32x2 bg = *(const f32x2*)(bgk + hd * 128 + 2 * cp);
        for (int i = tid; i < 64 * GS128 / 16; i += NTHREADS) *(LAS u32x4*)(lds + G_ST + i * 16) = (u32x4){0u, 0u, 0u, 0u};
        f32x4 S[4];
#pragma unroll
        for (int i = 0; i < 4; ++i) S[i] = (f32x4){0.f, 0.f, 0.f, 0.f};
        unsigned qv[8], kv[8]; float lrv[2]; u32x4 vv;
        const int vrow = tid >> 3, vc8 = tid & 7;
        auto prefetch = [&](int n) {
            const size_t tb = t0 + 64 * n;
#pragma unroll
            for (int tt = 0; tt < 8; ++tt) { const bf16_t* rowp = proj + (tb + 8 * wave + tt) * NPROJ; qv[tt] = *(const unsigned*)(rowp + hd * 128 + 2 * cp); kv[tt] = *(const unsigned*)(rowp + 512 + hd * 128 + 2 * cp); }
#pragma unroll
            for (int x = 0; x < 2; ++x) lrv[x] = lr[(tb + 8 * wave + 4 * x + g) * 16 + r];
            vv = *(const u32x4*)(proj + (tb + vrow) * NPROJ + 1024 + hd * 256 + cs * 64 + 8 * vc8);
        };
        prefetch(0);
        __syncthreads();
        for (int n = 0; n < SEQ / 64; ++n) {
            const int par = n & 1;
            float b0[8], b1[8];
            {
                float c0 = 0.f, c1 = 0.f;
#pragma unroll
                for (int tt = 0; tt < 8; ++tt) {
                    float z0 = bg.x, z1 = bg.y;
#pragma unroll
                    for (int q = 0; q < 16; ++q) { const float s = __builtin_bit_cast(float, __builtin_amdgcn_readlane(__builtin_bit_cast(int, lrv[tt >> 2]), (tt & 3) * 16 + q)); z0 += s * wg0[q]; z1 += s * wg1[q]; }
                    const float g0 = (fminf(z0, 0.f) - __logf(1.0f + __expf(-fabsf(z0)))) * 0.0625f, g1 = (fminf(z1, 0.f) - __logf(1.0f + __expf(-fabsf(z1)))) * 0.0625f;
                    c0 += g0; c1 += g1; b0[tt] = c0; b1[tt] = c1;
                }
                *(LAS f32x2*)(lds + G_SEG + ((par * 8 + wave) * 128 + 2 * cp) * 4) = (f32x2){c0, c1};
            }
            __syncthreads();
            {
                float off0 = 0.f, off1 = 0.f, tot0 = 0.f, tot1 = 0.f;
#pragma unroll
                for (int s = 0; s < 8; ++s) { const f32x2 v = *(const LAS f32x2*)(lds + G_SEG + ((par * 8 + s) * 128 + 2 * cp) * 4); tot0 += v.x; tot1 += v.y; if (s < wave) { off0 += v.x; off1 += v.y; } }
                float e0[8], e1[8];
#pragma unroll
                for (int tt = 0; tt < 8; ++tt) {
                    const float bb0 = off0 + b0[tt], bb1 = off1 + b1[tt];
                    const float q0 = bf_lo(qv[tt]), q1 = bf_hi(qv[tt]), k0 = bf_lo(kv[tt]), k1 = bf_hi(kv[tt]);
                    const int tok = 8 * wave + tt;
                    *(LAS unsigned*)(lds + G_QD + tok * GS128 + 4 * cp) = cvt_pk_bf16(q0 * __expf(bb0), q1 * __expf(bb1));
                    *(LAS unsigned*)(lds + G_KI + tok * GS128 + 4 * cp) = cvt_pk_bf16(k0 * __expf(-bb0), k1 * __expf(-bb1));
                    e0[tt] = k0 * __expf(tot0 - bb0); e1[tt] = k1 * __expf(tot1 - bb1);
                }
                unsigned ke0[4], ke1[4];
#pragma unroll
                for (int p = 0; p < 4; ++p) { ke0[p] = cvt_pk_bf16(e0[2 * p], e0[2 * p + 1]); ke1[p] = cvt_pk_bf16(e1[2 * p], e1[2 * p + 1]); }
                *(LAS u32x4*)(lds + G_KE + (2 * cp) * GS64 + 16 * wave) = (u32x4){ke0[0], ke0[1], ke0[2], ke0[3]};
                *(LAS u32x4*)(lds + G_KE + (2 * cp + 1) * GS64 + 16 * wave) = (u32x4){ke1[0], ke1[1], ke1[2], ke1[3]};
                if (wave == 0) *(LAS f32x2*)(lds + G_DEC + 8 * cp) = (f32x2){__expf(tot0), __expf(tot1)};
                const unsigned vw[4] = {vv.x, vv.y, vv.z, vv.w};
#pragma unroll
                for (int j = 0; j < 4; ++j) { *(LAS unsigned short*)(lds + G_VT + (8 * vc8 + 2 * j) * GS64 + 2 * vrow) = (unsigned short)(vw[j] & 0xffffu);
                                              *(LAS unsigned short*)(lds + G_VT + (8 * vc8 + 2 * j + 1) * GS64 + 2 * vrow) = (unsigned short)(vw[j] >> 16); }
            }
            __syncthreads();
            if (n + 1 < SEQ / 64) prefetch(n + 1);
            const int it = wave >> 1, half = wave & 1;
            bf16x8 qf[4];
#pragma unroll
            for (int ks = 0; ks < 4; ++ks) qf[ks] = ldfrag(lds + G_QD, GS128, it * 16 + r, (32 * ks + 8 * g) * 2);
#pragma unroll
            for (int jj = 0; jj < 2; ++jj) {
                const int jt = 2 * half + jj;
                f32x4 a = (f32x4){0.f, 0.f, 0.f, 0.f};
                if (jt <= it) {
#pragma unroll
                    for (int ks = 0; ks < 4; ++ks) a = __builtin_amdgcn_mfma_f32_16x16x32_bf16(ldfrag(lds + G_KI, GS128, jt * 16 + r, (32 * ks + 8 * g) * 2), qf[ks], a, 0, 0, 0);
                    if (jt == it) {
#pragma unroll
                        for (int x = 0; x < 4; ++x) if (4 * g + x > r) a[x] = 0.f; }
                }
                *(LAS u32x2*)(lds + G_AT + (it * 16 + r) * GS64 + (jt * 16 + 4 * g) * 2) = (u32x2){cvt_pk_bf16(a[0], a[1]), cvt_pk_bf16(a[2], a[3])};
            }
            f32x4 o[2];
#pragma unroll
            for (int cc = 0; cc < 2; ++cc) { o[cc] = (f32x4){0.f, 0.f, 0.f, 0.f};
#pragma unroll
                for (int ks = 0; ks < 4; ++ks) o[cc] = __builtin_amdgcn_mfma_f32_16x16x32_bf16(ldfrag(lds + G_ST + par * 64 * GS128, GS128, (2 * half + cc) * 16 + r, (32 * ks + 8 * g) * 2), qf[ks], o[cc], 0, 0, 0); }
            {
                const f32x4 dec = *(const LAS f32x4*)(lds + G_DEC + (wave * 16 + 4 * g) * 4);
                const bf16x8 kf0 = ldfrag(lds + G_KE, GS64, wave * 16 + r, (8 * g) * 2), kf1 = ldfrag(lds + G_KE, GS64, wave * 16 + r, (32 + 8 * g) * 2);
#pragma unroll
                for (int ct = 0; ct < 4; ++ct) {
                    f32x4 s = S[ct] * dec;
                    s = __builtin_amdgcn_mfma_f32_16x16x32_bf16(kf0, ldfrag(lds + G_VT, GS64, ct * 16 + r, (8 * g) * 2), s, 0, 0, 0);
                    s = __builtin_amdgcn_mfma_f32_16x16x32_bf16(kf1, ldfrag(lds + G_VT, GS64, ct * 16 + r, (32 + 8 * g) * 2), s, 0, 0, 0);
                    S[ct] = s;
                    *(LAS u32x2*)(lds + G_ST + (par ^ 1) * 64 * GS128 + (ct * 16 + r) * GS128 + (wave * 16 + 4 * g) * 2) = (u32x2){cvt_pk_bf16(s[0], s[1]), cvt_pk_bf16(s[2], s[3])};
                }
            }
            __syncthreads();
            {
                const bf16x8 af0 = ldfrag(lds + G_AT, GS64, it * 16 + r, (8 * g) * 2), af1 = ldfrag(lds + G_AT, GS64, it * 16 + r, (32 + 8 * g) * 2);
                float ssq = 0.f;
                const size_t trow = t0 + 64 * n + it * 16 + r;
#pragma unroll
                for (int cc = 0; cc < 2; ++cc) {
                    const int ct = 2 * half + cc;
                    o[cc] = __builtin_amdgcn_mfma_f32_16x16x32_bf16(ldfrag(lds + G_VT, GS64, ct * 16 + r, (8 * g) * 2), af0, o[cc], 0, 0, 0);
                    if (it >= 2) o[cc] = __builtin_amdgcn_mfma_f32_16x16x32_bf16(ldfrag(lds + G_VT, GS64, ct * 16 + r, (32 + 8 * g) * 2), af1, o[cc], 0, 0, 0);
                    const f32x4 v = o[cc];
                    ssq += (v[0] * v[0] + v[1] * v[1]) + (v[2] * v[2] + v[3] * v[3]);
                    const int col = hd * 256 + cs * 64 + ct * 16 + 4 * g;
                    const u32x2 rw = *(const u32x2*)(proj + trow * NPROJ + 2048 + col);
                    *(u32x2*)(og + trow * D + col) = (u32x2){cvt_pk_bf16(v[0] * fsilu(bf_lo(rw.x)), v[1] * fsilu(bf_hi(rw.x))), cvt_pk_bf16(v[2] * fsilu(bf_lo(rw.y)), v[3] * fsilu(bf_hi(rw.y)))};
                }
                ssq += __shfl_xor(ssq, 16); ssq += __shfl_xor(ssq, 32);
                if (g == 0) ssp[trow * 32 + hd * 8 + cs * 2 + half] = ssq;
            }
        }
        __syncthreads();
    }
}

__device__ __forceinline__ void e1_pass(bf16_t* __restrict__ og, const float* __restrict__ ssp, int G) {
    const size_t n8 = (size_t)T * D / 8;
    int tid_ = threadIdx.x; asm volatile("" : "+v"(tid_));
    for (size_t i = (size_t)blockIdx.x * NTHREADS + tid_; i < n8; i += (size_t)G * NTHREADS) {
        const size_t t = i >> 7; const int hd = (int)((i & 127) >> 5);
        const f32x4 a = *(const f32x4*)(ssp + t * 32 + hd * 8), b = *(const f32x4*)(ssp + t * 32 + hd * 8 + 4);
        const float s = (a[0] + a[1]) + (a[2] + a[3]) + (b[0] + b[1]) + (b[2] + b[3]);
        const float rsh = 1.0f / sqrtf(s * (1.0f / 256.0f) + EPS);
        const u32x4 w = *(const u32x4*)(og + i * 8);
        u32x4 o; o.x = cvt_pk_bf16(bf_lo(w.x) * rsh, bf_hi(w.x) * rsh); o.y = cvt_pk_bf16(bf_lo(w.y) * rsh, bf_hi(w.y) * rsh); o.z = cvt_pk_bf16(bf_lo(w.z) * rsh, bf_hi(w.z) * rsh); o.w = cvt_pk_bf16(bf_lo(w.w) * rsh, bf_hi(w.w) * rsh);
        *(u32x4*)(og + i * 8) = o;
    }
}

__device__ __forceinline__ void pool_pass(LAS unsigned char* lds, const float* __restrict__ h, bf16_t* __restrict__ pooled, int G, int wave, int lane) {
    LAS float* rsl = (LAS float*)lds;
    for (int tile = blockIdx.x; tile < T / 128; tile += G) {
        const int t0 = tile * 128, seq0 = (t0 / SEQ) * SEQ;
        for (int rr = wave; rr < 144; rr += NWAVES) {
            const int t = t0 - 16 + rr; float rsv = 0.f;
            if (t >= seq0) { const f32x4* x = (const f32x4*)(h + (size_t)t * D) + lane; float s = 0.f;
#pragma unroll
                for (int j = 0; j < 4; ++j) { const f32x4 v = x[64 * j]; s += (v[0] * v[0] + v[1] * v[1]) + (v[2] * v[2] + v[3] * v[3]); }
                rsv = 1.0f / sqrtf(wave_sum(s) * (1.0f / D) + EPS); }
            if (lane == 0) rsl[rr] = rsv;
        }
        __syncthreads();
        for (int tt = 0; tt < 16; ++tt) {
            const int t = t0 + 16 * wave + tt, ts = t - seq0, ri = 16 + 16 * wave + tt;
#pragma unroll
            for (int j = 0; j < 4; ++j) {
                const int W = 2 << j;
                const f32x4 x0 = *((const f32x4*)(h + (size_t)t * D + 256 * j) + lane) * rsl[ri];
                f32x4 acc = x0;
#pragma unroll
                for (int u = 1; u < W; ++u) if (ts - u >= 0) acc += *((const f32x4*)(h + (size_t)(t - u) * D + 256 * j) + lane) * rsl[ri - u];
                const float inv = 1.0f / (float)(ts + 1 < W ? ts + 1 : W);
                const f32x4 p = acc * inv - x0;
                *(u32x2*)(pooled + (size_t)t * D + 256 * j + 4 * lane) = (u32x2){cvt_pk_bf16(p[0], p[1]), cvt_pk_bf16(p[2], p[3])};
            }
        }
        __syncthreads();
    }
}

__device__ __forceinline__ void final_norm(const float* __restrict__ h, const float* __restrict__ gfin, float* __restrict__ out, int G, int wave, int lane) {
    f32x4 gv[4];
#pragma unroll
    for (int j = 0; j < 4; ++j) gv[j] = *((const f32x4*)gfin + lane + 64 * j);
    for (int row = blockIdx.x * NWAVES + wave; row < T; row += G * NWAVES) {
        const f32x4* x = (const f32x4*)(h + (size_t)row * D) + lane; f32x4 v[4]; float s = 0.f;
#pragma unroll
        for (int j = 0; j < 4; ++j) { v[j] = x[64 * j]; s += (v[j][0] * v[j][0] + v[j][1] * v[j][1]) + (v[j][2] * v[j][2] + v[j][3] * v[j][3]); }
        const float rsv = 1.0f / sqrtf(wave_sum(s) * (1.0f / D) + EPS);
        f32x4* o = (f32x4*)(out + (size_t)row * D) + lane;
#pragma unroll
        for (int j = 0; j < 4; ++j) o[64 * j] = v[j] * rsv * gv[j];
    }
}

template <bool UP>
__device__ __forceinline__ int moe_tables(LAS unsigned char* lds_all, const unsigned* cnt, const int* __restrict__ list, const float* __restrict__ rs, const float* __restrict__ wts, int G, int c) {
    LAS int* tpre = (LAS int*)(lds_all + TAB_OFF);
    int tid_ = threadIdx.x; asm volatile("" : "+v"(tid_));
    const int tid = tid_;
    if (tid == 0) { int acc = 0; for (int e = 0; e < NE; ++e) { tpre[e] = acc; acc += ((int)cnt[e] + 255) >> 8; } tpre[NE] = acc; }
    __syncthreads();
    const int ntiles = tpre[NE];
    MoeSched<UP> S; S.G = G; S.c = c; S.ntiles = ntiles; S.tpre = tpre; S.A = nullptr; S.W = nullptr;
    Unit u;
    for (int i = 0; S.next_search(i, u); ++i) {
        if (tid == 0) tpre[80 + i] = u.aux;
        if (tid < 256) {
            const int e = u.aux, idx = (u.pm - tpre[e]) * 256 + tid; const bool valid = idx < (int)cnt[e];
            const int a = valid ? list[(size_t)e * CAP + idx] : -1;
            if (UP) { ((LAS unsigned*)(lds_all + TABA_OFF))[i * 256 + tid] = valid ? (unsigned)(a >> 1) * (unsigned)(D * 2) : 0u; ((LAS float*)(lds_all + TABB_OFF))[i * 256 + tid] = valid ? rs[a >> 1] : 0.f; }
            else { ((LAS int*)(lds_all + TABA_OFF))[i * 256 + tid] = a; ((LAS float*)(lds_all + TABB_OFF))[i * 256 + tid] = valid ? wts[a] : 0.f; }
        }
    }
    __syncthreads();
    return ntiles;
}
constexpr int CWX_CNT = 1024;
constexpr int CWX_BAR = 4096;
constexpr int SEQ_FINAL = 41;
#ifndef FK_PHMASK
#define FK_PHMASK 0x7fff
#endif
#define PH_ON(k) (((FK_PHMASK) >> (k)) & 1)

__global__ void __launch_bounds__(NTHREADS, 2) fwd(Ptrs P, int li) {
    extern __shared__ __attribute__((aligned(16))) unsigned char lds_raw[];
    LAS unsigned char* lds = (LAS unsigned char*)lds_raw;
    const int tid = threadIdx.x, lane_k = tid & 63, wave_k = __builtin_amdgcn_readfirstlane(tid >> 6);
    const int G_k = gridDim.x, bid_k = blockIdx.x;
    const int vcu_k = (G_k % 8 == 0) ? (bid_k % 8) * (G_k / 8) + bid_k / 8 : bid_k;
#define PHV int lane = lane_k, wave = wave_k, G = G_k, bid = bid_k, vcu = vcu_k; asm volatile("" : "+v"(lane), "+s"(wave), "+s"(G), "+s"(bid), "+s"(vcu)); (void)lane; (void)wave; (void)G; (void)bid; (void)vcu;
    volatile LAS unsigned* MISC = (volatile LAS unsigned*)(lds + MISC_OFF);
    if (tid < 16) MISC[tid] = 0u;
    __syncthreads();
    const int lo = P.ph_lo, hi = P.ph_hi;
    XcdBarrier bar; bar.bar = (unsigned*)(P.ws + WS_CTL) + CWX_BAR + li * XCD_BAR_WORDS; bar.x = 0; bar.st = MISC + 8;
    if (hi - lo > 1) bar = xcd_barrier_post((unsigned*)(P.ws + WS_CTL) + CWX_BAR + li * XCD_BAR_WORDS, MISC + 8);
#define IN(s) (lo <= (s) && (s) < hi)
#define BAR_AFTER(s) do { if (hi > (s) + 1) xcd_barrier(bar); } while (0)
#define KA (*kargs())
#define WSP(off) (KA.ws + (off))
#define WIN ((bf16_t*)WSP(WS_WIN))
#define WLR ((bf16_t*)WSP(WS_WLR))
#define WOUT ((bf16_t*)WSP(WS_WOUT))
#define WPOOL ((bf16_t*)WSP(WS_WPOOL))
#define WR ((bf16_t*)WSP(WS_WR))
#define WPG ((bf16_t*)WSP(WS_WPG))
#define WPP ((bf16_t*)WSP(WS_WPP))
#define WGU ((bf16_t*)WSP(WS_WGU))
#define WD ((bf16_t*)WSP(WS_WD))
#define PB ((bf16_t*)WSP(WS_PB))
#define HB ((bf16_t*)WSP(WS_HB))
#define PROJ ((bf16_t*)WSP(WS_PROJ))
#define OG ((bf16_t*)WSP(WS_OG))
#define PP ((bf16_t*)WSP(WS_PP))
#define H2 ((bf16_t*)WSP(WS_H2))
#define Y ((bf16_t*)WSP(WS_Y))
#define LIST ((int*)WSP(WS_LIST))
#define RS ((float*)WSP(WS_RS))
#define LR ((float*)WSP(WS_LR))
#define SSP ((float*)WSP(WS_SSP))
#define WTS ((float*)WSP(WS_WTS))
#define CNT ((unsigned*)WSP(WS_CTL) + CWX_CNT)

    if (PH_ON(0) && IN(0)) { PHV prologue(KA, lds, vcu, G, wave, lane); BAR_AFTER(0); }

    for (int L = 0; L < 4; ++L) {
        const int base = 1 + 10 * L, j = L >> 1;

        if ((L & 1) == 0) {
            if (PH_ON(1) && IN(base + 0)) { PHV np_pass<0>(lds, (L == 0) ? KA.in[0] : KA.out, nullptr, HB, RS, WLR + (size_t)j * 2 * 16 * D, LR, nullptr, nullptr, nullptr, nullptr, nullptr, nullptr, G, wave, lane); BAR_AFTER(base + 0); }
            if (PH_ON(2) && IN(base + 1)) { PHV DenseSched S; S.init(HB, D, WIN + (size_t)j * NPROJ * D, T, NPROJ, D, G, bid, 0); EpiBf16Rs E{PROJ, NPROJ, RS}; gemm_phase(lds, D, D, S, E); BAR_AFTER(base + 1); }
            if (PH_ON(3) && IN(base + 2)) { PHV gla_phase(lds, PROJ, LR, KA.in[7] + (size_t)j * 16 * 512, KA.in[8] + j * 512, OG, SSP, vcu, G, wave, lane); BAR_AFTER(base + 2); }
            if (PH_ON(4) && IN(base + 3)) { PHV e1_pass(OG, SSP, G); BAR_AFTER(base + 3); }
            if (PH_ON(5) && IN(base + 4)) { PHV DenseSched S; S.init(OG, D, WOUT + (size_t)j * D * D, T, D, D, G, bid, 0); EpiResid E{(L == 0) ? KA.in[0] : KA.out, KA.out}; gemm_phase(lds, D, D, S, E); BAR_AFTER(base + 4); }
        } else {
            if (PH_ON(6) && IN(base + 0)) { PHV pool_pass(lds, KA.out, PROJ, G, wave, lane); BAR_AFTER(base + 0); }
            if (PH_ON(7) && IN(base + 1)) { PHV DenseSched S; S.init(PROJ, D, WPOOL + (size_t)j * D * 256, T, D, 256, G, bid, 256); EpiPool E{KA.out, KA.out, KA.in[12] + j * D, KA.in[13] + j * D}; gemm_phase(lds, 256, D, S, E); BAR_AFTER(base + 1); }
        }
        if (PH_ON(8) && IN(base + 5)) { PHV np_pass<1>(lds, KA.out, nullptr, HB, RS, WR + (size_t)L * 2 * 80 * D, nullptr, nullptr, KA.in[15] + L * 8, KA.in[17] + L * 64, CNT + L * 64, LIST, WTS, G, wave, lane); BAR_AFTER(base + 5); }
        if (IN(base + 6)) {
            if (PH_ON(9)) { PHV DenseSched S; S.init(PB + (size_t)L * T * PLE, PLE, WPP + (size_t)L * D * PLE, T, D, PLE, G, bid, 0); EpiBf16Rs E{PP, D, nullptr}; gemm_phase(lds, PLE, PLE, S, E); }
            if (PH_ON(10)) { PHV const int ntiles = moe_tables<true>(lds, CNT + L * 64, LIST, RS, WTS, G, vcu);
              MoeSched<true> S; S.A = HB; S.W = WGU + (size_t)L * NE * 768 * D; S.G = G; S.c = vcu; S.ntiles = ntiles; S.tpre = (const LAS int*)(lds + TAB_OFF);
              EpiUp E{H2}; gemm_phase(lds, D, D, S, E); }
            BAR_AFTER(base + 6);
        }
        if (PH_ON(11) && IN(base + 7)) { PHV
            const int ntiles = moe_tables<false>(lds, CNT + L * 64, LIST, RS, WTS, G, vcu);
            MoeSched<false> S; S.A = H2; S.W = WD + (size_t)L * NE * D * DFF; S.G = G; S.c = vcu; S.ntiles = ntiles; S.tpre = (const LAS int*)(lds + TAB_OFF);
            EpiDown E{Y}; gemm_phase(lds, DFF, DFF, S, E);
            BAR_AFTER(base + 7);
        }
        if (PH_ON(12) && IN(base + 8)) { PHV np_pass<2>(lds, KA.out, KA.out, HB, RS, nullptr, nullptr, Y, nullptr, nullptr, nullptr, nullptr, nullptr, G, wave, lane); BAR_AFTER(base + 8); }
        if (PH_ON(13) && IN(base + 9)) { PHV DenseSched S; S.init(HB, D, WPG + (size_t)L * D * D, T, D, D, G, bid, 0); EpiPle E{KA.out, KA.out, RS, PP}; gemm_phase(lds, D, D, S, E); BAR_AFTER(base + 9); }
    }
    if (PH_ON(14) && IN(SEQ_FINAL)) { PHV final_norm(KA.out, KA.in[5], KA.out, G, wave, lane); }
#undef IN
#undef BAR_AFTER
}
}


#ifndef FK_DIAG
#define FK_DIAG 0
#endif
#if FK_DIAG
__global__ void __launch_bounds__(256) k_cksum(const unsigned* __restrict__ p, size_t nwords4, unsigned long long* slot) {
    unsigned long long s = 0;
    for (size_t i = (size_t)blockIdx.x * 256 + threadIdx.x; i < nwords4; i += (size_t)gridDim.x * 256) { const uint4 v = ((const uint4*)p)[i]; s += (unsigned long long)v.x + v.y + v.z + v.w; }
    for (int o = 32; o; o >>= 1) s += __shfl_xor(s, o);
    if ((threadIdx.x & 63) == 0) atomicAdd(slot, s);
}
__global__ void __launch_bounds__(256) k_verdict(const unsigned long long* cs, int nph, float* out, size_t n) {
    __shared__ float code;
    if (threadIdx.x == 0) { int first = -1; for (int s = 0; s < nph; ++s) if (cs[s] != cs[64 + s] && first < 0) first = s; code = (first < 0) ? 100.0f : (float)(3 + first); }
    __syncthreads();
    for (size_t i = (size_t)blockIdx.x * 256 + threadIdx.x; i < n; i += (size_t)gridDim.x * 256) out[i] = code;
}
#endif
#ifndef FK_PER_PHASE
#define FK_PER_PHASE 0
#endif
extern "C" void kernel_launch(void* const* d_in, const int* in_sizes, int n_in, void* d_out, int out_size, void* d_ws, size_t ws_size, hipStream_t stream) {
    using namespace fk;
    static int grid = 0;
    if (grid == 0) {
        if (n_in != 23 || in_sizes[0] != T * D || out_size != T * D || ws_size < WS_END) { fprintf(stderr, "kernel_launch: unexpected shapes (n_in %d, out %d, ws %zu)\n", n_in, out_size, ws_size); grid = -1; return; }
        int dev = 0, cus = 0, per_cu = 0;
        if (hipGetDevice(&dev) != hipSuccess || hipDeviceGetAttribute(&cus, hipDeviceAttributeMultiprocessorCount, dev) != hipSuccess) { grid = -1; return; }
        if (hipFuncSetAttribute((const void*)fwd, hipFuncAttributeMaxDynamicSharedMemorySize, LDS_BYTES) != hipSuccess) { fprintf(stderr, "kernel_launch: hipFuncSetAttribute failed\n"); grid = -1; return; }
        if (hipOccupancyMaxActiveBlocksPerMultiprocessor(&per_cu, (const void*)fwd, NTHREADS, LDS_BYTES) != hipSuccess || per_cu < 1) fprintf(stderr, "kernel_launch: occupancy query says %d\n", per_cu);
        (void)hipGetLastError();
        grid = cus;
    }
    if (grid < 0) return;
    (void)hipMemsetAsync((char*)d_ws + WS_CTL, 0, CTL_ZERO_BYTES, stream);
    Ptrs P; memset(&P, 0, sizeof(P));
    for (int i = 0; i < 23; ++i) P.in[i] = (const float*)d_in[i];
    P.out = (float*)d_out; P.ws = (unsigned char*)d_ws;
#if FK_PER_PHASE
    int li = 0;
#if FK_DIAG
    unsigned long long* cs = (unsigned long long*)((char*)d_ws + WS_END);
    (void)hipMemsetAsync(cs, 0, 2 * 64 * 8, stream);
    for (int run = 0; run < 2; ++run) {
    if (run == 0) (void)hipMemsetAsync((char*)d_ws + 2 * MiB, 0xAA, WS_END - 2 * MiB, stream);
    (void)hipMemsetAsync((char*)d_ws + WS_CTL, 0, CTL_ZERO_BYTES, stream);
    int nph = 0;
#endif
    for (int s = 0; s <= SEQ_FINAL; ++s) {
        const int L = (s - 1) / 10, k = (s - 1) % 10;
        if (s >= 1 && s < SEQ_FINAL && (L & 1) == 1 && k >= 2 && k <= 4) continue;
        P.ph_lo = s; P.ph_hi = s + 1;
        hipLaunchKernelGGL(fwd, dim3(grid), dim3(NTHREADS), LDS_BYTES, stream, P, li);
#if FK_DIAG
        {
            struct Reg { size_t off, bytes; int is_out; };
            Reg regs[4]; int nr = 0;
            auto W = [&](size_t off, size_t bytes) { regs[nr++] = Reg{off, bytes, 0}; };
            auto O = [&]() { regs[nr++] = Reg{0, (size_t)T * D * 4, 1}; };
            if (s == 0) W(WS_WIN, WS_HB - WS_WIN);
            else if (s == SEQ_FINAL) O();
            else if ((L & 1) == 0 && k == 0) { W(WS_HB, 64 * MiB); W(WS_RS, MiB / 8); W(WS_LR, 2 * MiB); }
            else if ((L & 1) == 0 && k == 1) W(WS_PROJ, 192 * MiB);
            else if ((L & 1) == 0 && k == 2) { W(WS_OG, 64 * MiB); W(WS_SSP, 4 * MiB); }
            else if ((L & 1) == 0 && k == 3) W(WS_OG, 64 * MiB);
            else if ((L & 1) == 0 && k == 4) O();
            else if ((L & 1) == 1 && k == 0) W(WS_PROJ, 64 * MiB);
            else if ((L & 1) == 1 && k == 1) O();
            else if (k == 5) { W(WS_HB, 64 * MiB); W(WS_RS, MiB / 8); W(WS_WTS, MiB / 4); }
            else if (k == 6) W(WS_PP, 64 * MiB);
            else if (k == 7) W(WS_Y, 128 * MiB);
            else if (k == 8) { O(); W(WS_HB, 64 * MiB); W(WS_RS, MiB / 8); }
            else if (k == 9) O();
            for (int q = 0; q < nr; ++q)
                hipLaunchKernelGGL(k_cksum, dim3(2048), dim3(256), 0, stream, regs[q].is_out ? (const unsigned*)d_out : (const unsigned*)((char*)d_ws + regs[q].off), regs[q].bytes / 16, cs + run * 64 + nph);
        }
        ++nph;
#endif
    }
#if FK_DIAG
    if (run == 1) hipLaunchKernelGGL(k_verdict, dim3(1024), dim3(256), 0, stream, cs, nph, (float*)d_out, (size_t)T * D);
    }
#endif
#else
    P.ph_lo = 0; P.ph_hi = SEQ_FINAL + 1;
    hipLaunchKernelGGL(fwd, dim3(grid), dim3(NTHREADS), LDS_BYTES, stream, P, 0);
#endif
}
```

```cpp
#include <hip/hip_runtime.h>
#include <stdint.h>
#include <stdio.h>
#include <string.h>
namespace fk {
#define LAS __attribute__((address_space(3)))
#define GAS __attribute__((address_space(1)))
typedef unsigned short bf16_t;
typedef short bf16x8 __attribute__((ext_vector_type(8)));
typedef float f32x4 __attribute__((ext_vector_type(4)));
typedef float f32x2 __attribute__((ext_vector_type(2)));
typedef unsigned u32x4 __attribute__((ext_vector_type(4)));
typedef unsigned u32x2 __attribute__((ext_vector_type(2)));

constexpr int T = 32768, D = 1024, SEQ = 2048, NB = 16, DFF = 384, NE = 64, PLE = 256, GIN = 3088, NPROJ = 3072;
constexpr int CAP = 65536;
constexpr float EPS = 1e-6f;
constexpr int NWAVES = 8, NTHREADS = 512;

constexpr size_t MiB = (size_t)1 << 20;
constexpr size_t WS_CTL = 0, CTL_ZERO_BYTES = 1 * MiB;
constexpr size_t WS_WIN = 2 * MiB;
constexpr size_t WS_WLR = 14 * MiB;
constexpr size_t WS_WOUT = 15 * MiB;
constexpr size_t WS_WPOOL = 19 * MiB;
constexpr size_t WS_WR = 20 * MiB;
constexpr size_t WS_WPG = 22 * MiB;
constexpr size_t WS_WPP = 30 * MiB;
constexpr size_t WS_WGU = 32 * MiB;
constexpr size_t WS_WD = 416 * MiB;
constexpr size_t WS_PB = 608 * MiB;
constexpr size_t WS_HB = 672 * MiB;
constexpr size_t WS_PROJ = 736 * MiB;
constexpr size_t WS_OG = 928 * MiB;
constexpr size_t WS_PP = 992 * MiB;
constexpr size_t WS_H2 = 1056 * MiB;
constexpr size_t WS_Y = 1116 * MiB;
constexpr size_t WS_LIST = 1244 * MiB;
constexpr size_t WS_RS = 1260 * MiB;
constexpr size_t WS_LR = 1261 * MiB;
constexpr size_t WS_SSP = 1263 * MiB;
constexpr size_t WS_WTS = 1267 * MiB;
constexpr size_t WS_END = 1268 * MiB;
constexpr int CW_BAR = 4096;
constexpr int CW_CNT = 8192;

constexpr int STAGE_BYTES = 131072;
constexpr int TAB_OFF = STAGE_BYTES;
constexpr int MAXU = 6;
constexpr int TABA_OFF = TAB_OFF + 512, TABB_OFF = TABA_OFF + MAXU * 1024;
constexpr int MISC_OFF = TABB_OFF + MAXU * 1024;
constexpr int LDS_BYTES = MISC_OFF + 256;
static_assert(LDS_BYTES <= 160 * 1024, "LDS");

#define LDS_WAIT() asm volatile("s_waitcnt lgkmcnt(0)" ::: "memory")
#define VM_WAIT() asm volatile("s_waitcnt vmcnt(0)" ::: "memory")
typedef __bf16 bf16x2_t __attribute__((ext_vector_type(2)));
__device__ __forceinline__ unsigned cvt_pk_bf16(float lo, float hi) { const bf16x2_t b = __builtin_convertvector((f32x2){lo, hi}, bf16x2_t); return __builtin_bit_cast(unsigned, b); }
__device__ __forceinline__ float bf_lo(unsigned w) { return __uint_as_float(w << 16); }
__device__ __forceinline__ float bf_hi(unsigned w) { return __uint_as_float(w & 0xffff0000u); }
__device__ __forceinline__ float wave_sum(float v) {
#pragma unroll
    for (int o = 1; o < 64; o <<= 1) v += __shfl_xor(v, o);
    return v;
}
__device__ __forceinline__ float fsigmoid(float x) { return __builtin_amdgcn_rcpf(1.0f + __expf(-x)); }
__device__ __forceinline__ float fsilu(float x) { return x * fsigmoid(x); }

#define XB_TMO      128
#define XB_XCNT(j)  (256  + 64 * (j))
#define XB_XSUB(j)  (1280 + 64 * (j))
#define XB_XGEN(j)  (2304 + 64 * (j))
#define XB_TOP      3328
#define XB_TOPGEN   3392
#define XCD_BAR_WORDS 3456
#define XB_SPIN_CAP (1u << 18)
__device__ __forceinline__ unsigned xb_ld(unsigned* p)              { return __hip_atomic_load(p, __ATOMIC_RELAXED, __HIP_MEMORY_SCOPE_AGENT); }
__device__ __forceinline__ unsigned xb_add(unsigned* p, unsigned v) { return __hip_atomic_fetch_add(p, v, __ATOMIC_RELAXED, __HIP_MEMORY_SCOPE_AGENT); }
__device__ __forceinline__ unsigned xb_xcc_id() { return (unsigned)__builtin_amdgcn_s_getreg((3 << 11) | 20) & 0xFu; }
#define XB_SPIN(cond, bar) do { unsigned _sp = 0; while (cond) { __builtin_amdgcn_s_sleep(1); \
    if ((++_sp & 255u) == 0u) { if (xb_ld(&(bar)[XB_TMO])) break; if (_sp > XB_SPIN_CAP) { atomicAdd(&(bar)[XB_TMO], 1u); break; } } } } while (0)
struct XcdBarrier { unsigned* bar; unsigned x; volatile LAS unsigned* st; };
__device__ __forceinline__ XcdBarrier xcd_barrier_post(unsigned* bar, volatile LAS unsigned* st) {
    XcdBarrier b; b.bar = bar; b.x = xb_xcc_id(); b.st = st;
    if (threadIdx.x == 0) (void)xb_add(&bar[XB_XCNT(b.x)], 1u);
    return b;
}
__device__ __forceinline__ void xcd_barrier_complete(unsigned* bar, unsigned x, unsigned& nloc, unsigned& nx) {
    const unsigned G = gridDim.x * gridDim.y * gridDim.z;
    unsigned sum, cnt, mine, sp = 0u;
    for (;;) {
        sum = 0u; cnt = 0u; mine = 0u;
#pragma unroll
        for (unsigned j = 0; j < 16; ++j) { const unsigned c = xb_ld(&bar[XB_XCNT(j)]); sum += c; cnt += (c > 0u) ? 1u : 0u; mine = (j == x) ? c : mine; }
        if (sum == G) break;
        __builtin_amdgcn_s_sleep(1);
        if ((++sp & 255u) == 0u) { if (xb_ld(&bar[XB_TMO])) break; if (sp > XB_SPIN_CAP) { atomicAdd(&bar[XB_TMO], 1u); break; } }
    }
    nloc = mine > 0u ? mine : 1u; nx = cnt > 0u ? cnt : 1u;
}
__device__ __forceinline__ void xcd_barrier(const XcdBarrier& b) {
    asm volatile("s_waitcnt vmcnt(0)" ::: "memory");
    __syncthreads();
    if (threadIdx.x == 0) {
        unsigned* bar = b.bar;
        __builtin_amdgcn_s_waitcnt(0);
        unsigned nloc = b.st[0], nx = b.st[1];
        if (nloc == 0u) { xcd_barrier_complete(bar, b.x, nloc, nx); b.st[0] = nloc; b.st[1] = nx; }
        const unsigned old = xb_add(&bar[XB_XSUB(b.x)], 1u);
        const unsigned gen = old / nloc;
        if (old + 1u == (gen + 1u) * nloc) {
            __builtin_amdgcn_fence(__ATOMIC_RELEASE, "agent");
            asm volatile("s_waitcnt vmcnt(0)" ::: "memory");
            const unsigned og = xb_add(&bar[XB_TOP], 1u);
            const unsigned tg = og / nx;
            if (og + 1u == (tg + 1u) * nx) xb_add(&bar[XB_TOPGEN], 1u);
            else XB_SPIN(xb_ld(&bar[XB_TOPGEN]) == tg, bar);
            __builtin_amdgcn_fence(__ATOMIC_ACQUIRE, "agent");
            xb_add(&bar[XB_XGEN(b.x)], 1u);
            asm volatile("s_waitcnt vmcnt(0)" ::: "memory");
        } else {
            XB_SPIN(xb_ld(&bar[XB_XGEN(b.x)]) == gen, bar);
            __builtin_amdgcn_fence(__ATOMIC_ACQUIRE, "agent");
            asm volatile("s_waitcnt vmcnt(0)" ::: "memory");
        }
    }
    __syncthreads();
}

constexpr int BM = 256, BK = 64, HALF = 128, HTB = HALF * BK * 2, NXCD = 8, WGM = 8;
__device__ __forceinline__ int lds_byte(int r, int c) { const int st = (r >> 4) * 2 + (c >> 5), rr = r & 15, cc = c & 31, ob = rr * 64 + cc * 2; return st * 1024 + (ob ^ (((ob >> 9) & 1) << 5)); }
__device__ __forceinline__ void stage_rc(int b, int& R, int& C) { const int st = b / 1024, sb = b % 1024, swz = sb ^ (((sb >> 9) & 1) << 5); R = (st >> 1) * 16 + swz / 64; C = (st & 1) * 32 + (swz % 64) / 2; }
__device__ __forceinline__ int perm32(int rho) { const int n = rho >> 4, i = rho & 15; return 8 * (i >> 2) + 4 * n + (i & 3); }

struct Unit { int pm, pn, ui, aux; };

struct DenseSched {
    static constexpr bool GATHER = false;
    const bf16_t* A; const bf16_t* Bt; int lda, K, acol_per_pn;
    int nM, nN, nwg, G, c;
    __device__ __forceinline__ void init(const bf16_t* A_, int lda_, const bf16_t* Bt_, int M, int N, int K_, int G_, int c_, int acol_per_pn_) {
        A = A_; Bt = Bt_; lda = lda_; K = K_; acol_per_pn = acol_per_pn_; nM = M / BM; nN = N / BM; nwg = nM * nN; G = G_; c = c_; }
    __device__ __forceinline__ bool next(int i, Unit& u) const {
        const long L = (long)i * G + c; if (L >= nwg) return false;
        int wgid = (int)L; { const int q = nwg / NXCD, r = nwg % NXCD, xcd = wgid % NXCD, off = wgid / NXCD; wgid = (xcd < r ? xcd * (q + 1) : r * (q + 1) + (xcd - r) * q) + off; }
        const int nig = WGM * nN, gid = wgid / nig, fm = gid * WGM, gsz = (nM - fm) < WGM ? (nM - fm) : WGM;
        u.pm = fm + ((wgid % nig) % gsz); u.pn = (wgid % nig) / gsz; u.ui = i; u.aux = 0; return true;
    }
    __device__ __forceinline__ const char* a_base(const Unit& u) const { return (const char*)A + ((size_t)u.pm * BM * lda + (size_t)u.pn * acol_per_pn) * 2; }
    __device__ __forceinline__ const char* b_base(const Unit& u) const { return (const char*)Bt + (size_t)u.pn * BM * K * 2; }
    __device__ __forceinline__ void rows(const Unit&, LAS unsigned char*, unsigned (&)[4]) const {}
};
template <bool UP> struct MoeSched {
    static constexpr bool GATHER = UP;
    static constexpr int NTN = UP ? 3 : 4;
    const bf16_t* A; const bf16_t* W; int G, c, ntiles;
    const LAS int* tpre;
    __device__ __forceinline__ bool next(int i, Unit& u) const {
        const int L = i * G + c; if (L >= ntiles * NTN || i >= MAXU) return false;
        const int tile = L / NTN;
        u.pm = tile; u.pn = L - tile * NTN; u.ui = i; u.aux = __builtin_amdgcn_readfirstlane(tpre[80 + i]); return true;
    }
    __device__ __forceinline__ bool next_search(int i, Unit& u) const {
        const int L = i * G + c; if (L >= ntiles * NTN || i >= MAXU) return false;
        const int tile = L / NTN; int e = 0;
        for (int x = 1; x < NE; ++x) e += (tpre[x] <= tile) ? 1 : 0;
        u.pm = tile; u.pn = L - tile * NTN; u.ui = i; u.aux = e; return true;
    }
    __device__ __forceinline__ const char* a_base(const Unit& u) const { return UP ? (const char*)A : (const char*)A + (size_t)u.pm * BM * DFF * 2; }
    __device__ __forceinline__ const char* b_base(const Unit& u) const {
        return UP ? (const char*)W + ((size_t)u.aux * 768 + (size_t)u.pn * BM) * D * 2 : (const char*)W + ((size_t)u.aux * D + (size_t)u.pn * BM) * DFF * 2; }
    __device__ __forceinline__ void rows(const Unit& u, LAS unsigned char* lds_all, unsigned (&v)[4]) const {
        if (UP) { const LAS unsigned* tab = (const LAS unsigned*)(lds_all + TABA_OFF) + u.ui * 256;
#pragma unroll
            for (int i = 0; i < 2; ++i) { int R, C; int tx = threadIdx.x; asm volatile("" : "+v"(tx)); stage_rc(tx * 16 + i * 8192, R, C);
                v[i] = tab[R] + (unsigned)C * 2u; v[2 + i] = tab[HALF + R] + (unsigned)C * 2u; } }
    }
};

#define PG8_SA(b, h) (((b) * 2 + (h)) * HTB)
#define PG8_SB(b, h) ((4 + (b) * 2 + (h)) * HTB)
__device__ __forceinline__ void glds16(const void* gbase, unsigned voff, unsigned lds_dst) {
    unsigned keep;
    asm volatile("s_mov_b32 %0, m0\n\ts_mov_b32 m0, %3\n\ts_nop 0\n\tglobal_load_lds_dwordx4 %1, %2\n\ts_mov_b32 m0, %0" : "=&s"(keep) : "v"(voff), "s"(gbase), "s"(lds_dst) : "memory");
}
#define PG8_STAGE2(bufoff, gbase, o0, o1) do { glds16((gbase), (o0), (unsigned)(bufoff) + ldsw); glds16((gbase), (o1), (unsigned)(bufoff) + ldsw + 8192u); } while (0)
#define PG8_LDA(dst, b, h) do { _Pragma("unroll") for (int m = 0; m < 4; ++m) _Pragma("unroll") for (int k = 0; k < 2; ++k) dst[m][k] = *(const LAS bf16x8*)(lds + PG8_SA(b, h) + aoff + m * 2048 + k * 1024); } while (0)
#define PG8_LDB(dst, b, h) do { _Pragma("unroll") for (int n = 0; n < 2; ++n) _Pragma("unroll") for (int k = 0; k < 2; ++k) dst[n][k] = *(const LAS bf16x8*)(lds + PG8_SB(b, h) + boff + n * 2048 + k * 1024); } while (0)
#define PG8_MMA(ai, bj, At, Bt) do { __builtin_amdgcn_s_setprio(1); _Pragma("unroll") for (int m = 0; m < 4; ++m) _Pragma("unroll") for (int n = 0; n < 2; ++n) _Pragma("unroll") for (int k = 0; k < 2; ++k) \
        acc[ai][bj][m][n] = __builtin_amdgcn_mfma_f32_16x16x32_bf16(Bt[n][k], At[m][k], acc[ai][bj][m][n], 0, 0, 0); __builtin_amdgcn_s_setprio(0); } while (0)
#define PG8_WAIT_V(n) asm volatile("s_waitcnt vmcnt(" #n ")" ::: "memory")
#define PG8_WAIT_L(n) asm volatile("s_waitcnt lgkmcnt(" #n ")" ::: "memory")
#define PG8_BAR __builtin_amdgcn_s_barrier()
#define PG8_SCHED __builtin_amdgcn_sched_barrier(0)

template <class Epi, class Sched>
__device__ __forceinline__ void gemm_phase(LAS unsigned char* lds_all, const int K, const int lda, const Sched& S, const Epi& E) {
    LAS unsigned char* lds = lds_all;
    int tid_ = threadIdx.x; asm volatile("" : "+v"(tid_));
    const int tid = tid_, wid = __builtin_amdgcn_readfirstlane(tid >> 6), lane = tid & 63, wr = wid >> 2, wc = wid & 3, fr = lane & 15, fq = lane >> 4;
    const int nt = K / BK;
    unsigned vB[2], vA[4];
#pragma unroll
    for (int i = 0; i < 2; ++i) { int Rr, Cc; stage_rc(tid * 16 + i * 8192, Rr, Cc); const int Rb = Epi::PERM ? ((Rr & ~31) + perm32(Rr & 31)) : Rr;
        vB[i] = (unsigned)(Rb * K + Cc) * 2u; vA[i] = (unsigned)(Rr * lda + Cc) * 2u; vA[2 + i] = vA[i] + (unsigned)(HALF * lda) * 2u; }
    const size_t kstep = (size_t)(BK * 2);
    const size_t hstepB = (size_t)HALF * K * 2;
    const unsigned ldsw = (unsigned)wid * 1024u;
    const int aoff = lds_byte(wr * 64 + fr, fq * 8), boff = lds_byte(wc * 32 + fr, fq * 8);
    Unit cur, nxt; int ui = 0;
    if (!S.next(0, cur)) return;
    f32x4 acc[2][2][4][2];
#pragma unroll
    for (int a = 0; a < 2; ++a)
#pragma unroll
        for (int b = 0; b < 2; ++b)
#pragma unroll
            for (int m = 0; m < 4; ++m)
#pragma unroll
                for (int n = 0; n < 2; ++n) acc[a][b][m][n] = (f32x4){0.f, 0.f, 0.f, 0.f};
    bf16x8 At[4][2], B0[2][2], B1[2][2];
    const char* cA = S.a_base(cur); const char* cB = S.b_base(cur);
    if constexpr (Sched::GATHER) S.rows(cur, lds_all, vA);
    PG8_STAGE2(PG8_SB(0, 0), cB, vB[0], vB[1]); PG8_STAGE2(PG8_SB(0, 1), cB + hstepB, vB[0], vB[1]); PG8_STAGE2(PG8_SA(0, 0), cA, vA[0], vA[1]); PG8_STAGE2(PG8_SA(0, 1), cA, vA[2], vA[3]);
    if (wr == 1) PG8_BAR;
    PG8_WAIT_V(2); PG8_BAR;
    PG8_STAGE2(PG8_SB(1, 0), cB + kstep, vB[0], vB[1]); PG8_STAGE2(PG8_SA(1, 0), cA + kstep, vA[0], vA[1]); PG8_STAGE2(PG8_SB(1, 1), cB + hstepB + kstep, vB[0], vB[1]);
    PG8_WAIT_V(6); PG8_BAR;
    for (;;) {
        const bool has_next = S.next(ui + 1, nxt);
        const char* nA = has_next ? S.a_base(nxt) : cA; const char* nB = has_next ? S.b_base(nxt) : cB;
#pragma unroll 1
        for (int t = 0; t < nt; t += 2) {
            const bool last = (t == nt - 2);
            const char* a1 = cA + (size_t)(t + 1) * kstep;
            const char* a2 = last ? nA : cA + (size_t)(t + 2) * kstep; const char* b2 = last ? nB : cB + (size_t)(t + 2) * kstep;
            const char* a3 = a2 + kstep; const char* b3 = b2 + kstep;
            PG8_LDB(B0, 0, 0); PG8_LDB(B1, 0, 1); PG8_SCHED; PG8_LDA(At, 0, 0); PG8_STAGE2(PG8_SA(1, 1), a1, vA[2], vA[3]);
            PG8_WAIT_V(8); PG8_WAIT_L(0); PG8_BAR; PG8_MMA(0, 0, At, B0); PG8_MMA(0, 1, At, B1); PG8_BAR; PG8_SCHED;
            if constexpr (Sched::GATHER) { if (last && has_next) S.rows(nxt, lds_all, vA); }
            PG8_LDA(At, 0, 1); PG8_STAGE2(PG8_SB(0, 0), b2, vB[0], vB[1]); PG8_STAGE2(PG8_SB(0, 1), b2 + hstepB, vB[0], vB[1]); PG8_STAGE2(PG8_SA(0, 0), a2, vA[0], vA[1]);
            PG8_WAIT_V(8); PG8_WAIT_L(0); PG8_BAR; PG8_MMA(1, 0, At, B0); PG8_MMA(1, 1, At, B1); PG8_BAR; PG8_SCHED;
            PG8_LDB(B0, 1, 0); PG8_LDB(B1, 1, 1); PG8_SCHED; PG8_LDA(At, 1, 0); PG8_STAGE2(PG8_SA(0, 1), a2, vA[2], vA[3]);
            PG8_WAIT_V(8); PG8_WAIT_L(0); PG8_BAR; PG8_MMA(0, 0, At, B0); PG8_MMA(0, 1, At, B1); PG8_BAR; PG8_SCHED;
            PG8_LDA(At, 1, 1); PG8_STAGE2(PG8_SB(1, 0), b3, vB[0], vB[1]); PG8_STAGE2(PG8_SB(1, 1), b3 + hstepB, vB[0], vB[1]); PG8_STAGE2(PG8_SA(1, 0), a3, vA[0], vA[1]);
            PG8_WAIT_V(8); PG8_WAIT_L(0); PG8_BAR; PG8_MMA(1, 0, At, B0); PG8_MMA(1, 1, At, B1); PG8_BAR; PG8_SCHED;
        }
        if (wr == 0) PG8_BAR;
        E(acc, cur, wr, wc, fr, fq, lds_all);
        if (!has_next) break;
#pragma unroll
        for (int a = 0; a < 2; ++a)
#pragma unroll
            for (int b = 0; b < 2; ++b)
#pragma unroll
                for (int m = 0; m < 4; ++m)
#pragma unroll
                    for (int n = 0; n < 2; ++n) acc[a][b][m][n] = (f32x4){0.f, 0.f, 0.f, 0.f};
        cur = nxt; cA = nA; cB = nB; ++ui;
        if (wr == 1) PG8_BAR;
    }
    PG8_WAIT_V(0);
    PG8_BAR;
}

__device__ __forceinline__ u32x4 pack8(const f32x4 v0, const f32x4 v1) { u32x4 w; w.x = cvt_pk_bf16(v0[0], v0[1]); w.y = cvt_pk_bf16(v0[2], v0[3]); w.z = cvt_pk_bf16(v1[0], v1[1]); w.w = cvt_pk_bf16(v1[2], v1[3]); return w; }

struct EpiBf16Rs {
    static constexpr bool PERM = true;
    bf16_t* O; int ldc; const float* rs;
    __device__ __forceinline__ void operator()(const f32x4 (&acc)[2][2][4][2], const Unit& u, int wr, int wc, int fr, int fq, LAS unsigned char*) const {
        const int row0 = u.pm * BM + wr * 64 + fr, col0 = u.pn * BM + wc * 32 + 8 * fq;
#pragma unroll
        for (int ai = 0; ai < 2; ++ai)
#pragma unroll
            for (int m = 0; m < 4; ++m) { const int row = row0 + ai * HALF + m * 16; const float s = rs ? rs[row] : 1.0f; bf16_t* rowp = O + (size_t)row * ldc + col0;
#pragma unroll
                for (int bj = 0; bj < 2; ++bj) *(u32x4*)(rowp + bj * HALF) = pack8(acc[ai][bj][m][0] * s, acc[ai][bj][m][1] * s); }
    }
};
struct EpiResid {
    static constexpr bool PERM = false;
    const float* hin; float* out;
    __device__ __forceinline__ void operator()(const f32x4 (&acc)[2][2][4][2], const Unit& u, int wr, int wc, int fr, int fq, LAS unsigned char*) const {
        const int row0 = u.pm * BM + wr * 64 + fr, col0 = u.pn * BM + wc * 32 + 4 * fq;
#pragma unroll
        for (int ai = 0; ai < 2; ++ai)
#pragma unroll
            for (int m = 0; m < 4; ++m) { const size_t off = (size_t)(row0 + ai * HALF + m * 16) * D + col0;
#pragma unroll
                for (int bj = 0; bj < 2; ++bj)
#pragma unroll
                    for (int n = 0; n < 2; ++n) { const f32x4 b = *(const f32x4*)(hin + off + bj * HALF + n * 16); *(f32x4*)(out + off + bj * HALF + n * 16) = b + acc[ai][bj][m][n]; } }
    }
};
struct EpiPool {
    static constexpr bool PERM = false;
    const float* hin; float* out; const float* bias; const float* sc;
    __device__ __forceinline__ void operator()(const f32x4 (&acc)[2][2][4][2], const Unit& u, int wr, int wc, int fr, int fq, LAS unsigned char*) const {
        const int row0 = u.pm * BM + wr * 64 + fr, col0 = u.pn * BM + wc * 32 + 4 * fq;
#pragma unroll
        for (int bj = 0; bj < 2; ++bj)
#pragma unroll
            for (int n = 0; n < 2; ++n) { const f32x4 bv = *(const f32x4*)(bias + col0 + bj * HALF + n * 16), sv = *(const f32x4*)(sc + col0 + bj * HALF + n * 16);
#pragma unroll
                for (int ai = 0; ai < 2; ++ai)
#pragma unroll
                    for (int m = 0; m < 4; ++m) { const size_t off = (size_t)(row0 + ai * HALF + m * 16) * D + col0 + bj * HALF + n * 16;
                        const f32x4 b = *(const f32x4*)(hin + off); *(f32x4*)(out + off) = b + (acc[ai][bj][m][n] + bv) * sv; } }
    }
};
struct EpiPle {
    static constexpr bool PERM = false;
    const float* hin; float* out; const float* rs; const bf16_t* pp;
    __device__ __forceinline__ void operator()(const f32x4 (&acc)[2][2][4][2], const Unit& u, int wr, int wc, int fr, int fq, LAS unsigned char*) const {
        const int row0 = u.pm * BM + wr * 64 + fr, col0 = u.pn * BM + wc * 32 + 4 * fq;
#pragma unroll
        for (int ai = 0; ai < 2; ++ai)
#pragma unroll
            for (int m = 0; m < 4; ++m) { const int row = row0 + ai * HALF + m * 16; const size_t off = (size_t)row * D + col0; const float s = rs[row];
#pragma unroll
                for (int bj = 0; bj < 2; ++bj)
#pragma unroll
                    for (int n = 0; n < 2; ++n) { const f32x4 b = *(const f32x4*)(hin + off + bj * HALF + n * 16); const u32x2 pw = *(const u32x2*)(pp + off + bj * HALF + n * 16);
                        const f32x4 a = acc[ai][bj][m][n] * s; f32x4 o;
                        o[0] = b[0] + fsigmoid(a[0]) * bf_lo(pw.x); o[1] = b[1] + fsigmoid(a[1]) * bf_hi(pw.x); o[2] = b[2] + fsigmoid(a[2]) * bf_lo(pw.y); o[3] = b[3] + fsigmoid(a[3]) * bf_hi(pw.y);
                        *(f32x4*)(out + off + bj * HALF + n * 16) = o; } }
    }
};
struct EpiUp {
    static constexpr bool PERM = true;
    bf16_t* H;
    __device__ __forceinline__ void operator()(const f32x4 (&acc)[2][2][4][2], const Unit& u, int wr, int wc, int fr, int fq, LAS unsigned char* lds_all) const {
        const LAS float* rst = (const LAS float*)(lds_all + TABB_OFF) + u.ui * 256;
        const int r0 = wr * 64 + fr, col0 = u.pn * HALF + wc * 32 + 8 * fq;
#pragma unroll
        for (int ai = 0; ai < 2; ++ai)
#pragma unroll
            for (int m = 0; m < 4; ++m) { const int r = r0 + ai * HALF + m * 16; const float s = rst[r];
                f32x4 h0, h1;
#pragma unroll
                for (int j = 0; j < 4; ++j) { h0[j] = fsilu(acc[ai][0][m][0][j] * s) * (acc[ai][1][m][0][j] * s); h1[j] = fsilu(acc[ai][0][m][1][j] * s) * (acc[ai][1][m][1][j] * s); }
                *(u32x4*)(H + ((size_t)u.pm * BM + r) * DFF + col0) = pack8(h0, h1); }
    }
};
struct EpiDown {
    static constexpr bool PERM = true;
    bf16_t* Y;
    __device__ __forceinline__ void operator()(const f32x4 (&acc)[2][2][4][2], const Unit& u, int wr, int wc, int fr, int fq, LAS unsigned char* lds_all) const {
        const LAS int* at = (const LAS int*)(lds_all + TABA_OFF) + u.ui * 256; const LAS float* wt = (const LAS float*)(lds_all + TABB_OFF) + u.ui * 256;
        const int r0 = wr * 64 + fr, col0 = u.pn * BM + wc * 32 + 8 * fq;
#pragma unroll
        for (int ai = 0; ai < 2; ++ai)
#pragma unroll
            for (int m = 0; m < 4; ++m) { const int r = r0 + ai * HALF + m * 16; const int a = at[r]; const float w = wt[r];
                if (a >= 0) { bf16_t* rowp = Y + (size_t)a * D + col0;
#pragma unroll
                    for (int bj = 0; bj < 2; ++bj) *(u32x4*)(rowp + bj * HALF) = pack8(acc[ai][bj][m][0] * w, acc[ai][bj][m][1] * w); } }
    }
};
template <int MODE>
__device__ __forceinline__ void cvt_item(const float* __restrict__ src, int ldsrc, int col0, int K, int N, bf16_t* __restrict__ dst, int row0, const float* __restrict__ kscale, int kmod, float scalar,
                                         size_t lo_off, LAS float* scr, int item, int lane) {
    const int nblk = (N + 31) / 32, kb = item / nblk, nb = item - kb * nblk, k0 = 64 * kb, n0 = 32 * nb;
    {
        const int lr = lane >> 3, lc = (lane & 7) * 4;
#pragma unroll
        for (int i = 0; i < 8; ++i) { const int kk = lr + 8 * i; float v[4];
            if (n0 + lc + 3 < N) { const f32x4 t = *(const f32x4*)(src + (size_t)(k0 + kk) * ldsrc + col0 + n0 + lc); v[0] = t[0]; v[1] = t[1]; v[2] = t[2]; v[3] = t[3]; }
            else {
#pragma unroll
                for (int j = 0; j < 4; ++j) v[j] = (n0 + lc + j < N) ? src[(size_t)(k0 + kk) * ldsrc + col0 + n0 + lc + j] : 0.f; }
            const float g = (kscale ? kscale[(k0 + kk) % kmod] : 1.0f) * scalar;
#pragma unroll
            for (int j = 0; j < 4; ++j) scr[kk * 33 + lc + j] = v[j] * g; }
    }
    LDS_WAIT(); asm volatile("" ::: "memory");
    const int c = lane & 7;
#pragma unroll
    for (int j = 0; j < 4; ++j) { const int n = (lane >> 3) + 8 * j; const LAS float* s = scr + (8 * c) * 33 + n;
        float f[8];
#pragma unroll
        for (int q = 0; q < 8; ++q) f[q] = s[q * 33];
        if (n0 + n < N) {
            const int nn = n0 + n;
            int drow = row0 + nn;
            if (MODE == 1) drow = (nn >> 7) * 256 + (nn & 127);
            if (MODE == 2) drow = (nn >> 7) * 256 + 128 + (nn & 127);
            u32x4 o; o.x = cvt_pk_bf16(f[0], f[1]); o.y = cvt_pk_bf16(f[2], f[3]); o.z = cvt_pk_bf16(f[4], f[5]); o.w = cvt_pk_bf16(f[6], f[7]);
            *(u32x4*)(dst + (size_t)drow * K + k0 + 8 * c) = o;
            if (MODE == 3) { float l[8];
#pragma unroll
                for (int q = 0; q < 4; ++q) { l[2 * q] = f[2 * q] - bf_lo(((unsigned*)&o)[q]); l[2 * q + 1] = f[2 * q + 1] - bf_hi(((unsigned*)&o)[q]); }
                u32x4 p; p.x = cvt_pk_bf16(l[0], l[1]); p.y = cvt_pk_bf16(l[2], l[3]); p.z = cvt_pk_bf16(l[4], l[5]); p.w = cvt_pk_bf16(l[6], l[7]);
                *(u32x4*)(dst + lo_off + (size_t)drow * K + k0 + 8 * c) = p; }
        }
    }
    LDS_WAIT(); asm volatile("" ::: "memory");
}
template <int MODE>
__device__ __forceinline__ void cvt_matrix(const float* src, int ldsrc, int col0, int K, int N, bf16_t* dst, int row0, const float* kscale, int kmod, float scalar, size_t lo_off,
                                           LAS float* scr, int gw, int NGW, int lane) {
    const int nitems = (K / 64) * ((N + 31) / 32);
    for (int it = gw; it < nitems; it += NGW) cvt_item<MODE>(src, ldsrc, col0, K, N, dst, row0, kscale, kmod, scalar, lo_off, scr, it, lane);
}

struct Ptrs {
    const float* in[23]; float* out; unsigned char* ws; int ph_lo, ph_hi;
};

typedef const __attribute__((address_space(4))) Ptrs CPtrs;
__device__ __forceinline__ CPtrs* kargs() { CPtrs* p = (CPtrs*)__builtin_amdgcn_kernarg_segment_ptr(); asm volatile("" : "+s"(p)); return p; }

__device__ __forceinline__ void prologue(CPtrs& P, LAS unsigned char* lds, int vcu, int G, int wave, int lane) {
    LAS float* scr = (LAS float*)(lds + wave * 8448);
    const int gw = vcu * NWAVES + wave, NGW = G * NWAVES;
    unsigned char* ws = P.ws;
    const float* norm_mix = P.in[2]; const float* norm_ffn = P.in[3]; const float* norm_ple = P.in[4];
    {
        const float* wg = P.in[18]; const float* wu = P.in[19]; const float* wd = P.in[20];
        const int total = 4 * NE * 576;
        for (int it = gw; it < total; it += NGW) {
            const int le = it / 576, r = it - le * 576, which = r / 192, rr = r - which * 192, layer = le >> 6;
            bf16_t* gu = (bf16_t*)(ws + WS_WGU) + (size_t)le * 768 * D; bf16_t* dn = (bf16_t*)(ws + WS_WD) + (size_t)le * D * DFF;
            if (which == 0) cvt_item<1>(wg + (size_t)le * D * DFF, DFF, 0, D, DFF, gu, 0, norm_ffn + layer * D, D, 1.0f, 0, scr, rr, lane);
            else if (which == 1) cvt_item<2>(wu + (size_t)le * D * DFF, DFF, 0, D, DFF, gu, 0, norm_ffn + layer * D, D, 1.0f, 0, scr, rr, lane);
            else cvt_item<0>(wd + (size_t)le * DFF * D, D, 0, DFF, D, dn, 0, nullptr, 1, 1.0f, 0, scr, rr, lane);
        }
    }
    int rot = 0;
#define ROT() ((gw + NGW - (rot++ * 397) % NGW) % NGW)
    for (int j = 0; j < 2; ++j) {
        const float* win = P.in[6] + (size_t)j * D * GIN;
        bf16_t* wt = (bf16_t*)(ws + WS_WIN) + (size_t)j * NPROJ * D;
        cvt_matrix<0>(win, GIN, 0, D, 512, wt, 0, norm_mix + (2 * j) * D, D, 0.08838834764831845f, 0, scr, ROT(), NGW, lane);
        cvt_matrix<0>(win, GIN, 512, D, 2560, wt, 512, norm_mix + (2 * j) * D, D, 1.0f, 0, scr, ROT(), NGW, lane);
        cvt_matrix<3>(win, GIN, 3072, D, 16, (bf16_t*)(ws + WS_WLR) + (size_t)j * 2 * 16 * D, 0, norm_mix + (2 * j) * D, D, 1.0f, (size_t)16 * D, scr, ROT(), NGW, lane);
        cvt_matrix<0>(P.in[10] + (size_t)j * D * D, D, 0, D, D, (bf16_t*)(ws + WS_WOUT) + (size_t)j * D * D, 0, P.in[9] + j * 256, 256, 1.0f, 0, scr, ROT(), NGW, lane);
        for (int g = 0; g < 4; ++g)
            cvt_matrix<0>(P.in[11] + ((size_t)j * 4 + g) * 256 * 256, 256, 0, 256, 256, (bf16_t*)(ws + WS_WPOOL) + ((size_t)j * 4 + g) * 256 * 256, 0, norm_mix + (2 * j + 1) * D + g * 256, 256, 1.0f, 0, scr, ROT(), NGW, lane);
    }
    for (int i = 0; i < 4; ++i) {
        bf16_t* wr = (bf16_t*)(ws + WS_WR) + (size_t)i * 2 * 80 * D;
        cvt_matrix<3>(P.in[14] + (size_t)i * D * 8, 8, 0, D, 8, wr, 0, norm_ffn + i * D, D, 1.0f, (size_t)80 * D, scr, ROT(), NGW, lane);
        cvt_matrix<3>(P.in[16] + (size_t)i * D * 64, 64, 0, D, 64, wr, 8, norm_ffn + i * D, D, 1.0f, (size_t)80 * D, scr, ROT(), NGW, lane);
        cvt_matrix<0>(P.in[21] + (size_t)i * D * D, D, 0, D, D, (bf16_t*)(ws + WS_WPG) + (size_t)i * D * D, 0, norm_ple + i * D, D, 1.0f, 0, scr, ROT(), NGW, lane);
        cvt_matrix<0>(P.in[22] + (size_t)i * PLE * D, D, 0, PLE, D, (bf16_t*)(ws + WS_WPP) + (size_t)i * D * PLE, 0, nullptr, 1, 1.0f, 0, scr, ROT(), NGW, lane);
        for (int idx = gw * 64 + lane; idx < 2 * 8 * D / 8; idx += NGW * 64) { const int hl = idx / (8 * D / 8), rem = idx - hl * (8 * D / 8);
            *(u32x4*)(wr + (size_t)hl * 80 * D + (size_t)72 * D + (size_t)rem * 8) = (u32x4){0u, 0u, 0u, 0u}; }
    }
#undef ROT
    {
        const float* p = P.in[1]; bf16_t* pb = (bf16_t*)(ws + WS_PB);
        const size_t n8 = (size_t)4 * T * PLE / 8;
        for (size_t i = (size_t)gw * 64 + lane; i < n8; i += (size_t)NGW * 64) {
            const f32x4 a = *(const f32x4*)(p + i * 8), b = *(const f32x4*)(p + i * 8 + 4);
            *(u32x4*)(pb + i * 8) = pack8(a, b); }
    }
}

constexpr int NPB_STRIDE = 288;
template <int MODE>
__device__ __forceinline__ void np_pass(LAS unsigned char* lds, const float* __restrict__ hin, float* __restrict__ hout, bf16_t* __restrict__ hb, float* __restrict__ rs,
                                        const bf16_t* __restrict__ Wsm  , float* __restrict__ lr, const bf16_t* __restrict__ Y,
                                        const float* __restrict__ bc, const float* __restrict__ bfine, unsigned* cnt, int* __restrict__ list, float* __restrict__ wts,
                                        int G, int wave, int lane, bool do_lists = true) {
    constexpr int NR = (MODE == 1) ? 80 : 16, NT = NR / 16;
    constexpr int BUFB = 2 * NR * NPB_STRIDE;
    int tid_ = threadIdx.x; asm volatile("" : "+v"(tid_));
    const int tid = tid_, r = lane & 15, g = lane >> 4;
    for (int blk = blockIdx.x; blk < T / 128; blk += G) {
        const int row0 = blk * 128 + wave * 16;
        const float* hrow = hin + (size_t)(row0 + r) * D + 8 * g;
        float ss = 0.f;
        if constexpr (MODE == 2) {
            const bf16_t* y0 = Y + (size_t)(2 * (row0 + r)) * D + 8 * g; const bf16_t* y1 = y0 + D;
            float* orow = hout + (size_t)(row0 + r) * D + 8 * g; bf16_t* brow = hb + (size_t)(row0 + r) * D + 8 * g;
#pragma unroll 4
            for (int kk = 0; kk < 32; ++kk) {
                f32x4 a = *(const f32x4*)(hrow + 32 * kk), b = *(const f32x4*)(hrow + 32 * kk + 4);
                const u32x4 p = *(const u32x4*)(y0 + 32 * kk), q = *(const u32x4*)(y1 + 32 * kk);
                a[0] += bf_lo(p.x) + bf_lo(q.x); a[1] += bf_hi(p.x) + bf_hi(q.x); a[2] += bf_lo(p.y) + bf_lo(q.y); a[3] += bf_hi(p.y) + bf_hi(q.y);
                b[0] += bf_lo(p.z) + bf_lo(q.z); b[1] += bf_hi(p.z) + bf_hi(q.z); b[2] += bf_lo(p.w) + bf_lo(q.w); b[3] += bf_hi(p.w) + bf_hi(q.w);
                *(f32x4*)(orow + 32 * kk) = a; *(f32x4*)(orow + 32 * kk + 4) = b;
                *(u32x4*)(brow + 32 * kk) = pack8(a, b);
                ss += (a[0] * a[0] + a[1] * a[1]) + (a[2] * a[2] + a[3] * a[3]) + (b[0] * b[0] + b[1] * b[1]) + (b[2] * b[2] + b[3] * b[3]);
            }
            ss += __shfl_xor(ss, 16); ss += __shfl_xor(ss, 32);
            if (lane < 16) rs[row0 + lane] = 1.0f / sqrtf(ss * (1.0f / D) + EPS);
        } else {
            f32x4 acc[NT];
#pragma unroll
            for (int i = 0; i < NT; ++i) acc[i] = (f32x4){0.f, 0.f, 0.f, 0.f};
            bf16_t* brow = hb + (size_t)(row0 + r) * D + 8 * g;
            constexpr int PPT = (2 * NR * 16) / NTHREADS;
            static_assert(PPT * NTHREADS == 2 * NR * 16, "pieces");
            u32x4 breg[PPT];
            const unsigned goff0 = (unsigned)(tid >> 4) * (unsigned)(D * 2) + (unsigned)(tid & 15) * 16u, loff0 = (unsigned)(tid >> 4) * (unsigned)NPB_STRIDE + (unsigned)(tid & 15) * 16u;
            auto bload = [&](int c) {
                const char* gb = (const char*)Wsm + c * 256;
#pragma unroll
                for (int i = 0; i < PPT; ++i) breg[i] = *(const u32x4*)(gb + (goff0 + (unsigned)(i * 32 * D * 2)));
            };
            auto bstore = [&](int buf) {
#pragma unroll
                for (int i = 0; i < PPT; ++i) *(LAS u32x4*)(lds + buf * BUFB + loff0 + i * 32 * NPB_STRIDE) = breg[i];
            };
            bload(0); bstore(0);
            f32x4 hva[4][2], hvb[4][2];
#pragma unroll
            for (int kk = 0; kk < 4; ++kk) { hva[kk][0] = *(const f32x4*)(hrow + 32 * kk); hva[kk][1] = *(const f32x4*)(hrow + 32 * kk + 4); }
            __syncthreads();
            auto compute = [&](const f32x4 (&hv)[4][2], int c, int cb) {
#pragma unroll
                for (int kk = 0; kk < 4; ++kk) {
                    const f32x4 a = hv[kk][0], b = hv[kk][1];
                    ss += (a[0] * a[0] + a[1] * a[1]) + (a[2] * a[2] + a[3] * a[3]) + (b[0] * b[0] + b[1] * b[1]) + (b[2] * b[2] + b[3] * b[3]);
                    const u32x4 hi = pack8(a, b);
                    *(u32x4*)(brow + 128 * c + 32 * kk) = hi;
                    f32x4 la, lb;
                    la[0] = a[0] - bf_lo(hi.x); la[1] = a[1] - bf_hi(hi.x); la[2] = a[2] - bf_lo(hi.y); la[3] = a[3] - bf_hi(hi.y);
                    lb[0] = b[0] - bf_lo(hi.z); lb[1] = b[1] - bf_hi(hi.z); lb[2] = b[2] - bf_lo(hi.w); lb[3] = b[3] - bf_hi(hi.w);
                    const u32x4 lo = pack8(la, lb);
                    const bf16x8 ah = __builtin_bit_cast(bf16x8, hi), al = __builtin_bit_cast(bf16x8, lo);
#pragma unroll
                    for (int nt = 0; nt < NT; ++nt) {
                        const bf16x8 bh = *(const LAS bf16x8*)(lds + cb * BUFB + (nt * 16 + r) * NPB_STRIDE + (32 * kk + 8 * g) * 2);
                        const bf16x8 bl = *(const LAS bf16x8*)(lds + cb * BUFB + (NR + nt * 16 + r) * NPB_STRIDE + (32 * kk + 8 * g) * 2);
                        acc[nt] = __builtin_amdgcn_mfma_f32_16x16x32_bf16(ah, bh, acc[nt], 0, 0, 0);
                        acc[nt] = __builtin_amdgcn_mfma_f32_16x16x32_bf16(al, bh, acc[nt], 0, 0, 0);
                        acc[nt] = __builtin_amdgcn_mfma_f32_16x16x32_bf16(ah, bl, acc[nt], 0, 0, 0);
                    }
                }
            };
#pragma unroll 1
            for (int c = 0; c < 8; c += 2) {
                bload(c + 1);
#pragma unroll
                for (int kk = 0; kk < 4; ++kk) { hvb[kk][0] = *(const f32x4*)(hrow + 128 * (c + 1) + 32 * kk); hvb[kk][1] = *(const f32x4*)(hrow + 128 * (c + 1) + 32 * kk + 4); }
                compute(hva, c, 0);
                bstore(1);
                __syncthreads();
                if (c + 2 < 8) { bload(c + 2);
#pragma unroll
                    for (int kk = 0; kk < 4; ++kk) { hva[kk][0] = *(const f32x4*)(hrow + 128 * (c + 2) + 32 * kk); hva[kk][1] = *(const f32x4*)(hrow + 128 * (c + 2) + 32 * kk + 4); } }
                compute(hvb, c + 1, 1);
                if (c + 2 < 8) bstore(0);
                __syncthreads();
            }
            ss += __shfl_xor(ss, 16); ss += __shfl_xor(ss, 32);
            const float rsv = 1.0f / sqrtf(ss * (1.0f / D) + EPS);
            if (lane < 16) rs[row0 + lane] = rsv;
            float rsr[4];
#pragma unroll
            for (int j = 0; j < 4; ++j) rsr[j] = __shfl(rsv, 4 * g + j);
            if constexpr (MODE == 0) {
#pragma unroll
                for (int j = 0; j < 4; ++j) lr[(size_t)(row0 + 4 * g + j) * 16 + r] = acc[0][j] * rsr[j];
            } else {
                LAS float* slog = (LAS float*)(lds) + wave * 16 * 80;
                LAS int* hist = (LAS int*)(lds + 8 * 16 * 80 * 4);
#pragma unroll
                for (int nt = 0; nt < NT; ++nt) { const int n = nt * 16 + r; const float bias = (n < 8) ? bc[n] : ((n < 72) ? bfine[n - 8] : 0.f);
#pragma unroll
                    for (int j = 0; j < 4; ++j) slog[(4 * g + j) * 80 + n] = acc[nt][j] * rsr[j] + bias; }
                if (tid < 64) hist[tid] = 0;
                __syncthreads();
                if (do_lists) {
                int ea = 0, eb = 0, pa = 0, pb = 0; float w0 = 0.f, w1 = 0.f;
                if (lane < 16) {
                    const LAS float* L = slog + lane * 80;
                    int gq = 0; float m = L[0];
#pragma unroll
                    for (int j = 1; j < 8; ++j) { const float v = L[j]; if (v > m) { m = v; gq = j; } }
                    float den = 0.f;
#pragma unroll
                    for (int j = 0; j < 8; ++j) den += __expf(L[j] - m);
                    const float pg = 1.0f / den;
                    const LAS float* f = L + 8 + gq * 8;
                    int i0 = 0; float v0 = f[0];
#pragma unroll
                    for (int j = 1; j < 8; ++j) { const float v = f[j]; if (v > v0) { v0 = v; i0 = j; } }
                    int i1 = -1; float v1 = 0.f;
#pragma unroll
                    for (int j = 0; j < 8; ++j) { const float v = f[j]; if (j != i0 && (i1 < 0 || v > v1)) { v1 = v; i1 = j; } }
                    const float e1 = __expf(v1 - v0); w0 = pg / (1.0f + e1); w1 = pg * e1 / (1.0f + e1);
                    ea = gq * 8 + i0; eb = gq * 8 + i1;
                    pa = atomicAdd((int*)&hist[ea], 1); pb = atomicAdd((int*)&hist[eb], 1);
                }
                __syncthreads();
                if (tid < 64) { const int c = hist[tid]; hist[64 + tid] = c ? (int)atomicAdd(cnt + tid, (unsigned)c) : 0; }
                __syncthreads();
                if (lane < 16) { const int t = row0 + lane;
                    list[(size_t)ea * CAP + hist[64 + ea] + pa] = 2 * t; wts[2 * t] = w0;
                    list[(size_t)eb * CAP + hist[64 + eb] + pb] = 2 * t + 1; wts[2 * t + 1] = w1; }
                }
                __syncthreads();
            }
        }
    }
}

constexpr int GS128 = 288, GS64 = 160;
constexpr int G_QD = 0, G_KI = G_QD + 64 * GS128, G_KE = G_KI + 64 * GS128, G_DEC = G_KE + 128 * GS64, G_BLOB = G_DEC + 512;
constexpr int G_VT = G_BLOB, G_AT = G_VT + 2 * 64 * GS64, G_ST = G_AT + 64 * GS64, G_OT = G_ST + 2 * 64 * GS128, G_SQ = G_OT + 64 * 144, G_END = G_SQ + 64 * 8;
static_assert(G_END <= MISC_OFF && G_BLOB % 16 == 0, "GLA LDS");
constexpr int G_NPIECE = G_BLOB / 16;
__device__ __forceinline__ bf16x8 ldfrag(const LAS unsigned char* img, int stride, int row, int kbyte) { return *(const LAS bf16x8*)(img + row * stride + kbyte); }
#define GLA_BAR() asm volatile("s_waitcnt lgkmcnt(0)\n\ts_barrier" ::: "memory")

__device__ __forceinline__ void gla_pre(LAS unsigned char* lds, const bf16_t* __restrict__ proj, const float* __restrict__ lr, const float* __restrict__ wgk, const float* __restrict__ bgk,
                                        unsigned char* __restrict__ gimg, int vcu, int G, int wave, int lane) {
    const int cp = lane, r = lane & 15, g = lane >> 4;
    int parity = 0, cur_hd = -1;
    float wg0[16], wg1[16]; f32x2 bg = (f32x2){0.f, 0.f};
    for (int item = vcu; item < NB * 4 * 32; item += G, parity ^= 1) {
        const int b = item >> 7, hd = (item >> 5) & 3, n = item & 31;
        if (hd != cur_hd) { cur_hd = hd;
#pragma unroll
            for (int q = 0; q < 16; ++q) { const f32x2 w = *(const f32x2*)(wgk + q * 512 + hd * 128 + 2 * cp); wg0[q] = w.x; wg1[q] = w.y; }
            bg = *(const f32x2*)(bgk + hd * 128 + 2 * cp); }
        const size_t tb = (size_t)b * SEQ + 64 * n;
        unsigned qv[8], kv[8]; float lrv[2];
#pragma unroll
        for (int tt = 0; tt < 8; ++tt) { const bf16_t* rowp = proj + (tb + 8 * wave + tt) * NPROJ; qv[tt] = *(const unsigned*)(rowp + hd * 128 + 2 * cp); kv[tt] = *(const unsigned*)(rowp + 512 + hd * 128 + 2 * cp); }
#pragma unroll
        for (int x = 0; x < 2; ++x) lrv[x] = lr[(tb + 8 * wave + 4 * x + g) * 16 + r];
        float b0[8], b1[8];
        {
            float c0 = 0.f, c1 = 0.f;
#pragma unroll
            for (int tt = 0; tt < 8; ++tt) {
                float z0 = bg.x, z1 = bg.y;
#pragma unroll
                for (int q = 0; q < 16; ++q) { const float sv = __builtin_bit_cast(float, __builtin_amdgcn_readlane(__builtin_bit_cast(int, lrv[tt >> 2]), (tt & 3) * 16 + q)); z0 += sv * wg0[q]; z1 += sv * wg1[q]; }
                const float g0 = (fminf(z0, 0.f) - __logf(1.0f + __expf(-fabsf(z0)))) * 0.0625f, g1 = (fminf(z1, 0.f) - __logf(1.0f + __expf(-fabsf(z1)))) * 0.0625f;
                c0 += g0; c1 += g1; b0[tt] = c0; b1[tt] = c1;
            }
            *(LAS f32x2*)(lds + ((parity * 8 + wave) * 128 + 2 * cp) * 4) = (f32x2){c0, c1};
        }
        GLA_BAR();
        float off0 = 0.f, off1 = 0.f, tot0 = 0.f, tot1 = 0.f;
#pragma unroll
        for (int sg = 0; sg < 8; ++sg) { const f32x2 v = *(const LAS f32x2*)(lds + ((parity * 8 + sg) * 128 + 2 * cp) * 4); tot0 += v.x; tot1 += v.y; if (sg < wave) { off0 += v.x; off1 += v.y; } }
        unsigned char* blob = gimg + (size_t)item * G_BLOB;
        float e0[8], e1[8];
        const float et0 = __expf(tot0), et1 = __expf(tot1);
#pragma unroll
        for (int tt = 0; tt < 8; ++tt) {
            const float bb0 = off0 + b0[tt], bb1 = off1 + b1[tt];
            const float q0 = bf_lo(qv[tt]), q1 = bf_hi(qv[tt]), k0 = bf_lo(kv[tt]), k1 = bf_hi(kv[tt]);
            const int tok = 8 * wave + tt;
            const float x0 = __expf(bb0), x1 = __expf(bb1), i0 = __builtin_amdgcn_rcpf(x0), i1 = __builtin_amdgcn_rcpf(x1);
            *(unsigned*)(blob + G_QD + tok * GS128 + 4 * cp) = cvt_pk_bf16(q0 * x0, q1 * x1);
            *(unsigned*)(blob + G_KI + tok * GS128 + 4 * cp) = cvt_pk_bf16(k0 * i0, k1 * i1);
            e0[tt] = k0 * __expf(tot0 - bb0); e1[tt] = k1 * __expf(tot1 - bb1);
        }
        u32x4 ke0, ke1;
        ke0.x = cvt_pk_bf16(e0[0], e0[1]); ke0.y = cvt_pk_bf16(e0[2], e0[3]); ke0.z = cvt_pk_bf16(e0[4], e0[5]); ke0.w = cvt_pk_bf16(e0[6], e0[7]);
        ke1.x = cvt_pk_bf16(e1[0], e1[1]); ke1.y = cvt_pk_bf16(e1[2], e1[3]); ke1.z = cvt_pk_bf16(e1[4], e1[5]); ke1.w = cvt_pk_bf16(e1[6], e1[7]);
        *(u32x4*)(blob + G_KE + (2 * cp) * GS64 + 16 * wave) = ke0;
        *(u32x4*)(blob + G_KE + (2 * cp + 1) * GS64 + 16 * wave) = ke1;
        if (wave == 0) *(f32x2*)(blob + G_DEC + 8 * cp) = (f32x2){et0, et1};
    }
    __syncthreads();
}

template <int SMODE = 0>
__device__ __forceinline__ void gla_scan(LAS unsigned char* lds, const bf16_t* __restrict__ proj, const unsigned char* __restrict__ gimg, bf16_t* __restrict__ og, float* __restrict__ ssp,
                                         int vcu, int G, int wave, int lane) {
    int tid_ = threadIdx.x; asm volatile("" : "+v"(tid_));
    const int tid = tid_, r = lane & 15, g = lane >> 4;
    const int vrow = lane, vc8 = wave, it = wave >> 1, half = wave & 1;
    for (int unit = vcu; unit < NB * 4 * 4; unit += G) {
        const int b = unit >> 4, hd = (unit >> 2) & 3, cs = unit & 3;
        const size_t t0 = (size_t)b * SEQ;
        const unsigned char* blob0 = gimg + (size_t)((b * 4 + hd) * 32) * G_BLOB;
        for (int i = tid; i < 64 * GS128 / 16; i += NTHREADS) *(LAS u32x4*)(lds + G_ST + i * 16) = (u32x4){0u, 0u, 0u, 0u};
        f32x4 S[4];
#pragma unroll
        for (int i = 0; i < 4; ++i) S[i] = (f32x4){0.f, 0.f, 0.f, 0.f};
        u32x4 pa[8], va; u32x2 ra[2];
        auto prefetch = [&](int n, u32x4 (&pp)[8], u32x4& vv, u32x2 (&rr)[2]) {
            const unsigned char* bl = blob0 + (size_t)n * G_BLOB; const size_t tb = t0 + 64 * n;
#pragma unroll
            for (int i = 0; i < 7; ++i) pp[i] = *(const u32x4*)(bl + (size_t)(tid + i * NTHREADS) * 16);
            if (tid < G_NPIECE - 7 * NTHREADS) pp[7] = *(const u32x4*)(bl + (size_t)(tid + 7 * NTHREADS) * 16);
            vv = *(const u32x4*)(proj + (tb + vrow) * NPROJ + 1024 + hd * 256 + cs * 64 + 8 * vc8);
#pragma unroll
            for (int cc = 0; cc < 2; ++cc) rr[cc] = *(const u32x2*)(proj + (tb + it * 16 + r) * NPROJ + 2048 + hd * 256 + cs * 64 + (2 * half + cc) * 16 + 4 * g);
        };
        auto flush = [&](int n) {
            const int row = tid >> 3, pc = tid & 7;
            const u32x4 w = *(const LAS u32x4*)(lds + G_OT + row * 144 + pc * 16);
            *(u32x4*)(og + (t0 + 64 * n + row) * D + hd * 256 + cs * 64 + pc * 8) = w;
            if (tid < 64) { const f32x2 q = *(const LAS f32x2*)(lds + G_SQ + tid * 8); ssp[(size_t)(hd * 4 + cs) * T + t0 + 64 * n + tid] = q.x + q.y; }
        };
        auto chunk = [&](int n, u32x4 (&pp)[8], u32x4& vv, u32x2 (&rr)[2]) {
            const int par = n & 1;
            LAS unsigned char* VT = lds + G_VT + par * 64 * GS64;
            {
#pragma unroll
            for (int i = 0; i < 7; ++i) *(LAS u32x4*)(lds + (tid + i * NTHREADS) * 16) = pp[i];
            if (tid < G_NPIECE - 7 * NTHREADS) *(LAS u32x4*)(lds + (tid + 7 * NTHREADS) * 16) = pp[7];
            { const unsigned vw[4] = {vv.x, vv.y, vv.z, vv.w};
#pragma unroll
              for (int j = 0; j < 4; ++j) { *(LAS unsigned short*)(VT + (8 * vc8 + 2 * j) * GS64 + 2 * vrow) = (unsigned short)(vw[j] & 0xffffu);
                                            *(LAS unsigned short*)(VT + (8 * vc8 + 2 * j + 1) * GS64 + 2 * vrow) = (unsigned short)(vw[j] >> 16); } }
            }
            const u32x2 rc0 = rr[0], rc1 = rr[1];
            if (n + 1 < SEQ / 64) prefetch(n + 1, pp, vv, rr);
            GLA_BAR();
            if (n > 0) flush(n - 1);
            f32x4 at0 = (f32x4){0.f, 0.f, 0.f, 0.f}, at1 = at0, o0 = at0, o1 = at0;
            const bool do0 = (2 * half) <= it, do1 = (2 * half + 1) <= it;
            const LAS unsigned char* STc = lds + G_ST + par * 64 * GS128;
            bf16x8 fq[2], fk0[2], fk1[2], fs0[2], fs1[2];
#define GLA_LDK(ks, bufi) do { const int kb = (32 * (ks) + 8 * g) * 2; fq[bufi] = ldfrag(lds + G_QD, GS128, it * 16 + r, kb); fk0[bufi] = ldfrag(lds + G_KI, GS128, (2 * half) * 16 + r, kb); \
                fk1[bufi] = ldfrag(lds + G_KI, GS128, (2 * half + 1) * 16 + r, kb); fs0[bufi] = ldfrag(STc, GS128, (2 * half) * 16 + r, kb); fs1[bufi] = ldfrag(STc, GS128, (2 * half + 1) * 16 + r, kb); } while (0)
            GLA_LDK(0, 0);
#pragma unroll
            for (int ks = 0; ks < 4; ++ks) {
                const int cb = ks & 1;
                if (ks < 3) GLA_LDK(ks + 1, cb ^ 1);
                o0 = __builtin_amdgcn_mfma_f32_16x16x32_bf16(fs0[cb], fq[cb], o0, 0, 0, 0);
                o1 = __builtin_amdgcn_mfma_f32_16x16x32_bf16(fs1[cb], fq[cb], o1, 0, 0, 0);
                if (do0) at0 = __builtin_amdgcn_mfma_f32_16x16x32_bf16(fk0[cb], fq[cb], at0, 0, 0, 0);
                if (do1) at1 = __builtin_amdgcn_mfma_f32_16x16x32_bf16(fk1[cb], fq[cb], at1, 0, 0, 0);
            }
#undef GLA_LDK
            const f32x4 dec = *(const LAS f32x4*)(lds + G_DEC + (wave * 16 + 4 * g) * 4);
            const bf16x8 kf0 = ldfrag(lds + G_KE, GS64, wave * 16 + r, (8 * g) * 2), kf1 = ldfrag(lds + G_KE, GS64, wave * 16 + r, (32 + 8 * g) * 2);
            if (2 * half == it) {
#pragma unroll
                for (int x = 0; x < 4; ++x) if (4 * g + x > r) at0[x] = 0.f; }
            if (2 * half + 1 == it) {
#pragma unroll
                for (int x = 0; x < 4; ++x) if (4 * g + x > r) at1[x] = 0.f; }
            *(LAS u32x2*)(lds + G_AT + (it * 16 + r) * GS64 + ((2 * half) * 16 + 4 * g) * 2) = (u32x2){cvt_pk_bf16(at0[0], at0[1]), cvt_pk_bf16(at0[2], at0[3])};
            *(LAS u32x2*)(lds + G_AT + (it * 16 + r) * GS64 + ((2 * half + 1) * 16 + 4 * g) * 2) = (u32x2){cvt_pk_bf16(at1[0], at1[1]), cvt_pk_bf16(at1[2], at1[3])};
            f32x4 o[2]; o[0] = o0; o[1] = o1;
            {
#pragma unroll
                for (int cp2 = 0; cp2 < 2; ++cp2) {
                    bf16x8 vf[2][2]; f32x4 sv[2];
#pragma unroll
                    for (int c = 0; c < 2; ++c) { const int ct = 2 * cp2 + c; vf[c][0] = ldfrag(VT, GS64, ct * 16 + r, (8 * g) * 2); vf[c][1] = ldfrag(VT, GS64, ct * 16 + r, (32 + 8 * g) * 2); sv[c] = S[ct] * dec; }
#pragma unroll
                    for (int c = 0; c < 2; ++c) sv[c] = __builtin_amdgcn_mfma_f32_16x16x32_bf16(kf0, vf[c][0], sv[c], 0, 0, 0);
#pragma unroll
                    for (int c = 0; c < 2; ++c) sv[c] = __builtin_amdgcn_mfma_f32_16x16x32_bf16(kf1, vf[c][1], sv[c], 0, 0, 0);
#pragma unroll
                    for (int c = 0; c < 2; ++c) { const int ct = 2 * cp2 + c; S[ct] = sv[c];
                        *(LAS u32x2*)(lds + G_ST + (par ^ 1) * 64 * GS128 + (ct * 16 + r) * GS128 + (wave * 16 + 4 * g) * 2) = (u32x2){cvt_pk_bf16(sv[c][0], sv[c][1]), cvt_pk_bf16(sv[c][2], sv[c][3])}; }
                }
            }
            GLA_BAR();
            {
                const bf16x8 af0 = ldfrag(lds + G_AT, GS64, it * 16 + r, (8 * g) * 2), af1 = ldfrag(lds + G_AT, GS64, it * 16 + r, (32 + 8 * g) * 2);
                float ssq = 0.f;
                const size_t trow = t0 + 64 * n + it * 16 + r;
                bf16x8 wf[2][2];
#pragma unroll
                for (int cc = 0; cc < 2; ++cc) { wf[cc][0] = ldfrag(VT, GS64, (2 * half + cc) * 16 + r, (8 * g) * 2); if (it >= 2) wf[cc][1] = ldfrag(VT, GS64, (2 * half + cc) * 16 + r, (32 + 8 * g) * 2); }
#pragma unroll
                for (int cc = 0; cc < 2; ++cc) o[cc] = __builtin_amdgcn_mfma_f32_16x16x32_bf16(wf[cc][0], af0, o[cc], 0, 0, 0);
                if (it >= 2) {
#pragma unroll
                    for (int cc = 0; cc < 2; ++cc) o[cc] = __builtin_amdgcn_mfma_f32_16x16x32_bf16(wf[cc][1], af1, o[cc], 0, 0, 0); }
#pragma unroll
                for (int cc = 0; cc < 2; ++cc) {
                    const int ct = 2 * half + cc;
                    const f32x4 v = o[cc];
                    ssq += (v[0] * v[0] + v[1] * v[1]) + (v[2] * v[2] + v[3] * v[3]);
                    const int col = hd * 256 + cs * 64 + ct * 16 + 4 * g;
                    const u32x2 rw = cc ? rc1 : rc0;
                    *(LAS u32x2*)(lds + G_OT + (it * 16 + r) * 144 + (ct * 16 + 4 * g) * 2) = (u32x2){cvt_pk_bf16(v[0] * fsilu(bf_lo(rw.x)), v[1] * fsilu(bf_hi(rw.x))), cvt_pk_bf16(v[2] * fsilu(bf_lo(rw.y)), v[3] * fsilu(bf_hi(rw.y)))};
                }
                ssq += __shfl_xor(ssq, 16); ssq += __shfl_xor(ssq, 32);
                if (g == 0) *(LAS float*)(lds + G_SQ + ((it * 16 + r) * 2 + half) * 4) = ssq;
            }
        };
        prefetch(0, pa, va, ra);
        __syncthreads();
#pragma unroll 1
        for (int n = 0; n < SEQ / 64; ++n) chunk(n, pa, va, ra);
        __syncthreads();
        flush(SEQ / 64 - 1);
        __syncthreads();
    }
}
#undef GLA_BAR

__device__ __forceinline__ void e1_pass(const bf16_t* og, bf16_t* ogo, const float* __restrict__ ssp, int G) {
    const size_t n8 = (size_t)T * D / 8;
    int tid_ = threadIdx.x; asm volatile("" : "+v"(tid_));
    for (size_t i = (size_t)blockIdx.x * NTHREADS + tid_; i < n8; i += (size_t)G * NTHREADS) {
        const size_t t = i >> 7; const int hd = (int)((i & 127) >> 5);
        const float s = (ssp[(size_t)(hd * 4 + 0) * T + t] + ssp[(size_t)(hd * 4 + 1) * T + t]) + (ssp[(size_t)(hd * 4 + 2) * T + t] + ssp[(size_t)(hd * 4 + 3) * T + t]);
        const float rsh = 1.0f / sqrtf(s * (1.0f / 256.0f) + EPS);
        const u32x4 w = *(const u32x4*)(og + i * 8);
        u32x4 o; o.x = cvt_pk_bf16(bf_lo(w.x) * rsh, bf_hi(w.x) * rsh); o.y = cvt_pk_bf16(bf_lo(w.y) * rsh, bf_hi(w.y) * rsh); o.z = cvt_pk_bf16(bf_lo(w.z) * rsh, bf_hi(w.z) * rsh); o.w = cvt_pk_bf16(bf_lo(w.w) * rsh, bf_hi(w.w) * rsh);
        *(u32x4*)(ogo + i * 8) = o;
    }
}

template <int J>
__device__ __forceinline__ void pool_group(const float* __restrict__ h, bf16_t* __restrict__ pooled, const LAS float* rsl, int tw  , int seq0, int ri0  , int lane) {
    constexpr int W = 2 << J, NTK = 8, NRW = W + NTK - 1;
    f32x4 xs[NRW];
#pragma unroll
    for (int i = 0; i < NRW; ++i) { const int t = tw - (W - 1) + i, tc = t < seq0 ? seq0 : t;
        xs[i] = *((const f32x4*)(h + (size_t)tc * D + 256 * J) + lane); }
#pragma unroll
    for (int i = 0; i < NRW; ++i) xs[i] = xs[i] * rsl[ri0 - (W - 1) + i];
    f32x4 sum = xs[0];
#pragma unroll
    for (int i = 1; i < W; ++i) sum += xs[i];
#pragma unroll
    for (int tt = 0; tt < NTK; ++tt) {
        const int ts = tw + tt - seq0; const float inv = 1.0f / (float)(ts + 1 < W ? ts + 1 : W);
        const f32x4 p = sum * inv - xs[tt + W - 1];
        *(u32x2*)(pooled + (size_t)(tw + tt) * D + 256 * J + 4 * lane) = (u32x2){cvt_pk_bf16(p[0], p[1]), cvt_pk_bf16(p[2], p[3])};
        if (tt < NTK - 1) sum += xs[tt + W] - xs[tt];
    }
}
__device__ __forceinline__ void pool_pass(LAS unsigned char* lds, const float* __restrict__ h, bf16_t* __restrict__ pooled, int G, int wave, int lane) {
    LAS float* rsl = (LAS float*)lds;
    for (int tile = blockIdx.x; tile < T / 128; tile += G) {
        const int t0 = tile * 128, seq0 = (t0 / SEQ) * SEQ;
#pragma unroll
        for (int bt = 0; bt < 3; ++bt) {
            f32x4 v[6][4];
#pragma unroll
            for (int q = 0; q < 6; ++q) { const int t = t0 - 16 + wave + 8 * (6 * bt + q), tc = t < seq0 ? seq0 : t; const f32x4* x = (const f32x4*)(h + (size_t)tc * D) + lane;
#pragma unroll
                for (int j = 0; j < 4; ++j) v[q][j] = x[64 * j]; }
#pragma unroll
            for (int q = 0; q < 6; ++q) { const int rr = wave + 8 * (6 * bt + q), t = t0 - 16 + rr; float sq = 0.f;
#pragma unroll
                for (int j = 0; j < 4; ++j) sq += (v[q][j][0] * v[q][j][0] + v[q][j][1] * v[q][j][1]) + (v[q][j][2] * v[q][j][2] + v[q][j][3] * v[q][j][3]);
                const float rsv = (t >= seq0) ? 1.0f / sqrtf(wave_sum(sq) * (1.0f / D) + EPS) : 0.f;
                if (lane == 0) rsl[rr] = rsv; }
            __builtin_amdgcn_sched_barrier(0);
        }
        __syncthreads();
        const int tw = t0 + 16 * wave, ri0 = 16 + 16 * wave;
#pragma unroll
        for (int hf = 0; hf < 2; ++hf) {
            pool_group<0>(h, pooled, rsl, tw + 8 * hf, seq0, ri0 + 8 * hf, lane); __builtin_amdgcn_sched_barrier(0);
            pool_group<1>(h, pooled, rsl, tw + 8 * hf, seq0, ri0 + 8 * hf, lane); __builtin_amdgcn_sched_barrier(0);
            pool_group<2>(h, pooled, rsl, tw + 8 * hf, seq0, ri0 + 8 * hf, lane); __builtin_amdgcn_sched_barrier(0);
            pool_group<3>(h, pooled, rsl, tw + 8 * hf, seq0, ri0 + 8 * hf, lane); __builtin_amdgcn_sched_barrier(0);
        }
        __syncthreads();
    }
}

__device__ __forceinline__ void final_norm(const float* __restrict__ h, const float* __restrict__ gfin, float* __restrict__ out, int G, int wave, int lane) {
    f32x4 gv[4];
#pragma unroll
    for (int j = 0; j < 4; ++j) gv[j] = *((const f32x4*)gfin + lane + 64 * j);
    for (int row = blockIdx.x * NWAVES + wave; row < T; row += G * NWAVES) {
        const f32x4* x = (const f32x4*)(h + (size_t)row * D) + lane; f32x4 v[4]; float s = 0.f;
#pragma unroll
        for (int j = 0; j < 4; ++j) { v[j] = x[64 * j]; s += (v[j][0] * v[j][0] + v[j][1] * v[j][1]) + (v[j][2] * v[j][2] + v[j][3] * v[j][3]); }
        const float rsv = 1.0f / sqrtf(wave_sum(s) * (1.0f / D) + EPS);
        f32x4* o = (f32x4*)(out + (size_t)row * D) + lane;
#pragma unroll
        for (int j = 0; j < 4; ++j) o[64 * j] = v[j] * rsv * gv[j];
    }
}

template <bool UP>
__device__ __forceinline__ int moe_tables(LAS unsigned char* lds_all, const unsigned* cnt, const int* __restrict__ list, const float* __restrict__ rs, const float* __restrict__ wts, int G, int c) {
    LAS int* tpre = (LAS int*)(lds_all + TAB_OFF);
    int tid_ = threadIdx.x; asm volatile("" : "+v"(tid_));
    const int tid = tid_;
    if (tid < 64) {
        const int nt = ((int)cnt[tid] + 255) >> 8; int incl = nt;
#pragma unroll
        for (int o = 1; o < 64; o <<= 1) { const int v = __shfl_up(incl, o); if (tid >= o) incl += v; }
        tpre[tid] = incl - nt; if (tid == 63) tpre[NE] = incl;
    }
    __syncthreads();
    const int ntiles = tpre[NE];
    MoeSched<UP> S; S.G = G; S.c = c; S.ntiles = ntiles; S.tpre = tpre; S.A = nullptr; S.W = nullptr;
    Unit u;
    int av[MAXU]; bool vv[MAXU]; int nu = 0;
#pragma unroll
    for (int i = 0; i < MAXU; ++i) { av[i] = -1; vv[i] = false;
        if (S.next_search(i, u)) { nu = i + 1; if (tid == 0) tpre[80 + i] = u.aux;
            if (tid < 256) { const int e = u.aux, idx = (u.pm - tpre[e]) * 256 + tid; vv[i] = idx < (int)cnt[e]; if (vv[i]) av[i] = list[(size_t)e * CAP + idx]; } } }
#pragma unroll
    for (int i = 0; i < MAXU; ++i) if (i < nu && tid < 256) {
        const int a = av[i]; const bool valid = vv[i];
        if (UP) { ((LAS unsigned*)(lds_all + TABA_OFF))[i * 256 + tid] = valid ? (unsigned)(a >> 1) * (unsigned)(D * 2) : 0u; ((LAS float*)(lds_all + TABB_OFF))[i * 256 + tid] = valid ? rs[a >> 1] : 0.f; }
        else { ((LAS int*)(lds_all + TABA_OFF))[i * 256 + tid] = a; ((LAS float*)(lds_all + TABB_OFF))[i * 256 + tid] = valid ? wts[a] : 0.f; }
    }
    __syncthreads();
    return ntiles;
}
constexpr int CWX_CNT = 1024;
constexpr int CWX_BAR = 4096;
constexpr int SEQ_FINAL = 41;
#ifndef FK_PHMASK
#define FK_PHMASK 0x7fff
#endif
#define PH_ON(k) (((FK_PHMASK) >> (k)) & 1)
#ifndef FK_NOPRE
#define FK_NOPRE 0
#endif
#ifndef FK_DUP
#define FK_DUP (-1)
#endif
#define NREP(k) ((FK_DUP == (k)) ? 2 : 1)
#define DUMMY(k, rep) (FK_DUP == (k) && (rep) == 0)
constexpr size_t WS_DUM_F32 = 1270 * MiB, WS_DUM_B16 = 1398 * MiB, WS_DUM_RS = 1462 * MiB;
constexpr size_t WS_GIMG = 1270 * MiB;

__global__ void __launch_bounds__(NTHREADS, 2) fwd(Ptrs P, int li) {
    extern __shared__ __attribute__((aligned(16))) unsigned char lds_raw[];
    LAS unsigned char* lds = (LAS unsigned char*)lds_raw;
    const int tid = threadIdx.x, lane_k = tid & 63, wave_k = __builtin_amdgcn_readfirstlane(tid >> 6);
    const int G_k = gridDim.x, bid_k = blockIdx.x;
    const int vcu_k = (G_k % 8 == 0) ? (bid_k % 8) * (G_k / 8) + bid_k / 8 : bid_k;
#define PHV int lane = lane_k, wave = wave_k, G = G_k, bid = bid_k, vcu = vcu_k; asm volatile("" : "+v"(lane), "+s"(wave), "+s"(G), "+s"(bid), "+s"(vcu)); (void)lane; (void)wave; (void)G; (void)bid; (void)vcu;
    volatile LAS unsigned* MISC = (volatile LAS unsigned*)(lds + MISC_OFF);
    if (tid < 16) MISC[tid] = 0u;
    __syncthreads();
    const int lo = P.ph_lo, hi = P.ph_hi;
    XcdBarrier bar; bar.bar = (unsigned*)(P.ws + WS_CTL) + CWX_BAR + li * XCD_BAR_WORDS; bar.x = 0; bar.st = MISC + 8;
    if (hi - lo > 1) bar = xcd_barrier_post((unsigned*)(P.ws + WS_CTL) + CWX_BAR + li * XCD_BAR_WORDS, MISC + 8);
#define IN(s) (lo <= (s) && (s) < hi)
#define BAR_AFTER(s) do { if (hi > (s) + 1) xcd_barrier(bar); } while (0)
#define KA (*kargs())
#define WSP(off) (KA.ws + (off))
#define WIN ((bf16_t*)WSP(WS_WIN))
#define WLR ((bf16_t*)WSP(WS_WLR))
#define WOUT ((bf16_t*)WSP(WS_WOUT))
#define WPOOL ((bf16_t*)WSP(WS_WPOOL))
#define WR ((bf16_t*)WSP(WS_WR))
#define WPG ((bf16_t*)WSP(WS_WPG))
#define WPP ((bf16_t*)WSP(WS_WPP))
#define WGU ((bf16_t*)WSP(WS_WGU))
#define WD ((bf16_t*)WSP(WS_WD))
#define PB ((bf16_t*)WSP(WS_PB))
#define HB ((bf16_t*)WSP(WS_HB))
#define PROJ ((bf16_t*)WSP(WS_PROJ))
#define OG ((bf16_t*)WSP(WS_OG))
#define PP ((bf16_t*)WSP(WS_PP))
#define H2 ((bf16_t*)WSP(WS_H2))
#define Y ((bf16_t*)WSP(WS_Y))
#define LIST ((int*)WSP(WS_LIST))
#define RS ((float*)WSP(WS_RS))
#define LR ((float*)WSP(WS_LR))
#define SSP ((float*)WSP(WS_SSP))
#define WTS ((float*)WSP(WS_WTS))
#define CNT ((unsigned*)WSP(WS_CTL) + CWX_CNT)

    if (PH_ON(0) && IN(0)) for (int rep = 0; rep < NREP(0); ++rep) { PHV prologue(KA, lds, vcu, G, wave, lane); BAR_AFTER(0); }

    for (int L = 0; L < 4; ++L) {
        const int base = 1 + 10 * L, j = L >> 1;

        if ((L & 1) == 0) {
            if (PH_ON(1) && IN(base + 0)) for (int rep = 0; rep < NREP(1); ++rep) { PHV np_pass<0>(lds, (L == 0) ? KA.in[0] : KA.out, nullptr, HB, RS, WLR + (size_t)j * 2 * 16 * D, LR, nullptr, nullptr, nullptr, nullptr, nullptr, nullptr, G, wave, lane); BAR_AFTER(base + 0); }
            if (PH_ON(2) && IN(base + 1)) for (int rep = 0; rep < NREP(2); ++rep) { PHV DenseSched S; S.init(HB, D, WIN + (size_t)j * NPROJ * D, T, NPROJ, D, G, bid, 0); EpiBf16Rs E{PROJ, NPROJ, RS}; gemm_phase(lds, D, D, S, E); BAR_AFTER(base + 1); }
            if (PH_ON(3) && IN(base + 2)) for (int rep = 0; rep < NREP(3); ++rep) { PHV
                for (int r2 = 0; r2 < NREP(15) && !FK_NOPRE; ++r2) { gla_pre(lds, PROJ, LR, KA.in[7] + (size_t)j * 16 * 512, KA.in[8] + j * 512, WSP(WS_GIMG), vcu, G, wave, lane); xcd_barrier(bar); }
                #ifndef FK_SCANMODE
#define FK_SCANMODE 0
#endif
                if (FK_DUP == 16) { gla_scan<0>(lds, PROJ, WSP(WS_GIMG), (bf16_t*)WSP(WS_DUM_B16), (float*)WSP(WS_DUM_RS), vcu, G, wave, lane); xcd_barrier(bar); }
                gla_scan<0>(lds, PROJ, WSP(WS_GIMG), OG, SSP, vcu, G, wave, lane);
                BAR_AFTER(base + 2); }
            if (PH_ON(4) && IN(base + 3)) for (int rep = 0; rep < NREP(4); ++rep) { PHV e1_pass(OG, DUMMY(4, rep) ? (bf16_t*)WSP(WS_DUM_B16) : OG, SSP, G); BAR_AFTER(base + 3); }
            if (PH_ON(5) && IN(base + 4)) for (int rep = 0; rep < NREP(5); ++rep) { PHV DenseSched S; S.init(OG, D, WOUT + (size_t)j * D * D, T, D, D, G, bid, 0); EpiResid E{(L == 0) ? KA.in[0] : KA.out, DUMMY(5, rep) ? (float*)WSP(WS_DUM_F32) : KA.out}; gemm_phase(lds, D, D, S, E); BAR_AFTER(base + 4); }
        } else {
            if (PH_ON(6) && IN(base + 0)) for (int rep = 0; rep < NREP(6); ++rep) { PHV pool_pass(lds, KA.out, PROJ, G, wave, lane); BAR_AFTER(base + 0); }
            if (PH_ON(7) && IN(base + 1)) for (int rep = 0; rep < NREP(7); ++rep) { PHV DenseSched S; S.init(PROJ, D, WPOOL + (size_t)j * D * 256, T, D, 256, G, bid, 256); EpiPool E{KA.out, DUMMY(7, rep) ? (float*)WSP(WS_DUM_F32) : KA.out, KA.in[12] + j * D, KA.in[13] + j * D}; gemm_phase(lds, 256, D, S, E); BAR_AFTER(base + 1); }
        }
        if (PH_ON(8) && IN(base + 5)) for (int rep = 0; rep < NREP(8); ++rep) { PHV np_pass<1>(lds, KA.out, nullptr, DUMMY(8, rep) ? (bf16_t*)WSP(WS_DUM_B16) : HB, DUMMY(8, rep) ? (float*)WSP(WS_DUM_RS) : RS, WR + (size_t)L * 2 * 80 * D, nullptr, nullptr, KA.in[15] + L * 8, KA.in[17] + L * 64, CNT + L * 64, LIST, WTS, G, wave, lane, !DUMMY(8, rep)); BAR_AFTER(base + 5); }
        if (IN(base + 6)) {
            if (PH_ON(9)) for (int rep = 0; rep < NREP(9); ++rep) { PHV DenseSched S; S.init(PB + (size_t)L * T * PLE, PLE, WPP + (size_t)L * D * PLE, T, D, PLE, G, bid, 0); EpiBf16Rs E{PP, D, nullptr}; gemm_phase(lds, PLE, PLE, S, E); if (DUMMY(9, rep)) xcd_barrier(bar); }
            if (PH_ON(10)) for (int rep = 0; rep < NREP(10); ++rep) { PHV const int ntiles = moe_tables<true>(lds, CNT + L * 64, LIST, RS, WTS, G, vcu);
              MoeSched<true> S; S.A = HB; S.W = WGU + (size_t)L * NE * 768 * D; S.G = G; S.c = vcu; S.ntiles = ntiles; S.tpre = (const LAS int*)(lds + TAB_OFF);
              EpiUp E{H2}; gemm_phase(lds, D, D, S, E); if (DUMMY(10, rep)) xcd_barrier(bar); }
            BAR_AFTER(base + 6);
        }
        if (PH_ON(11) && IN(base + 7)) for (int rep = 0; rep < NREP(11); ++rep) { PHV
            const int ntiles = moe_tables<false>(lds, CNT + L * 64, LIST, RS, WTS, G, vcu);
            MoeSched<false> S; S.A = H2; S.W = WD + (size_t)L * NE * D * DFF; S.G = G; S.c = vcu; S.ntiles = ntiles; S.tpre = (const LAS int*)(lds + TAB_OFF);
            EpiDown E{Y}; gemm_phase(lds, DFF, DFF, S, E);
            BAR_AFTER(base + 7);
        }
        if (PH_ON(12) && IN(base + 8)) for (int rep = 0; rep < NREP(12); ++rep) { PHV np_pass<2>(lds, KA.out, DUMMY(12, rep) ? (float*)WSP(WS_DUM_F32) : KA.out, DUMMY(12, rep) ? (bf16_t*)WSP(WS_DUM_B16) : HB, DUMMY(12, rep) ? (float*)WSP(WS_DUM_RS) : RS, nullptr, nullptr, Y, nullptr, nullptr, nullptr, nullptr, nullptr, G, wave, lane); BAR_AFTER(base + 8); }
        if (PH_ON(13) && IN(base + 9)) for (int rep = 0; rep < NREP(13); ++rep) { PHV DenseSched S; S.init(HB, D, WPG + (size_t)L * D * D, T, D, D, G, bid, 0); EpiPle E{KA.out, DUMMY(13, rep) ? (float*)WSP(WS_DUM_F32) : KA.out, RS, PP}; gemm_phase(lds, D, D, S, E); BAR_AFTER(base + 9); }
    }
    if (PH_ON(14) && IN(SEQ_FINAL)) { PHV final_norm(KA.out, KA.in[5], KA.out, G, wave, lane); }
#undef IN
#undef BAR_AFTER
}
}


#ifndef FK_DIAG
#define FK_DIAG 0
#endif
#if FK_DIAG
__global__ void __launch_bounds__(256) k_cksum(const unsigned* __restrict__ p, size_t nwords4, unsigned long long* slot) {
    unsigned long long s = 0;
    for (size_t i = (size_t)blockIdx.x * 256 + threadIdx.x; i < nwords4; i += (size_t)gridDim.x * 256) { const uint4 v = ((const uint4*)p)[i]; s += (unsigned long long)v.x + v.y + v.z + v.w; }
    for (int o = 32; o; o >>= 1) s += __shfl_xor(s, o);
    if ((threadIdx.x & 63) == 0) atomicAdd(slot, s);
}
__global__ void __launch_bounds__(256) k_verdict(const unsigned long long* cs, int nph, float* out, size_t n) {
    __shared__ float code;
    if (threadIdx.x == 0) { int first = -1; for (int s = 0; s < nph; ++s) if (cs[s] != cs[64 + s] && first < 0) first = s; code = (first < 0) ? 100.0f : (float)(3 + first); }
    __syncthreads();
    for (size_t i = (size_t)blockIdx.x * 256 + threadIdx.x; i < n; i += (size_t)gridDim.x * 256) out[i] = code;
}
#endif
#ifndef FK_PER_PHASE
#define FK_PER_PHASE 0
#endif
extern "C" void kernel_launch(void* const* d_in, const int* in_sizes, int n_in, void* d_out, int out_size, void* d_ws, size_t ws_size, hipStream_t stream) {
    using namespace fk;
    static int grid = 0;
    if (grid == 0) {
        if (n_in != 23 || in_sizes[0] != T * D || out_size != T * D || ws_size < WS_END + 260 * MiB) { fprintf(stderr, "kernel_launch: unexpected shapes (n_in %d, out %d, ws %zu)\n", n_in, out_size, ws_size); grid = -1; return; }
        int dev = 0, cus = 0, per_cu = 0;
        if (hipGetDevice(&dev) != hipSuccess || hipDeviceGetAttribute(&cus, hipDeviceAttributeMultiprocessorCount, dev) != hipSuccess) { grid = -1; return; }
        if (hipFuncSetAttribute((const void*)fwd, hipFuncAttributeMaxDynamicSharedMemorySize, LDS_BYTES) != hipSuccess) { fprintf(stderr, "kernel_launch: hipFuncSetAttribute failed\n"); grid = -1; return; }
        if (hipOccupancyMaxActiveBlocksPerMultiprocessor(&per_cu, (const void*)fwd, NTHREADS, LDS_BYTES) != hipSuccess || per_cu < 1) fprintf(stderr, "kernel_launch: occupancy query says %d\n", per_cu);
        (void)hipGetLastError();
        grid = cus;
    }
    if (grid < 0) return;
    (void)hipMemsetAsync((char*)d_ws + WS_CTL, 0, CTL_ZERO_BYTES, stream);
    Ptrs P; memset(&P, 0, sizeof(P));
    for (int i = 0; i < 23; ++i) P.in[i] = (const float*)d_in[i];
    P.out = (float*)d_out; P.ws = (unsigned char*)d_ws;
#if FK_PER_PHASE
    int li = 0;
#if FK_DIAG
    unsigned long long* cs = (unsigned long long*)((char*)d_ws + WS_END);
    (void)hipMemsetAsync(cs, 0, 2 * 64 * 8, stream);
    for (int run = 0; run < 2; ++run) {
    if (run == 0) (void)hipMemsetAsync((char*)d_ws + 2 * MiB, 0xAA, WS_END - 2 * MiB, stream);
    (void)hipMemsetAsync((char*)d_ws + WS_CTL, 0, CTL_ZERO_BYTES, stream);
    int nph = 0;
#endif
    for (int s = 0; s <= SEQ_FINAL; ++s) {
        const int L = (s - 1) / 10, k = (s - 1) % 10;
        if (s >= 1 && s < SEQ_FINAL && (L & 1) == 1 && k >= 2 && k <= 4) continue;
        P.ph_lo = s; P.ph_hi = s + 1;
        hipLaunchKernelGGL(fwd, dim3(grid), dim3(NTHREADS), LDS_BYTES, stream, P, li);
#if FK_DIAG
        {
            struct Reg { size_t off, bytes; int is_out; };
            Reg regs[4]; int nr = 0;
            auto W = [&](size_t off, size_t bytes) { regs[nr++] = Reg{off, bytes, 0}; };
            auto O = [&]() { regs[nr++] = Reg{0, (size_t)T * D * 4, 1}; };
            if (s == 0) W(WS_WIN, WS_HB - WS_WIN);
            else if (s == SEQ_FINAL) O();
            else if ((L & 1) == 0 && k == 0) { W(WS_HB, 64 * MiB); W(WS_RS, MiB / 8); W(WS_LR, 2 * MiB); }
            else if ((L & 1) == 0 && k == 1) W(WS_PROJ, 192 * MiB);
            else if ((L & 1) == 0 && k == 2) { W(WS_OG, 64 * MiB); W(WS_SSP, 4 * MiB); }
            else if ((L & 1) == 0 && k == 3) W(WS_OG, 64 * MiB);
            else if ((L & 1) == 0 && k == 4) O();
            else if ((L & 1) == 1 && k == 0) W(WS_PROJ, 64 * MiB);
            else if ((L & 1) == 1 && k == 1) O();
            else if (k == 5) { W(WS_HB, 64 * MiB); W(WS_RS, MiB / 8); W(WS_WTS, MiB / 4); }
            else if (k == 6) W(WS_PP, 64 * MiB);
            else if (k == 7) W(WS_Y, 128 * MiB);
            else if (k == 8) { O(); W(WS_HB, 64 * MiB); W(WS_RS, MiB / 8); }
            else if (k == 9) O();
            for (int q = 0; q < nr; ++q)
                hipLaunchKernelGGL(k_cksum, dim3(2048), dim3(256), 0, stream, regs[q].is_out ? (const unsigned*)d_out : (const unsigned*)((char*)d_ws + regs[q].off), regs[q].bytes / 16, cs + run * 64 + nph);
        }
        ++nph;
#endif
    }
#if FK_DIAG
    if (run == 1) hipLaunchKernelGGL(k_verdict, dim3(1024), dim3(256), 0, stream, cs, nph, (float*)d_out, (size_t)T * D);
    }
#endif
#else
    P.ph_lo = 0; P.ph_hi = SEQ_FINAL + 1;
    hipLaunchKernelGGL(fwd, dim3(grid), dim3(NTHREADS), LDS_BYTES, stream, P, 0);
#endif
}
```

```cpp
#include <hip/hip_runtime.h>
#include <stdint.h>
#include <stdio.h>
#include <string.h>
namespace fk {
#define LAS __attribute__((address_space(3)))
#define GAS __attribute__((address_space(1)))
typedef unsigned short bf16_t;
typedef short bf16x8 __attribute__((ext_vector_type(8)));
typedef float f32x4 __attribute__((ext_vector_type(4)));
typedef float f32x2 __attribute__((ext_vector_type(2)));
typedef unsigned u32x4 __attribute__((ext_vector_type(4)));
typedef unsigned u32x2 __attribute__((ext_vector_type(2)));

constexpr int T = 32768, D = 1024, SEQ = 2048, NB = 16, DFF = 384, NE = 64, PLE = 256, GIN = 3088, NPROJ = 3072;
constexpr int CAP = 65536;
constexpr float EPS = 1e-6f;
constexpr int NWAVES = 8, NTHREADS = 512;

constexpr size_t MiB = (size_t)1 << 20;
constexpr size_t WS_CTL = 0, CTL_ZERO_BYTES = 1 * MiB;
constexpr size_t WS_WIN = 2 * MiB;
constexpr size_t WS_WLR = 14 * MiB;
constexpr size_t WS_WOUT = 15 * MiB;
constexpr size_t WS_WPOOL = 19 * MiB;
constexpr size_t WS_WR = 20 * MiB;
constexpr size_t WS_WPG = 22 * MiB;
constexpr size_t WS_WPP = 30 * MiB;
constexpr size_t WS_WGU = 32 * MiB;
constexpr size_t WS_WD = 416 * MiB;
constexpr size_t WS_PB = 608 * MiB;
constexpr size_t WS_HB = 672 * MiB;
constexpr size_t WS_PROJ = 736 * MiB;
constexpr size_t WS_OG = 928 * MiB;
constexpr size_t WS_PP = 992 * MiB;
constexpr size_t WS_H2 = 1056 * MiB;
constexpr size_t WS_Y = 1116 * MiB;
constexpr size_t WS_LIST = 1244 * MiB;
constexpr size_t WS_RS = 1260 * MiB;
constexpr size_t WS_LR = 1261 * MiB;
constexpr size_t WS_SSP = 1263 * MiB;
constexpr size_t WS_WTS = 1267 * MiB;
constexpr size_t WS_END = 1268 * MiB;
constexpr int CW_BAR = 4096;
constexpr int CW_CNT = 8192;

constexpr int STAGE_BYTES = 131072;
constexpr int TAB_OFF = STAGE_BYTES;
constexpr int MAXU = 6;
constexpr int TABA_OFF = TAB_OFF + 512, TABB_OFF = TABA_OFF + MAXU * 1024;
constexpr int MISC_OFF = TABB_OFF + MAXU * 1024;
constexpr int LDS_BYTES = MISC_OFF + 256;
static_assert(LDS_BYTES <= 160 * 1024, "LDS");

#define LDS_WAIT() asm volatile("s_waitcnt lgkmcnt(0)" ::: "memory")
#define VM_WAIT() asm volatile("s_waitcnt vmcnt(0)" ::: "memory")
typedef __bf16 bf16x2_t __attribute__((ext_vector_type(2)));
__device__ __forceinline__ unsigned cvt_pk_bf16(float lo, float hi) { const bf16x2_t b = __builtin_convertvector((f32x2){lo, hi}, bf16x2_t); return __builtin_bit_cast(unsigned, b); }
__device__ __forceinline__ float bf_lo(unsigned w) { return __uint_as_float(w << 16); }
__device__ __forceinline__ float bf_hi(unsigned w) { return __uint_as_float(w & 0xffff0000u); }
__device__ __forceinline__ float wave_sum(float v) {
#pragma unroll
    for (int o = 1; o < 64; o <<= 1) v += __shfl_xor(v, o);
    return v;
}
__device__ __forceinline__ float fsigmoid(float x) { return __builtin_amdgcn_rcpf(1.0f + __expf(-x)); }
__device__ __forceinline__ float fsilu(float x) { return x * fsigmoid(x); }

#define XB_TMO      128
#define XB_XCNT(j)  (256  + 64 * (j))
#define XB_XSUB(j)  (1280 + 64 * (j))
#define XB_XGEN(j)  (2304 + 64 * (j))
#define XB_TOP      3328
#define XB_TOPGEN   3392
#define XCD_BAR_WORDS 3456
#define XB_SPIN_CAP (1u << 18)
__device__ __forceinline__ unsigned xb_ld(unsigned* p)              { return __hip_atomic_load(p, __ATOMIC_RELAXED, __HIP_MEMORY_SCOPE_AGENT); }
__device__ __forceinline__ unsigned xb_add(unsigned* p, unsigned v) { return __hip_atomic_fetch_add(p, v, __ATOMIC_RELAXED, __HIP_MEMORY_SCOPE_AGENT); }
__device__ __forceinline__ unsigned xb_xcc_id() { return (unsigned)__builtin_amdgcn_s_getreg((3 << 11) | 20) & 0xFu; }
#define XB_SPIN(cond, bar) do { unsigned _sp = 0; while (cond) { __builtin_amdgcn_s_sleep(1); \
    if ((++_sp & 255u) == 0u) { if (xb_ld(&(bar)[XB_TMO])) break; if (_sp > XB_SPIN_CAP) { atomicAdd(&(bar)[XB_TMO], 1u); break; } } } } while (0)
struct XcdBarrier { unsigned* bar; unsigned x; volatile LAS unsigned* st; };
__device__ __forceinline__ XcdBarrier xcd_barrier_post(unsigned* bar, volatile LAS unsigned* st) {
    XcdBarrier b; b.bar = bar; b.x = xb_xcc_id(); b.st = st;
    if (threadIdx.x == 0) (void)xb_add(&bar[XB_XCNT(b.x)], 1u);
    return b;
}
__device__ __forceinline__ void xcd_barrier_complete(unsigned* bar, unsigned x, unsigned& nloc, unsigned& nx) {
    const unsigned G = gridDim.x * gridDim.y * gridDim.z;
    unsigned sum, cnt, mine, sp = 0u;
    for (;;) {
        sum = 0u; cnt = 0u; mine = 0u;
#pragma unroll
        for (unsigned j = 0; j < 16; ++j) { const unsigned c = xb_ld(&bar[XB_XCNT(j)]); sum += c; cnt += (c > 0u) ? 1u : 0u; mine = (j == x) ? c : mine; }
        if (sum == G) break;
        __builtin_amdgcn_s_sleep(1);
        if ((++sp & 255u) == 0u) { if (xb_ld(&bar[XB_TMO])) break; if (sp > XB_SPIN_CAP) { atomicAdd(&bar[XB_TMO], 1u); break; } }
    }
    nloc = mine > 0u ? mine : 1u; nx = cnt > 0u ? cnt : 1u;
}
__device__ __forceinline__ void xcd_barrier(const XcdBarrier& b) {
    asm volatile("s_waitcnt vmcnt(0)" ::: "memory");
    __syncthreads();
    if (threadIdx.x == 0) {
        unsigned* bar = b.bar;
        __builtin_amdgcn_s_waitcnt(0);
        unsigned nloc = b.st[0], nx = b.st[1];
        if (nloc == 0u) { xcd_barrier_complete(bar, b.x, nloc, nx); b.st[0] = nloc; b.st[1] = nx; }
        const unsigned old = xb_add(&bar[XB_XSUB(b.x)], 1u);
        const unsigned gen = old / nloc;
        if (old + 1u == (gen + 1u) * nloc) {
            __builtin_amdgcn_fence(__ATOMIC_RELEASE, "agent");
            asm volatile("s_waitcnt vmcnt(0)" ::: "memory");
            const unsigned og = xb_add(&bar[XB_TOP], 1u);
            const unsigned tg = og / nx;
            if (og + 1u == (tg + 1u) * nx) xb_add(&bar[XB_TOPGEN], 1u);
            else XB_SPIN(xb_ld(&bar[XB_TOPGEN]) == tg, bar);
            __builtin_amdgcn_fence(__ATOMIC_ACQUIRE, "agent");
            xb_add(&bar[XB_XGEN(b.x)], 1u);
            asm volatile("s_waitcnt vmcnt(0)" ::: "memory");
        } else {
            XB_SPIN(xb_ld(&bar[XB_XGEN(b.x)]) == gen, bar);
            __builtin_amdgcn_fence(__ATOMIC_ACQUIRE, "agent");
            asm volatile("s_waitcnt vmcnt(0)" ::: "memory");
        }
    }
    __syncthreads();
}

constexpr int BM = 256, BK = 64, HALF = 128, HTB = HALF * BK * 2, NXCD = 8, WGM = 8;
__device__ __forceinline__ int lds_byte(int r, int c) { const int st = (r >> 4) * 2 + (c >> 5), rr = r & 15, cc = c & 31, ob = rr * 64 + cc * 2; return st * 1024 + (ob ^ (((ob >> 9) & 1) << 5)); }
__device__ __forceinline__ void stage_rc(int b, int& R, int& C) { const int st = b / 1024, sb = b % 1024, swz = sb ^ (((sb >> 9) & 1) << 5); R = (st >> 1) * 16 + swz / 64; C = (st & 1) * 32 + (swz % 64) / 2; }
__device__ __forceinline__ int perm32(int rho) { const int n = rho >> 4, i = rho & 15; return 8 * (i >> 2) + 4 * n + (i & 3); }

struct Unit { int pm, pn, ui, aux; };

struct DenseSched {
    static constexpr bool GATHER = false;
    const bf16_t* A; const bf16_t* Bt; int lda, K, acol_per_pn;
    int nM, nN, nwg, G, c;
    __device__ __forceinline__ void init(const bf16_t* A_, int lda_, const bf16_t* Bt_, int M, int N, int K_, int G_, int c_, int acol_per_pn_) {
        A = A_; Bt = Bt_; lda = lda_; K = K_; acol_per_pn = acol_per_pn_; nM = M / BM; nN = N / BM; nwg = nM * nN; G = G_; c = c_; }
    __device__ __forceinline__ bool next(int i, Unit& u) const {
        const long L = (long)i * G + c; if (L >= nwg) return false;
        int wgid = (int)L; { const int q = nwg / NXCD, r = nwg % NXCD, xcd = wgid % NXCD, off = wgid / NXCD; wgid = (xcd < r ? xcd * (q + 1) : r * (q + 1) + (xcd - r) * q) + off; }
        const int nig = WGM * nN, gid = wgid / nig, fm = gid * WGM, gsz = (nM - fm) < WGM ? (nM - fm) : WGM;
        u.pm = fm + ((wgid % nig) % gsz); u.pn = (wgid % nig) / gsz; u.ui = i; u.aux = 0; return true;
    }
    __device__ __forceinline__ const char* a_base(const Unit& u) const { return (const char*)A + ((size_t)u.pm * BM * lda + (size_t)u.pn * acol_per_pn) * 2; }
    __device__ __forceinline__ const char* b_base(const Unit& u) const { return (const char*)Bt + (size_t)u.pn * BM * K * 2; }
    __device__ __forceinline__ void rows(const Unit&, LAS unsigned char*, unsigned (&)[4]) const {}
};
template <bool UP> struct MoeSched {
    static constexpr bool GATHER = UP;
    static constexpr int NTN = UP ? 3 : 4;
    const bf16_t* A; const bf16_t* W; int G, c, ntiles;
    const LAS int* tpre;
    __device__ __forceinline__ bool next(int i, Unit& u) const {
        const int L = i * G + c; if (L >= ntiles * NTN || i >= MAXU) return false;
        const int tile = L / NTN;
        u.pm = tile; u.pn = L - tile * NTN; u.ui = i; u.aux = __builtin_amdgcn_readfirstlane(tpre[80 + i]); return true;
    }
    __device__ __forceinline__ bool next_search(int i, Unit& u) const {
        const int L = i * G + c; if (L >= ntiles * NTN || i >= MAXU) return false;
        const int tile = L / NTN; int e = 0;
        for (int x = 1; x < NE; ++x) e += (tpre[x] <= tile) ? 1 : 0;
        u.pm = tile; u.pn = L - tile * NTN; u.ui = i; u.aux = e; return true;
    }
    __device__ __forceinline__ const char* a_base(const Unit& u) const { return UP ? (const char*)A : (const char*)A + (size_t)u.pm * BM * DFF * 2; }
    __device__ __forceinline__ const char* b_base(const Unit& u) const {
        return UP ? (const char*)W + ((size_t)u.aux * 768 + (size_t)u.pn * BM) * D * 2 : (const char*)W + ((size_t)u.aux * D + (size_t)u.pn * BM) * DFF * 2; }
    __device__ __forceinline__ void rows(const Unit& u, LAS unsigned char* lds_all, unsigned (&v)[4]) const {
        if (UP) { const LAS unsigned* tab = (const LAS unsigned*)(lds_all + TABA_OFF) + u.ui * 256;
#pragma unroll
            for (int i = 0; i < 2; ++i) { int R, C; int tx = threadIdx.x; asm volatile("" : "+v"(tx)); stage_rc(tx * 16 + i * 8192, R, C);
                v[i] = tab[R] + (unsigned)C * 2u; v[2 + i] = tab[HALF + R] + (unsigned)C * 2u; } }
    }
};

#define PG8_SA(b, h) (((b) * 2 + (h)) * HTB)
#define PG8_SB(b, h) ((4 + (b) * 2 + (h)) * HTB)
__device__ __forceinline__ void glds16(const void* gbase, unsigned voff, unsigned lds_dst) {
    unsigned keep;
    asm volatile("s_mov_b32 %0, m0\n\ts_mov_b32 m0, %3\n\ts_nop 0\n\tglobal_load_lds_dwordx4 %1, %2\n\ts_mov_b32 m0, %0" : "=&s"(keep) : "v"(voff), "s"(gbase), "s"(lds_dst) : "memory");
}
#define PG8_STAGE2(bufoff, gbase, o0, o1) do { glds16((gbase), (o0), (unsigned)(bufoff) + ldsw); glds16((gbase), (o1), (unsigned)(bufoff) + ldsw + 8192u); } while (0)
#define PG8_LDA(dst, b, h) do { _Pragma("unroll") for (int m = 0; m < 4; ++m) _Pragma("unroll") for (int k = 0; k < 2; ++k) dst[m][k] = *(const LAS bf16x8*)(lds + PG8_SA(b, h) + aoff + m * 2048 + k * 1024); } while (0)
#define PG8_LDB(dst, b, h) do { _Pragma("unroll") for (int n = 0; n < 2; ++n) _Pragma("unroll") for (int k = 0; k < 2; ++k) dst[n][k] = *(const LAS bf16x8*)(lds + PG8_SB(b, h) + boff + n * 2048 + k * 1024); } while (0)
#define PG8_MMA(ai, bj, At, Bt) do { __builtin_amdgcn_s_setprio(1); _Pragma("unroll") for (int m = 0; m < 4; ++m) _Pragma("unroll") for (int n = 0; n < 2; ++n) _Pragma("unroll") for (int k = 0; k < 2; ++k) \
        acc[ai][bj][m][n] = __builtin_amdgcn_mfma_f32_16x16x32_bf16(Bt[n][k], At[m][k], acc[ai][bj][m][n], 0, 0, 0); __builtin_amdgcn_s_setprio(0); } while (0)
#define PG8_WAIT_V(n) asm volatile("s_waitcnt vmcnt(" #n ")" ::: "memory")
#define PG8_WAIT_L(n) asm volatile("s_waitcnt lgkmcnt(" #n ")" ::: "memory")
#define PG8_BAR __builtin_amdgcn_s_barrier()
#define PG8_SCHED __builtin_amdgcn_sched_barrier(0)

template <class Epi, class Sched>
__device__ __forceinline__ void gemm_phase(LAS unsigned char* lds_all, const int K, const int lda, const Sched& S, const Epi& E) {
    LAS unsigned char* lds = lds_all;
    int tid_ = threadIdx.x; asm volatile("" : "+v"(tid_));
    const int tid = tid_, wid = __builtin_amdgcn_readfirstlane(tid >> 6), lane = tid & 63, wr = wid >> 2, wc = wid & 3, fr = lane & 15, fq = lane >> 4;
    const int nt = K / BK;
    unsigned vB[2], vA[4];
#pragma unroll
    for (int i = 0; i < 2; ++i) { int Rr, Cc; stage_rc(tid * 16 + i * 8192, Rr, Cc); const int Rb = Epi::PERM ? ((Rr & ~31) + perm32(Rr & 31)) : Rr;
        vB[i] = (unsigned)(Rb * K + Cc) * 2u; vA[i] = (unsigned)(Rr * lda + Cc) * 2u; vA[2 + i] = vA[i] + (unsigned)(HALF * lda) * 2u; }
    const size_t kstep = (size_t)(BK * 2);
    const size_t hstepB = (size_t)HALF * K * 2;
    const unsigned ldsw = (unsigned)wid * 1024u;
    const int aoff = lds_byte(wr * 64 + fr, fq * 8), boff = lds_byte(wc * 32 + fr, fq * 8);
    Unit cur, nxt; int ui = 0;
    if (!S.next(0, cur)) return;
    f32x4 acc[2][2][4][2];
#pragma unroll
    for (int a = 0; a < 2; ++a)
#pragma unroll
        for (int b = 0; b < 2; ++b)
#pragma unroll
            for (int m = 0; m < 4; ++m)
#pragma unroll
                for (int n = 0; n < 2; ++n) acc[a][b][m][n] = (f32x4){0.f, 0.f, 0.f, 0.f};
    bf16x8 At[4][2], B0[2][2], B1[2][2];
    const char* cA = S.a_base(cur); const char* cB = S.b_base(cur);
    if constexpr (Sched::GATHER) S.rows(cur, lds_all, vA);
    PG8_STAGE2(PG8_SB(0, 0), cB, vB[0], vB[1]); PG8_STAGE2(PG8_SB(0, 1), cB + hstepB, vB[0], vB[1]); PG8_STAGE2(PG8_SA(0, 0), cA, vA[0], vA[1]); PG8_STAGE2(PG8_SA(0, 1), cA, vA[2], vA[3]);
    if (wr == 1) PG8_BAR;
    PG8_WAIT_V(2); PG8_BAR;
    PG8_STAGE2(PG8_SB(1, 0), cB + kstep, vB[0], vB[1]); PG8_STAGE2(PG8_SA(1, 0), cA + kstep, vA[0], vA[1]); PG8_STAGE2(PG8_SB(1, 1), cB + hstepB + kstep, vB[0], vB[1]);
    PG8_WAIT_V(6); PG8_BAR;
    for (;;) {
        const bool has_next = S.next(ui + 1, nxt);
        const char* nA = has_next ? S.a_base(nxt) : cA; const char* nB = has_next ? S.b_base(nxt) : cB;
#pragma unroll 1
        for (int t = 0; t < nt; t += 2) {
            const bool last = (t == nt - 2);
            const char* a1 = cA + (size_t)(t + 1) * kstep;
            const char* a2 = last ? nA : cA + (size_t)(t + 2) * kstep; const char* b2 = last ? nB : cB + (size_t)(t + 2) * kstep;
            const char* a3 = a2 + kstep; const char* b3 = b2 + kstep;
            PG8_LDB(B0, 0, 0); PG8_LDB(B1, 0, 1); PG8_SCHED; PG8_LDA(At, 0, 0); PG8_STAGE2(PG8_SA(1, 1), a1, vA[2], vA[3]);
            PG8_WAIT_V(8); PG8_WAIT_L(0); PG8_BAR; PG8_MMA(0, 0, At, B0); PG8_MMA(0, 1, At, B1); PG8_BAR; PG8_SCHED;
            if constexpr (Sched::GATHER) { if (last && has_next) S.rows(nxt, lds_all, vA); }
            PG8_LDA(At, 0, 1); PG8_STAGE2(PG8_SB(0, 0), b2, vB[0], vB[1]); PG8_STAGE2(PG8_SB(0, 1), b2 + hstepB, vB[0], vB[1]); PG8_STAGE2(PG8_SA(0, 0), a2, vA[0], vA[1]);
            PG8_WAIT_V(8); PG8_WAIT_L(0); PG8_BAR; PG8_MMA(1, 0, At, B0); PG8_MMA(1, 1, At, B1); PG8_BAR; PG8_SCHED;
            PG8_LDB(B0, 1, 0); PG8_LDB(B1, 1, 1); PG8_SCHED; PG8_LDA(At, 1, 0); PG8_STAGE2(PG8_SA(0, 1), a2, vA[2], vA[3]);
            PG8_WAIT_V(8); PG8_WAIT_L(0); PG8_BAR; PG8_MMA(0, 0, At, B0); PG8_MMA(0, 1, At, B1); PG8_BAR; PG8_SCHED;
            PG8_LDA(At, 1, 1); PG8_STAGE2(PG8_SB(1, 0), b3, vB[0], vB[1]); PG8_STAGE2(PG8_SB(1, 1), b3 + hstepB, vB[0], vB[1]); PG8_STAGE2(PG8_SA(1, 0), a3, vA[0], vA[1]);
            PG8_WAIT_V(8); PG8_WAIT_L(0); PG8_BAR; PG8_MMA(1, 0, At, B0); PG8_MMA(1, 1, At, B1); PG8_BAR; PG8_SCHED;
        }
        if (wr == 0) PG8_BAR;
        E(acc, cur, wr, wc, fr, fq, lds_all);
        if (!has_next) break;
#pragma unroll
        for (int a = 0; a < 2; ++a)
#pragma unroll
            for (int b = 0; b < 2; ++b)
#pragma unroll
                for (int m = 0; m < 4; ++m)
#pragma unroll
                    for (int n = 0; n < 2; ++n) acc[a][b][m][n] = (f32x4){0.f, 0.f, 0.f, 0.f};
        cur = nxt; cA = nA; cB = nB; ++ui;
        if (wr == 1) PG8_BAR;
    }
    PG8_WAIT_V(0);
    PG8_BAR;
}

__device__ __forceinline__ u32x4 pack8(const f32x4 v0, const f32x4 v1) { u32x4 w; w.x = cvt_pk_bf16(v0[0], v0[1]); w.y = cvt_pk_bf16(v0[2], v0[3]); w.z = cvt_pk_bf16(v1[0], v1[1]); w.w = cvt_pk_bf16(v1[2], v1[3]); return w; }

struct EpiBf16Rs {
    static constexpr bool PERM = true;
    bf16_t* O; int ldc; const float* rs;
    __device__ __forceinline__ void operator()(const f32x4 (&acc)[2][2][4][2], const Unit& u, int wr, int wc, int fr, int fq, LAS unsigned char*) const {
        const int row0 = u.pm * BM + wr * 64 + fr, col0 = u.pn * BM + wc * 32 + 8 * fq;
#pragma unroll
        for (int ai = 0; ai < 2; ++ai)
#pragma unroll
            for (int m = 0; m < 4; ++m) { const int row = row0 + ai * HALF + m * 16; const float s = rs ? rs[row] : 1.0f; bf16_t* rowp = O + (size_t)row * ldc + col0;
#pragma unroll
                for (int bj = 0; bj < 2; ++bj) *(u32x4*)(rowp + bj * HALF) = pack8(acc[ai][bj][m][0] * s, acc[ai][bj][m][1] * s); }
    }
};
__device__ __forceinline__ void unpack8(const u32x4 w, f32x4& lo, f32x4& hi) { lo = (f32x4){bf_lo(w.x), bf_hi(w.x), bf_lo(w.y), bf_hi(w.y)}; hi = (f32x4){bf_lo(w.z), bf_hi(w.z), bf_lo(w.w), bf_hi(w.w)}; }
template <bool F32IN> struct EpiResid {
    static constexpr bool PERM = true;
    const void* hin; bf16_t* hout;
    __device__ __forceinline__ void operator()(const f32x4 (&acc)[2][2][4][2], const Unit& u, int wr, int wc, int fr, int fq, LAS unsigned char*) const {
        const int row0 = u.pm * BM + wr * 64 + fr, col0 = u.pn * BM + wc * 32 + 8 * fq;
#pragma unroll
        for (int ai = 0; ai < 2; ++ai)
#pragma unroll
            for (int m = 0; m < 4; ++m) { const size_t off = (size_t)(row0 + ai * HALF + m * 16) * D + col0;
#pragma unroll
                for (int bj = 0; bj < 2; ++bj) { f32x4 lo, hi;
                    if (F32IN) { lo = *(const f32x4*)((const float*)hin + off + bj * HALF); hi = *(const f32x4*)((const float*)hin + off + bj * HALF + 4); }
                    else unpack8(*(const u32x4*)((const bf16_t*)hin + off + bj * HALF), lo, hi);
                    *(u32x4*)(hout + off + bj * HALF) = pack8(lo + acc[ai][bj][m][0], hi + acc[ai][bj][m][1]); } }
    }
};
struct EpiPool {
    static constexpr bool PERM = true;
    bf16_t* h; const float* bias; const float* sc;
    __device__ __forceinline__ void operator()(const f32x4 (&acc)[2][2][4][2], const Unit& u, int wr, int wc, int fr, int fq, LAS unsigned char*) const {
        const int row0 = u.pm * BM + wr * 64 + fr, col0 = u.pn * BM + wc * 32 + 8 * fq;
#pragma unroll
        for (int bj = 0; bj < 2; ++bj) { const f32x4 b0 = *(const f32x4*)(bias + col0 + bj * HALF), b1 = *(const f32x4*)(bias + col0 + bj * HALF + 4), s0 = *(const f32x4*)(sc + col0 + bj * HALF), s1 = *(const f32x4*)(sc + col0 + bj * HALF + 4);
#pragma unroll
            for (int ai = 0; ai < 2; ++ai)
#pragma unroll
                for (int m = 0; m < 4; ++m) { bf16_t* p = h + (size_t)(row0 + ai * HALF + m * 16) * D + col0 + bj * HALF; f32x4 lo, hi; unpack8(*(const u32x4*)p, lo, hi);
                    *(u32x4*)p = pack8(lo + (acc[ai][bj][m][0] + b0) * s0, hi + (acc[ai][bj][m][1] + b1) * s1); } }
    }
};
struct EpiPle {
    static constexpr bool PERM = true;
    const bf16_t* hin; bf16_t* hout; const float* rs; const bf16_t* pp;
    __device__ __forceinline__ void operator()(const f32x4 (&acc)[2][2][4][2], const Unit& u, int wr, int wc, int fr, int fq, LAS unsigned char*) const {
        const int row0 = u.pm * BM + wr * 64 + fr, col0 = u.pn * BM + wc * 32 + 8 * fq;
#pragma unroll
        for (int ai = 0; ai < 2; ++ai)
#pragma unroll
            for (int m = 0; m < 4; ++m) { const int row = row0 + ai * HALF + m * 16; const size_t off = (size_t)row * D + col0; const float sr = rs[row];
#pragma unroll
                for (int bj = 0; bj < 2; ++bj) { f32x4 lo, hi, plo, phi; unpack8(*(const u32x4*)(hin + off + bj * HALF), lo, hi); unpack8(*(const u32x4*)(pp + off + bj * HALF), plo, phi);
                    const f32x4 a0 = acc[ai][bj][m][0] * sr, a1 = acc[ai][bj][m][1] * sr;
#pragma unroll
                    for (int j = 0; j < 4; ++j) { lo[j] += fsigmoid(a0[j]) * plo[j]; hi[j] += fsigmoid(a1[j]) * phi[j]; }
                    *(u32x4*)(hout + off + bj * HALF) = pack8(lo, hi); } }
    }
};
struct EpiUp {
    static constexpr bool PERM = true;
    bf16_t* H;
    __device__ __forceinline__ void operator()(const f32x4 (&acc)[2][2][4][2], const Unit& u, int wr, int wc, int fr, int fq, LAS unsigned char* lds_all) const {
        const LAS float* rst = (const LAS float*)(lds_all + TABB_OFF) + u.ui * 256;
        const int r0 = wr * 64 + fr, col0 = u.pn * HALF + wc * 32 + 8 * fq;
#pragma unroll
        for (int ai = 0; ai < 2; ++ai)
#pragma unroll
            for (int m = 0; m < 4; ++m) { const int r = r0 + ai * HALF + m * 16; const float s = rst[r];
                f32x4 h0, h1;
#pragma unroll
                for (int j = 0; j < 4; ++j) { h0[j] = fsilu(acc[ai][0][m][0][j] * s) * (acc[ai][1][m][0][j] * s); h1[j] = fsilu(acc[ai][0][m][1][j] * s) * (acc[ai][1][m][1][j] * s); }
                *(u32x4*)(H + ((size_t)u.pm * BM + r) * DFF + col0) = pack8(h0, h1); }
    }
};
struct EpiDown {
    static constexpr bool PERM = true;
    bf16_t* Y;
    __device__ __forceinline__ void operator()(const f32x4 (&acc)[2][2][4][2], const Unit& u, int wr, int wc, int fr, int fq, LAS unsigned char* lds_all) const {
        const LAS int* at = (const LAS int*)(lds_all + TABA_OFF) + u.ui * 256; const LAS float* wt = (const LAS float*)(lds_all + TABB_OFF) + u.ui * 256;
        const int r0 = wr * 64 + fr, col0 = u.pn * BM + wc * 32 + 8 * fq;
#pragma unroll
        for (int ai = 0; ai < 2; ++ai)
#pragma unroll
            for (int m = 0; m < 4; ++m) { const int r = r0 + ai * HALF + m * 16; const int a = at[r]; const float w = wt[r];
                if (a >= 0) { bf16_t* rowp = Y + (size_t)a * D + col0;
#pragma unroll
                    for (int bj = 0; bj < 2; ++bj) *(u32x4*)(rowp + bj * HALF) = pack8(acc[ai][bj][m][0] * w, acc[ai][bj][m][1] * w); } }
    }
};
template <int MODE>
__device__ __forceinline__ void cvt_item(const float* __restrict__ src, int ldsrc, int col0, int K, int N, bf16_t* __restrict__ dst, int row0, const float* __restrict__ kscale, int kmod, float scalar,
                                         size_t lo_off, LAS float* scr, int item, int lane) {
    const int nblk = (N + 31) / 32, kb = item / nblk, nb = item - kb * nblk, k0 = 64 * kb, n0 = 32 * nb;
    {
        const int lr = lane >> 3, lc = (lane & 7) * 4;
#pragma unroll
        for (int i = 0; i < 8; ++i) { const int kk = lr + 8 * i; float v[4];
            if (n0 + lc + 3 < N) { const f32x4 t = *(const f32x4*)(src + (size_t)(k0 + kk) * ldsrc + col0 + n0 + lc); v[0] = t[0]; v[1] = t[1]; v[2] = t[2]; v[3] = t[3]; }
            else {
#pragma unroll
                for (int j = 0; j < 4; ++j) v[j] = (n0 + lc + j < N) ? src[(size_t)(k0 + kk) * ldsrc + col0 + n0 + lc + j] : 0.f; }
            const float g = (kscale ? kscale[(k0 + kk) % kmod] : 1.0f) * scalar;
#pragma unroll
            for (int j = 0; j < 4; ++j) scr[kk * 33 + lc + j] = v[j] * g; }
    }
    LDS_WAIT(); asm volatile("" ::: "memory");
    const int c = lane & 7;
#pragma unroll
    for (int j = 0; j < 4; ++j) { const int n = (lane >> 3) + 8 * j; const LAS float* s = scr + (8 * c) * 33 + n;
        float f[8];
#pragma unroll
        for (int q = 0; q < 8; ++q) f[q] = s[q * 33];
        if (n0 + n < N) {
            const int nn = n0 + n;
            int drow = row0 + nn;
            if (MODE == 1) drow = (nn >> 7) * 256 + (nn & 127);
            if (MODE == 2) drow = (nn >> 7) * 256 + 128 + (nn & 127);
            u32x4 o; o.x = cvt_pk_bf16(f[0], f[1]); o.y = cvt_pk_bf16(f[2], f[3]); o.z = cvt_pk_bf16(f[4], f[5]); o.w = cvt_pk_bf16(f[6], f[7]);
            *(u32x4*)(dst + (size_t)drow * K + k0 + 8 * c) = o;
            if (MODE == 3) { float l[8];
#pragma unroll
                for (int q = 0; q < 4; ++q) { l[2 * q] = f[2 * q] - bf_lo(((unsigned*)&o)[q]); l[2 * q + 1] = f[2 * q + 1] - bf_hi(((unsigned*)&o)[q]); }
                u32x4 p; p.x = cvt_pk_bf16(l[0], l[1]); p.y = cvt_pk_bf16(l[2], l[3]); p.z = cvt_pk_bf16(l[4], l[5]); p.w = cvt_pk_bf16(l[6], l[7]);
                *(u32x4*)(dst + lo_off + (size_t)drow * K + k0 + 8 * c) = p; }
        }
    }
    LDS_WAIT(); asm volatile("" ::: "memory");
}
template <int MODE>
__device__ __forceinline__ void cvt_matrix(const float* src, int ldsrc, int col0, int K, int N, bf16_t* dst, int row0, const float* kscale, int kmod, float scalar, size_t lo_off,
                                           LAS float* scr, int gw, int NGW, int lane) {
    const int nitems = (K / 64) * ((N + 31) / 32);
    for (int it = gw; it < nitems; it += NGW) cvt_item<MODE>(src, ldsrc, col0, K, N, dst, row0, kscale, kmod, scalar, lo_off, scr, it, lane);
}

struct Ptrs {
    const float* in[23]; float* out; unsigned char* ws; int ph_lo, ph_hi;
};

typedef const __attribute__((address_space(4))) Ptrs CPtrs;
__device__ __forceinline__ CPtrs* kargs() { CPtrs* p = (CPtrs*)__builtin_amdgcn_kernarg_segment_ptr(); asm volatile("" : "+s"(p)); return p; }

__device__ __forceinline__ void prologue(CPtrs& P, LAS unsigned char* lds, int vcu, int G, int wave, int lane) {
    LAS float* scr = (LAS float*)(lds + wave * 8448);
    const int gw = vcu * NWAVES + wave, NGW = G * NWAVES;
    unsigned char* ws = P.ws;
    const float* norm_mix = P.in[2]; const float* norm_ffn = P.in[3]; const float* norm_ple = P.in[4];
    {
        const float* wg = P.in[18]; const float* wu = P.in[19]; const float* wd = P.in[20];
        const int total = 4 * NE * 576;
        for (int it = gw; it < total; it += NGW) {
            const int le = it / 576, r = it - le * 576, which = r / 192, rr = r - which * 192, layer = le >> 6;
            bf16_t* gu = (bf16_t*)(ws + WS_WGU) + (size_t)le * 768 * D; bf16_t* dn = (bf16_t*)(ws + WS_WD) + (size_t)le * D * DFF;
            if (which == 0) cvt_item<1>(wg + (size_t)le * D * DFF, DFF, 0, D, DFF, gu, 0, norm_ffn + layer * D, D, 1.0f, 0, scr, rr, lane);
            else if (which == 1) cvt_item<2>(wu + (size_t)le * D * DFF, DFF, 0, D, DFF, gu, 0, norm_ffn + layer * D, D, 1.0f, 0, scr, rr, lane);
            else cvt_item<0>(wd + (size_t)le * DFF * D, D, 0, DFF, D, dn, 0, nullptr, 1, 1.0f, 0, scr, rr, lane);
        }
    }
    int rot = 0;
#define ROT() ((gw + NGW - (rot++ * 397) % NGW) % NGW)
    for (int j = 0; j < 2; ++j) {
        const float* win = P.in[6] + (size_t)j * D * GIN;
        bf16_t* wt = (bf16_t*)(ws + WS_WIN) + (size_t)j * NPROJ * D;
        cvt_matrix<0>(win, GIN, 0, D, 512, wt, 0, norm_mix + (2 * j) * D, D, 0.08838834764831845f, 0, scr, ROT(), NGW, lane);
        cvt_matrix<0>(win, GIN, 512, D, 2560, wt, 512, norm_mix + (2 * j) * D, D, 1.0f, 0, scr, ROT(), NGW, lane);
        cvt_matrix<3>(win, GIN, 3072, D, 16, (bf16_t*)(ws + WS_WLR) + (size_t)j * 2 * 16 * D, 0, norm_mix + (2 * j) * D, D, 1.0f, (size_t)16 * D, scr, ROT(), NGW, lane);
        cvt_matrix<0>(P.in[10] + (size_t)j * D * D, D, 0, D, D, (bf16_t*)(ws + WS_WOUT) + (size_t)j * D * D, 0, P.in[9] + j * 256, 256, 1.0f, 0, scr, ROT(), NGW, lane);
        for (int g = 0; g < 4; ++g)
            cvt_matrix<0>(P.in[11] + ((size_t)j * 4 + g) * 256 * 256, 256, 0, 256, 256, (bf16_t*)(ws + WS_WPOOL) + ((size_t)j * 4 + g) * 256 * 256, 0, norm_mix + (2 * j + 1) * D + g * 256, 256, 1.0f, 0, scr, ROT(), NGW, lane);
    }
    for (int i = 0; i < 4; ++i) {
        bf16_t* wr = (bf16_t*)(ws + WS_WR) + (size_t)i * 2 * 80 * D;
        cvt_matrix<3>(P.in[14] + (size_t)i * D * 8, 8, 0, D, 8, wr, 0, norm_ffn + i * D, D, 1.0f, (size_t)80 * D, scr, ROT(), NGW, lane);
        cvt_matrix<3>(P.in[16] + (size_t)i * D * 64, 64, 0, D, 64, wr, 8, norm_ffn + i * D, D, 1.0f, (size_t)80 * D, scr, ROT(), NGW, lane);
        cvt_matrix<0>(P.in[21] + (size_t)i * D * D, D, 0, D, D, (bf16_t*)(ws + WS_WPG) + (size_t)i * D * D, 0, norm_ple + i * D, D, 1.0f, 0, scr, ROT(), NGW, lane);
        cvt_matrix<0>(P.in[22] + (size_t)i * PLE * D, D, 0, PLE, D, (bf16_t*)(ws + WS_WPP) + (size_t)i * D * PLE, 0, nullptr, 1, 1.0f, 0, scr, ROT(), NGW, lane);
        for (int idx = gw * 64 + lane; idx < 2 * 8 * D / 8; idx += NGW * 64) { const int hl = idx / (8 * D / 8), rem = idx - hl * (8 * D / 8);
            *(u32x4*)(wr + (size_t)hl * 80 * D + (size_t)72 * D + (size_t)rem * 8) = (u32x4){0u, 0u, 0u, 0u}; }
    }
#undef ROT
    {
        const float* p = P.in[1]; bf16_t* pb = (bf16_t*)(ws + WS_PB);
        const size_t n8 = (size_t)4 * T * PLE / 8;
        for (size_t i = (size_t)gw * 64 + lane; i < n8; i += (size_t)NGW * 64) {
            const f32x4 a = *(const f32x4*)(p + i * 8), b = *(const f32x4*)(p + i * 8 + 4);
            *(u32x4*)(pb + i * 8) = pack8(a, b); }
    }
}

constexpr int NPB_STRIDE = 288;
template <int MODE, bool F32IN>
__device__ __forceinline__ void np_pass(LAS unsigned char* lds, const void* __restrict__ hin, bf16_t* __restrict__ hb, float* __restrict__ rs,
                                        const bf16_t* __restrict__ Wsm  , float* __restrict__ lr, const bf16_t* __restrict__ Y,
                                        const float* __restrict__ bc, const float* __restrict__ bfine, unsigned* cnt, int* __restrict__ list, float* __restrict__ wts,
                                        int G, int wave, int lane, bool do_lists = true) {
    constexpr int NR = (MODE == 1) ? 80 : 16, NT = NR / 16;
    constexpr int BUFB = 2 * NR * NPB_STRIDE;
    int tid_ = threadIdx.x; asm volatile("" : "+v"(tid_));
    const int tid = tid_, r = lane & 15, g = lane >> 4;
    for (int blk = blockIdx.x; blk < T / 128; blk += G) {
        const int row0 = blk * 128 + wave * 16;
        float ss = 0.f;
        if constexpr (MODE == 2) {
            bf16_t* hrow = hb + (size_t)(row0 + r) * D + 8 * g;
            const bf16_t* y0 = Y + (size_t)(2 * (row0 + r)) * D + 8 * g; const bf16_t* y1 = y0 + D;
#pragma unroll 8
            for (int kk = 0; kk < 32; ++kk) {
                f32x4 a, b, p0, p1, q0, q1;
                unpack8(*(const u32x4*)(hrow + 32 * kk), a, b); unpack8(*(const u32x4*)(y0 + 32 * kk), p0, p1); unpack8(*(const u32x4*)(y1 + 32 * kk), q0, q1);
                a += p0 + q0; b += p1 + q1;
                const u32x4 w = pack8(a, b);
                *(u32x4*)(hrow + 32 * kk) = w;
                unpack8(w, a, b);
                ss += (a[0] * a[0] + a[1] * a[1]) + (a[2] * a[2] + a[3] * a[3]) + (b[0] * b[0] + b[1] * b[1]) + (b[2] * b[2] + b[3] * b[3]);
            }
            ss += __shfl_xor(ss, 16); ss += __shfl_xor(ss, 32);
            if (lane < 16) rs[row0 + lane] = 1.0f / sqrtf(ss * (1.0f / D) + EPS);
        } else {
            f32x4 acc[NT];
#pragma unroll
            for (int i = 0; i < NT; ++i) acc[i] = (f32x4){0.f, 0.f, 0.f, 0.f};
            constexpr int PPT = (2 * NR * 16) / NTHREADS;
            static_assert(PPT * NTHREADS == 2 * NR * 16, "pieces");
            u32x4 breg[PPT];
            const unsigned goff0 = (unsigned)(tid >> 4) * (unsigned)(D * 2) + (unsigned)(tid & 15) * 16u, loff0 = (unsigned)(tid >> 4) * (unsigned)NPB_STRIDE + (unsigned)(tid & 15) * 16u;
            auto bload = [&](int c) {
                const char* gb = (const char*)Wsm + c * 256;
#pragma unroll
                for (int i = 0; i < PPT; ++i) breg[i] = *(const u32x4*)(gb + (goff0 + (unsigned)(i * 32 * D * 2)));
            };
            auto bstore = [&](int buf) {
#pragma unroll
                for (int i = 0; i < PPT; ++i) *(LAS u32x4*)(lds + buf * BUFB + loff0 + i * 32 * NPB_STRIDE) = breg[i];
            };
            constexpr int AW = F32IN ? 2 : 1;
            u32x4 hva[4][AW], hvb[4][AW];
            const char* hrow = F32IN ? (const char*)((const float*)hin + (size_t)(row0 + r) * D + 8 * g) : (const char*)((const bf16_t*)hin + (size_t)(row0 + r) * D + 8 * g);
            constexpr int KSB = F32IN ? 128 : 64;
            auto aload = [&](u32x4 (&hv)[4][AW], int c) {
#pragma unroll
                for (int kk = 0; kk < 4; ++kk)
#pragma unroll
                    for (int w = 0; w < AW; ++w) hv[kk][w] = *(const u32x4*)(hrow + (size_t)(4 * c + kk) * KSB + 16 * w);
            };
            bf16_t* brow = hb + (size_t)(row0 + r) * D + 8 * g;
            auto compute = [&](const u32x4 (&hv)[4][AW], int c, int cb) {
#pragma unroll
                for (int kk = 0; kk < 4; ++kk) {
                    bf16x8 ah, al;
                    if constexpr (F32IN) {
                        const f32x4 a = __builtin_bit_cast(f32x4, hv[kk][0]), b = __builtin_bit_cast(f32x4, hv[kk][AW - 1]);
                        const u32x4 hi = pack8(a, b);
                        *(u32x4*)(brow + 128 * c + 32 * kk) = hi;
                        f32x4 ha, hb2; unpack8(hi, ha, hb2);
                        ss += (ha[0] * ha[0] + ha[1] * ha[1]) + (ha[2] * ha[2] + ha[3] * ha[3]) + (hb2[0] * hb2[0] + hb2[1] * hb2[1]) + (hb2[2] * hb2[2] + hb2[3] * hb2[3]);
                        ah = __builtin_bit_cast(bf16x8, hi); al = __builtin_bit_cast(bf16x8, pack8(a - ha, b - hb2));
                    } else {
                        f32x4 ha, hb2; unpack8(hv[kk][0], ha, hb2);
                        ss += (ha[0] * ha[0] + ha[1] * ha[1]) + (ha[2] * ha[2] + ha[3] * ha[3]) + (hb2[0] * hb2[0] + hb2[1] * hb2[1]) + (hb2[2] * hb2[2] + hb2[3] * hb2[3]);
                        ah = __builtin_bit_cast(bf16x8, hv[kk][0]); al = ah;
                    }
#pragma unroll
                    for (int nt = 0; nt < NT; ++nt) {
                        const bf16x8 bh = *(const LAS bf16x8*)(lds + cb * BUFB + (nt * 16 + r) * NPB_STRIDE + (32 * kk + 8 * g) * 2);
                        const bf16x8 bl = *(const LAS bf16x8*)(lds + cb * BUFB + (NR + nt * 16 + r) * NPB_STRIDE + (32 * kk + 8 * g) * 2);
                        acc[nt] = __builtin_amdgcn_mfma_f32_16x16x32_bf16(ah, bh, acc[nt], 0, 0, 0);
                        if constexpr (F32IN) acc[nt] = __builtin_amdgcn_mfma_f32_16x16x32_bf16(al, bh, acc[nt], 0, 0, 0);
                        acc[nt] = __builtin_amdgcn_mfma_f32_16x16x32_bf16(ah, bl, acc[nt], 0, 0, 0);
                    }
                }
            };
            bload(0); bstore(0);
            aload(hva, 0);
            __syncthreads();
#pragma unroll 1
            for (int c = 0; c < 8; c += 2) {
                bload(c + 1); aload(hvb, c + 1);
                compute(hva, c, 0);
                bstore(1);
                __syncthreads();
                if (c + 2 < 8) { bload(c + 2); aload(hva, c + 2); }
                compute(hvb, c + 1, 1);
                if (c + 2 < 8) bstore(0);
                __syncthreads();
            }
            ss += __shfl_xor(ss, 16); ss += __shfl_xor(ss, 32);
            const float rsv = 1.0f / sqrtf(ss * (1.0f / D) + EPS);
            if (lane < 16) rs[row0 + lane] = rsv;
            float rsr[4];
#pragma unroll
            for (int j = 0; j < 4; ++j) rsr[j] = __shfl(rsv, 4 * g + j);
            if constexpr (MODE == 0) {
#pragma unroll
                for (int j = 0; j < 4; ++j) lr[(size_t)(row0 + 4 * g + j) * 16 + r] = acc[0][j] * rsr[j];
            } else {
                LAS float* slog = (LAS float*)(lds) + wave * 16 * 80;
                LAS int* hist = (LAS int*)(lds + 8 * 16 * 80 * 4);
#pragma unroll
                for (int nt = 0; nt < NT; ++nt) { const int n = nt * 16 + r; const float bias = (n < 8) ? bc[n] : ((n < 72) ? bfine[n - 8] : 0.f);
#pragma unroll
                    for (int j = 0; j < 4; ++j) slog[(4 * g + j) * 80 + n] = acc[nt][j] * rsr[j] + bias; }
                if (tid < 64) hist[tid] = 0;
                __syncthreads();
                if (do_lists) {
                int ea = 0, eb = 0, pa = 0, pb = 0; float w0 = 0.f, w1 = 0.f;
                if (lane < 16) {
                    const LAS float* L = slog + lane * 80;
                    int gq = 0; float m = L[0];
#pragma unroll
                    for (int j = 1; j < 8; ++j) { const float v = L[j]; if (v > m) { m = v; gq = j; } }
                    float den = 0.f;
#pragma unroll
                    for (int j = 0; j < 8; ++j) den += __expf(L[j] - m);
                    const float pg = 1.0f / den;
                    const LAS float* f = L + 8 + gq * 8;
                    int i0 = 0; float v0 = f[0];
#pragma unroll
                    for (int j = 1; j < 8; ++j) { const float v = f[j]; if (v > v0) { v0 = v; i0 = j; } }
                    int i1 = -1; float v1 = 0.f;
#pragma unroll
                    for (int j = 0; j < 8; ++j) { const float v = f[j]; if (j != i0 && (i1 < 0 || v > v1)) { v1 = v; i1 = j; } }
                    const float e1 = __expf(v1 - v0); w0 = pg / (1.0f + e1); w1 = pg * e1 / (1.0f + e1);
                    ea = gq * 8 + i0; eb = gq * 8 + i1;
                    pa = atomicAdd((int*)&hist[ea], 1); pb = atomicAdd((int*)&hist[eb], 1);
                }
                __syncthreads();
                if (tid < 64) { const int c = hist[tid]; hist[64 + tid] = c ? (int)atomicAdd(cnt + tid, (unsigned)c) : 0; }
                __syncthreads();
                if (lane < 16) { const int t = row0 + lane;
                    list[(size_t)ea * CAP + hist[64 + ea] + pa] = 2 * t; wts[2 * t] = w0;
                    list[(size_t)eb * CAP + hist[64 + eb] + pb] = 2 * t + 1; wts[2 * t + 1] = w1; }
                }
                __syncthreads();
            }
        }
    }
}

constexpr int GS128 = 288, GS64 = 160;
constexpr int G_QD = 0, G_KI = G_QD + 64 * GS128, G_KE = G_KI + 64 * GS128, G_BLOB = G_KE + 128 * GS64;
constexpr int G_VT = G_BLOB, G_AT = G_VT + 2 * 64 * GS64, G_ST = G_AT + 64 * GS64, G_OT = G_ST + 2 * 64 * GS128, G_SQ = G_OT + 64 * 144, G_END = G_SQ + 64 * 8;
static_assert(G_END <= MISC_OFF && G_BLOB % 16 == 0, "GLA LDS");
static_assert(G_BLOB == 7 * NTHREADS * 16, "blob pieces");
__device__ __forceinline__ bf16x8 ldfrag(const LAS unsigned char* img, int stride, int row, int kbyte) { return *(const LAS bf16x8*)(img + row * stride + kbyte); }
#define GLA_BAR() asm volatile("s_waitcnt lgkmcnt(0)\n\ts_barrier" ::: "memory")

__device__ __forceinline__ void gla_pre(LAS unsigned char* lds, const bf16_t* __restrict__ proj, const float* __restrict__ lr, const float* __restrict__ wgk, const float* __restrict__ bgk,
                                        unsigned char* __restrict__ gimg, int vcu, int G, int wave, int lane) {
    const int cp = lane, r = lane & 15, g = lane >> 4;
    int parity = 0, cur_hd = -1;
    float wg0[16], wg1[16]; f32x2 bg = (f32x2){0.f, 0.f};
    for (int item = vcu; item < NB * 4 * 32; item += G, parity ^= 1) {
        const int b = item >> 7, hd = (item >> 5) & 3, n = item & 31;
        if (hd != cur_hd) { cur_hd = hd;
#pragma unroll
            for (int q = 0; q < 16; ++q) { const f32x2 w = *(const f32x2*)(wgk + q * 512 + hd * 128 + 2 * cp); wg0[q] = w.x; wg1[q] = w.y; }
            bg = *(const f32x2*)(bgk + hd * 128 + 2 * cp); }
        const size_t tb = (size_t)b * SEQ + 64 * n;
        unsigned qv[8], kv[8]; float lrv[2];
#pragma unroll
        for (int tt = 0; tt < 8; ++tt) { const bf16_t* rowp = proj + (tb + 8 * wave + tt) * NPROJ; qv[tt] = *(const unsigned*)(rowp + hd * 128 + 2 * cp); kv[tt] = *(const unsigned*)(rowp + 512 + hd * 128 + 2 * cp); }
#pragma unroll
        for (int x = 0; x < 2; ++x) lrv[x] = lr[(tb + 8 * wave + 4 * x + g) * 16 + r];
        float b0[8], b1[8];
        {
            float c0 = 0.f, c1 = 0.f;
#pragma unroll
            for (int tt = 0; tt < 8; ++tt) {
                float z0 = bg.x, z1 = bg.y;
#pragma unroll
                for (int q = 0; q < 16; ++q) { const float sv = __builtin_bit_cast(float, __builtin_amdgcn_readlane(__builtin_bit_cast(int, lrv[tt >> 2]), (tt & 3) * 16 + q)); z0 += sv * wg0[q]; z1 += sv * wg1[q]; }
                const float g0 = (fminf(z0, 0.f) - __logf(1.0f + __expf(-fabsf(z0)))) * 0.0625f, g1 = (fminf(z1, 0.f) - __logf(1.0f + __expf(-fabsf(z1)))) * 0.0625f;
                c0 += g0; c1 += g1; b0[tt] = c0; b1[tt] = c1;
            }
            *(LAS f32x2*)(lds + ((parity * 8 + wave) * 128 + 2 * cp) * 4) = (f32x2){c0, c1};
        }
        GLA_BAR();
        float off0 = 0.f, off1 = 0.f, tot0 = 0.f, tot1 = 0.f;
#pragma unroll
        for (int sg = 0; sg < 8; ++sg) { const f32x2 v = *(const LAS f32x2*)(lds + ((parity * 8 + sg) * 128 + 2 * cp) * 4); tot0 += v.x; tot1 += v.y; if (sg < wave) { off0 += v.x; off1 += v.y; } }
        unsigned char* blob = gimg + (size_t)item * G_BLOB;
        float e0[8], e1[8];
        const float et0 = __expf(tot0), et1 = __expf(tot1);
#pragma unroll
        for (int tt = 0; tt < 8; ++tt) {
            const float bb0 = off0 + b0[tt], bb1 = off1 + b1[tt];
            const float q0 = bf_lo(qv[tt]), q1 = bf_hi(qv[tt]), k0 = bf_lo(kv[tt]), k1 = bf_hi(kv[tt]);
            const int tok = 8 * wave + tt;
            const float x0 = __expf(bb0), x1 = __expf(bb1), i0 = __builtin_amdgcn_rcpf(x0), i1 = __builtin_amdgcn_rcpf(x1);
            *(unsigned*)(blob + G_QD + tok * GS128 + 4 * cp) = cvt_pk_bf16(q0 * x0, q1 * x1);
            *(unsigned*)(blob + G_KI + tok * GS128 + 4 * cp) = cvt_pk_bf16(k0 * i0, k1 * i1);
            e0[tt] = k0 * __expf(tot0 - bb0); e1[tt] = k1 * __expf(tot1 - bb1);
        }
        u32x4 ke0, ke1;
        ke0.x = cvt_pk_bf16(e0[0], e0[1]); ke0.y = cvt_pk_bf16(e0[2], e0[3]); ke0.z = cvt_pk_bf16(e0[4], e0[5]); ke0.w = cvt_pk_bf16(e0[6], e0[7]);
        ke1.x = cvt_pk_bf16(e1[0], e1[1]); ke1.y = cvt_pk_bf16(e1[2], e1[3]); ke1.z = cvt_pk_bf16(e1[4], e1[5]); ke1.w = cvt_pk_bf16(e1[6], e1[7]);
        *(u32x4*)(blob + G_KE + (2 * cp) * GS64 + 16 * wave) = ke0;
        *(u32x4*)(blob + G_KE + (2 * cp + 1) * GS64 + 16 * wave) = ke1;
        if (wave == 0) { *(float*)(blob + G_KE + (2 * cp) * GS64 + 128) = et0; *(float*)(blob + G_KE + (2 * cp + 1) * GS64 + 128) = et1; }
    }
    __syncthreads();
}

template <int SMODE = 0>
__device__ __forceinline__ void gla_scan(LAS unsigned char* lds, const bf16_t* __restrict__ proj, const unsigned char* __restrict__ gimg, bf16_t* __restrict__ og, float* __restrict__ ssp,
                                         int vcu, int G, int wave, int lane) {
    int tid_ = threadIdx.x; asm volatile("" : "+v"(tid_));
    const int tid = tid_, r = lane & 15, g = lane >> 4;
    const int vrow = lane, vc8 = wave, it = wave >> 1, half = wave & 1;
    for (int unit = vcu; unit < NB * 4 * 4; unit += G) {
        const int b = unit >> 4, hd = (unit >> 2) & 3, cs = unit & 3;
        const size_t t0 = (size_t)b * SEQ;
        const unsigned char* blob0 = gimg + (size_t)((b * 4 + hd) * 32) * G_BLOB;
        for (int i = tid; i < 64 * GS128 / 16; i += NTHREADS) *(LAS u32x4*)(lds + G_ST + i * 16) = (u32x4){0u, 0u, 0u, 0u};
        f32x4 S[4];
#pragma unroll
        for (int i = 0; i < 4; ++i) S[i] = (f32x4){0.f, 0.f, 0.f, 0.f};
        u32x4 pa[7], va; u32x2 ra[2];
        auto prefetch = [&](int n, u32x4 (&pp)[7], u32x4& vv, u32x2 (&rr)[2]) {
            const unsigned char* bl = blob0 + (size_t)n * G_BLOB; const size_t tb = t0 + 64 * n;
#pragma unroll
            for (int i = 0; i < 7; ++i) pp[i] = *(const u32x4*)(bl + (size_t)(tid + i * NTHREADS) * 16);
            vv = *(const u32x4*)(proj + (tb + vrow) * NPROJ + 1024 + hd * 256 + cs * 64 + 8 * vc8);
#pragma unroll
            for (int cc = 0; cc < 2; ++cc) rr[cc] = *(const u32x2*)(proj + (tb + it * 16 + r) * NPROJ + 2048 + hd * 256 + cs * 64 + (2 * half + cc) * 16 + 4 * g);
        };
        auto flush = [&](int n) {
            const int row = tid >> 3, pc = tid & 7;
            const u32x4 w = *(const LAS u32x4*)(lds + G_OT + row * 144 + pc * 16);
            *(u32x4*)(og + (t0 + 64 * n + row) * D + hd * 256 + cs * 64 + pc * 8) = w;
            { const f32x2 q = *(const LAS f32x2*)(lds + G_SQ + row * 8); ssp[(size_t)(hd * 4 + cs) * T + t0 + 64 * n + row] = q.x + q.y; }
        };
        auto chunk = [&](int n, u32x4 (&pp)[7], u32x4& vv, u32x2 (&rr)[2]) {
            const int par = n & 1;
            LAS unsigned char* VT = lds + G_VT + par * 64 * GS64;
            {
#pragma unroll
            for (int i = 0; i < 7; ++i) *(LAS u32x4*)(lds + (tid + i * NTHREADS) * 16) = pp[i];
            { const unsigned vw[4] = {vv.x, vv.y, vv.z, vv.w};
#pragma unroll
              for (int j = 0; j < 4; ++j) { *(LAS unsigned short*)(VT + (8 * vc8 + 2 * j) * GS64 + 2 * vrow) = (unsigned short)(vw[j] & 0xffffu);
                                            *(LAS unsigned short*)(VT + (8 * vc8 + 2 * j + 1) * GS64 + 2 * vrow) = (unsigned short)(vw[j] >> 16); } }
            }
            const u32x2 rc0 = rr[0], rc1 = rr[1];
            prefetch(n + 1 < SEQ / 64 ? n + 1 : n, pp, vv, rr);
            GLA_BAR();
            flush(n > 0 ? n - 1 : 0);
            f32x4 at0 = (f32x4){0.f, 0.f, 0.f, 0.f}, at1 = at0, o0 = at0, o1 = at0;
            const bool do0 = (2 * half) <= it, do1 = (2 * half + 1) <= it;
            const LAS unsigned char* STc = lds + G_ST + par * 64 * GS128;
            bf16x8 fq[2], fk0[2], fk1[2], fs0[2], fs1[2];
#define GLA_LDK(ks, bufi) do { const int kb = (32 * (ks) + 8 * g) * 2; fq[bufi] = ldfrag(lds + G_QD, GS128, it * 16 + r, kb); fk0[bufi] = ldfrag(lds + G_KI, GS128, (2 * half) * 16 + r, kb); \
                fk1[bufi] = ldfrag(lds + G_KI, GS128, (2 * half + 1) * 16 + r, kb); fs0[bufi] = ldfrag(STc, GS128, (2 * half) * 16 + r, kb); fs1[bufi] = ldfrag(STc, GS128, (2 * half + 1) * 16 + r, kb); } while (0)
            GLA_LDK(0, 0);
#pragma unroll
            for (int ks = 0; ks < 4; ++ks) {
                const int cb = ks & 1;
                if (ks < 3) GLA_LDK(ks + 1, cb ^ 1);
                o0 = __builtin_amdgcn_mfma_f32_16x16x32_bf16(fs0[cb], fq[cb], o0, 0, 0, 0);
                o1 = __builtin_amdgcn_mfma_f32_16x16x32_bf16(fs1[cb], fq[cb], o1, 0, 0, 0);
                if (do0) at0 = __builtin_amdgcn_mfma_f32_16x16x32_bf16(fk0[cb], fq[cb], at0, 0, 0, 0);
                if (do1) at1 = __builtin_amdgcn_mfma_f32_16x16x32_bf16(fk1[cb], fq[cb], at1, 0, 0, 0);
            }
#undef GLA_LDK
            f32x4 dec;
#pragma unroll
            for (int x = 0; x < 4; ++x) dec[x] = *(const LAS float*)(lds + G_KE + (wave * 16 + 4 * g + x) * GS64 + 128);
            const bf16x8 kf0 = ldfrag(lds + G_KE, GS64, wave * 16 + r, (8 * g) * 2), kf1 = ldfrag(lds + G_KE, GS64, wave * 16 + r, (32 + 8 * g) * 2);
            if (2 * half == it) {
#pragma unroll
                for (int x = 0; x < 4; ++x) if (4 * g + x > r) at0[x] = 0.f; }
            if (2 * half + 1 == it) {
#pragma unroll
                for (int x = 0; x < 4; ++x) if (4 * g + x > r) at1[x] = 0.f; }
            *(LAS u32x2*)(lds + G_AT + (it * 16 + r) * GS64 + ((2 * half) * 16 + 4 * g) * 2) = (u32x2){cvt_pk_bf16(at0[0], at0[1]), cvt_pk_bf16(at0[2], at0[3])};
            *(LAS u32x2*)(lds + G_AT + (it * 16 + r) * GS64 + ((2 * half + 1) * 16 + 4 * g) * 2) = (u32x2){cvt_pk_bf16(at1[0], at1[1]), cvt_pk_bf16(at1[2], at1[3])};
            f32x4 o[2]; o[0] = o0; o[1] = o1;
            {
#pragma unroll
                for (int cp2 = 0; cp2 < 2; ++cp2) {
                    bf16x8 vf[2][2]; f32x4 sv[2];
#pragma unroll
                    for (int c = 0; c < 2; ++c) { const int ct = 2 * cp2 + c; vf[c][0] = ldfrag(VT, GS64, ct * 16 + r, (8 * g) * 2); vf[c][1] = ldfrag(VT, GS64, ct * 16 + r, (32 + 8 * g) * 2); sv[c] = S[ct] * dec; }
#pragma unroll
                    for (int c = 0; c < 2; ++c) sv[c] = __builtin_amdgcn_mfma_f32_16x16x32_bf16(kf0, vf[c][0], sv[c], 0, 0, 0);
#pragma unroll
                    for (int c = 0; c < 2; ++c) sv[c] = __builtin_amdgcn_mfma_f32_16x16x32_bf16(kf1, vf[c][1], sv[c], 0, 0, 0);
#pragma unroll
                    for (int c = 0; c < 2; ++c) { const int ct = 2 * cp2 + c; S[ct] = sv[c];
                        *(LAS u32x2*)(lds + G_ST + (par ^ 1) * 64 * GS128 + (ct * 16 + r) * GS128 + (wave * 16 + 4 * g) * 2) = (u32x2){cvt_pk_bf16(sv[c][0], sv[c][1]), cvt_pk_bf16(sv[c][2], sv[c][3])}; }
                }
            }
            GLA_BAR();
            {
                const bf16x8 af0 = ldfrag(lds + G_AT, GS64, it * 16 + r, (8 * g) * 2), af1 = ldfrag(lds + G_AT, GS64, it * 16 + r, (32 + 8 * g) * 2);
                float ssq = 0.f;
                const size_t trow = t0 + 64 * n + it * 16 + r;
                bf16x8 wf[2][2];
#pragma unroll
                for (int cc = 0; cc < 2; ++cc) { wf[cc][0] = ldfrag(VT, GS64, (2 * half + cc) * 16 + r, (8 * g) * 2); if (it >= 2) wf[cc][1] = ldfrag(VT, GS64, (2 * half + cc) * 16 + r, (32 + 8 * g) * 2); }
#pragma unroll
                for (int cc = 0; cc < 2; ++cc) o[cc] = __builtin_amdgcn_mfma_f32_16x16x32_bf16(wf[cc][0], af0, o[cc], 0, 0, 0);
                if (it >= 2) {
#pragma unroll
                    for (int cc = 0; cc < 2; ++cc) o[cc] = __builtin_amdgcn_mfma_f32_16x16x32_bf16(wf[cc][1], af1, o[cc], 0, 0, 0); }
#pragma unroll
                for (int cc = 0; cc < 2; ++cc) {
                    const int ct = 2 * half + cc;
                    const f32x4 v = o[cc];
                    ssq += (v[0] * v[0] + v[1] * v[1]) + (v[2] * v[2] + v[3] * v[3]);
                    const int col = hd * 256 + cs * 64 + ct * 16 + 4 * g;
                    const u32x2 rw = cc ? rc1 : rc0;
                    *(LAS u32x2*)(lds + G_OT + (it * 16 + r) * 144 + (ct * 16 + 4 * g) * 2) = (u32x2){cvt_pk_bf16(v[0] * fsilu(bf_lo(rw.x)), v[1] * fsilu(bf_hi(rw.x))), cvt_pk_bf16(v[2] * fsilu(bf_lo(rw.y)), v[3] * fsilu(bf_hi(rw.y)))};
                }
                ssq += __shfl_xor(ssq, 16); ssq += __shfl_xor(ssq, 32);
                if (g == 0) *(LAS float*)(lds + G_SQ + ((it * 16 + r) * 2 + half) * 4) = ssq;
            }
        };
        prefetch(0, pa, va, ra);
        __syncthreads();
#pragma unroll 1
        for (int n = 0; n < SEQ / 64; ++n) chunk(n, pa, va, ra);
        __syncthreads();
        flush(SEQ / 64 - 1);
        __syncthreads();
    }
}
#undef GLA_BAR

__device__ __forceinline__ void e1_pass(const bf16_t* og, bf16_t* ogo, const float* __restrict__ ssp, int G) {
    const size_t n8 = (size_t)T * D / 8;
    int tid_ = threadIdx.x; asm volatile("" : "+v"(tid_));
    for (size_t i = (size_t)blockIdx.x * NTHREADS + tid_; i < n8; i += (size_t)G * NTHREADS) {
        const size_t t = i >> 7; const int hd = (int)((i & 127) >> 5);
        const float s = (ssp[(size_t)(hd * 4 + 0) * T + t] + ssp[(size_t)(hd * 4 + 1) * T + t]) + (ssp[(size_t)(hd * 4 + 2) * T + t] + ssp[(size_t)(hd * 4 + 3) * T + t]);
        const float rsh = 1.0f / sqrtf(s * (1.0f / 256.0f) + EPS);
        const u32x4 w = *(const u32x4*)(og + i * 8);
        u32x4 o; o.x = cvt_pk_bf16(bf_lo(w.x) * rsh, bf_hi(w.x) * rsh); o.y = cvt_pk_bf16(bf_lo(w.y) * rsh, bf_hi(w.y) * rsh); o.z = cvt_pk_bf16(bf_lo(w.z) * rsh, bf_hi(w.z) * rsh); o.w = cvt_pk_bf16(bf_lo(w.w) * rsh, bf_hi(w.w) * rsh);
        *(u32x4*)(ogo + i * 8) = o;
    }
}

template <int J>
__device__ __forceinline__ void pool_group(const bf16_t* __restrict__ h, bf16_t* __restrict__ pooled, const LAS float* rsl, int tw  , int seq0, int ri0  , int lane) {
    constexpr int W = 2 << J, NTK = 8, NRW = W + NTK - 1;
    f32x4 xs[NRW];
    u32x2 raw[NRW];
#pragma unroll
    for (int i = 0; i < NRW; ++i) { const int t = tw - (W - 1) + i, tc = t < seq0 ? seq0 : t;
        raw[i] = *((const u32x2*)(h + (size_t)tc * D + 256 * J) + lane); }
#pragma unroll
    for (int i = 0; i < NRW; ++i) { const float sc = rsl[ri0 - (W - 1) + i]; xs[i] = (f32x4){bf_lo(raw[i].x) * sc, bf_hi(raw[i].x) * sc, bf_lo(raw[i].y) * sc, bf_hi(raw[i].y) * sc}; }
    f32x4 sum = xs[0];
#pragma unroll
    for (int i = 1; i < W; ++i) sum += xs[i];
#pragma unroll
    for (int tt = 0; tt < NTK; ++tt) {
        const int ts = tw + tt - seq0; const float inv = 1.0f / (float)(ts + 1 < W ? ts + 1 : W);
        const f32x4 p = sum * inv - xs[tt + W - 1];
        *(u32x2*)(pooled + (size_t)(tw + tt) * D + 256 * J + 4 * lane) = (u32x2){cvt_pk_bf16(p[0], p[1]), cvt_pk_bf16(p[2], p[3])};
        if (tt < NTK - 1) sum += xs[tt + W] - xs[tt];
    }
}
__device__ __forceinline__ void pool_pass(LAS unsigned char* lds, const bf16_t* __restrict__ h, bf16_t* __restrict__ pooled, int G, int wave, int lane) {
    LAS float* rsl = (LAS float*)lds;
    for (int tile = blockIdx.x; tile < T / 128; tile += G) {
        const int t0 = tile * 128, seq0 = (t0 / SEQ) * SEQ;
#pragma unroll
        for (int bt = 0; bt < 2; ++bt) {
            u32x4 v[9][2];
#pragma unroll
            for (int q = 0; q < 9; ++q) { const int t = t0 - 16 + wave + 8 * (9 * bt + q), tc = t < seq0 ? seq0 : t; const u32x4* x = (const u32x4*)(h + (size_t)tc * D) + 2 * lane; v[q][0] = x[0]; v[q][1] = x[1]; }
#pragma unroll
            for (int q = 0; q < 9; ++q) { const int rr = wave + 8 * (9 * bt + q), t = t0 - 16 + rr; float sq = 0.f;
#pragma unroll
                for (int w = 0; w < 2; ++w) { f32x4 a, b; unpack8(v[q][w], a, b); sq += (a[0] * a[0] + a[1] * a[1]) + (a[2] * a[2] + a[3] * a[3]) + (b[0] * b[0] + b[1] * b[1]) + (b[2] * b[2] + b[3] * b[3]); }
                const float rsv = (t >= seq0) ? 1.0f / sqrtf(wave_sum(sq) * (1.0f / D) + EPS) : 0.f;
                if (lane == 0) rsl[rr] = rsv; }
            __builtin_amdgcn_sched_barrier(0);
        }
        __syncthreads();
        const int tw = t0 + 16 * wave, ri0 = 16 + 16 * wave;
#pragma unroll
        for (int hf = 0; hf < 2; ++hf) {
            pool_group<0>(h, pooled, rsl, tw + 8 * hf, seq0, ri0 + 8 * hf, lane); __builtin_amdgcn_sched_barrier(0);
            pool_group<1>(h, pooled, rsl, tw + 8 * hf, seq0, ri0 + 8 * hf, lane); __builtin_amdgcn_sched_barrier(0);
            pool_group<2>(h, pooled, rsl, tw + 8 * hf, seq0, ri0 + 8 * hf, lane); __builtin_amdgcn_sched_barrier(0);
            pool_group<3>(h, pooled, rsl, tw + 8 * hf, seq0, ri0 + 8 * hf, lane); __builtin_amdgcn_sched_barrier(0);
        }
        __syncthreads();
    }
}

__device__ __forceinline__ void final_norm(const bf16_t* __restrict__ h, const float* __restrict__ gfin, float* __restrict__ out, int G, int wave, int lane) {
    f32x4 gv[4];
#pragma unroll
    for (int j = 0; j < 4; ++j) gv[j] = *((const f32x4*)gfin + 4 * lane + j);
    for (int row = blockIdx.x * NWAVES + wave; row < T; row += G * NWAVES) {
        const u32x4* x = (const u32x4*)(h + (size_t)row * D) + 2 * lane; f32x4 v[4]; float s = 0.f;
        unpack8(x[0], v[0], v[1]); unpack8(x[1], v[2], v[3]);
#pragma unroll
        for (int j = 0; j < 4; ++j) s += (v[j][0] * v[j][0] + v[j][1] * v[j][1]) + (v[j][2] * v[j][2] + v[j][3] * v[j][3]);
        const float rsv = 1.0f / sqrtf(wave_sum(s) * (1.0f / D) + EPS);
        f32x4* o = (f32x4*)(out + (size_t)row * D) + 4 * lane;
#pragma unroll
        for (int j = 0; j < 4; ++j) o[j] = v[j] * rsv * gv[j];
    }
}

template <bool UP>
__device__ __forceinline__ int moe_tables(LAS unsigned char* lds_all, const unsigned* cnt, const int* __restrict__ list, const float* __restrict__ rs, const float* __restrict__ wts, int G, int c) {
    LAS int* tpre = (LAS int*)(lds_all + TAB_OFF);
    int tid_ = threadIdx.x; asm volatile("" : "+v"(tid_));
    const int tid = tid_;
    if (tid < 64) {
        const int nt = ((int)cnt[tid] + 255) >> 8; int incl = nt;
#pragma unroll
        for (int o = 1; o < 64; o <<= 1) { const int v = __shfl_up(incl, o); if (tid >= o) incl += v; }
        tpre[tid] = incl - nt; if (tid == 63) tpre[NE] = incl;
    }
    __syncthreads();
    const int ntiles = tpre[NE];
    MoeSched<UP> S; S.G = G; S.c = c; S.ntiles = ntiles; S.tpre = tpre; S.A = nullptr; S.W = nullptr;
    Unit u;
    int av[MAXU]; bool vv[MAXU]; int nu = 0;
#pragma unroll
    for (int i = 0; i < MAXU; ++i) { av[i] = -1; vv[i] = false;
        if (S.next_search(i, u)) { nu = i + 1; if (tid == 0) tpre[80 + i] = u.aux;
            if (tid < 256) { const int e = u.aux, idx = (u.pm - tpre[e]) * 256 + tid; vv[i] = idx < (int)cnt[e]; if (vv[i]) av[i] = list[(size_t)e * CAP + idx]; } } }
#pragma unroll
    for (int i = 0; i < MAXU; ++i) if (i < nu && tid < 256) {
        const int a = av[i]; const bool valid = vv[i];
        if (UP) { ((LAS unsigned*)(lds_all + TABA_OFF))[i * 256 + tid] = valid ? (unsigned)(a >> 1) * (unsigned)(D * 2) : 0u; ((LAS float*)(lds_all + TABB_OFF))[i * 256 + tid] = valid ? rs[a >> 1] : 0.f; }
        else { ((LAS int*)(lds_all + TABA_OFF))[i * 256 + tid] = a; ((LAS float*)(lds_all + TABB_OFF))[i * 256 + tid] = valid ? wts[a] : 0.f; }
    }
    __syncthreads();
    return ntiles;
}
constexpr int CWX_CNT = 1024;
constexpr int CWX_BAR = 4096;
constexpr int SEQ_FINAL = 41;
#ifndef FK_PHMASK
#define FK_PHMASK 0x7fff
#endif
#define PH_ON(k) (((FK_PHMASK) >> (k)) & 1)
#ifndef FK_NOPRE
#define FK_NOPRE 0
#endif
#ifndef FK_DUP
#define FK_DUP (-1)
#endif
#define NREP(k) ((FK_DUP == (k)) ? 2 : 1)
#define DUMMY(k, rep) (FK_DUP == (k) && (rep) == 0)
constexpr size_t WS_DUM_F32 = 1270 * MiB, WS_DUM_B16 = 1398 * MiB, WS_DUM_RS = 1527 * MiB;
constexpr size_t WS_HB1 = 1462 * MiB;
constexpr size_t WS_GIMG = 1270 * MiB;

__global__ void __launch_bounds__(NTHREADS, 2) fwd(Ptrs P, int li) {
    extern __shared__ __attribute__((aligned(16))) unsigned char lds_raw[];
    LAS unsigned char* lds = (LAS unsigned char*)lds_raw;
    const int tid = threadIdx.x, lane_k = tid & 63, wave_k = __builtin_amdgcn_readfirstlane(tid >> 6);
    const int G_k = gridDim.x, bid_k = blockIdx.x;
    const int vcu_k = (G_k % 8 == 0) ? (bid_k % 8) * (G_k / 8) + bid_k / 8 : bid_k;
#define PHV int lane = lane_k, wave = wave_k, G = G_k, bid = bid_k, vcu = vcu_k; asm volatile("" : "+v"(lane), "+s"(wave), "+s"(G), "+s"(bid), "+s"(vcu)); (void)lane; (void)wave; (void)G; (void)bid; (void)vcu;
    volatile LAS unsigned* MISC = (volatile LAS unsigned*)(lds + MISC_OFF);
    if (tid < 16) MISC[tid] = 0u;
    __syncthreads();
    const int lo = P.ph_lo, hi = P.ph_hi;
    XcdBarrier bar; bar.bar = (unsigned*)(P.ws + WS_CTL) + CWX_BAR + li * XCD_BAR_WORDS; bar.x = 0; bar.st = MISC + 8;
    if (hi - lo > 1) bar = xcd_barrier_post((unsigned*)(P.ws + WS_CTL) + CWX_BAR + li * XCD_BAR_WORDS, MISC + 8);
#define IN(s) (lo <= (s) && (s) < hi)
#define BAR_AFTER(s) do { if (hi > (s) + 1) xcd_barrier(bar); } while (0)
#define KA (*kargs())
#define WSP(off) (KA.ws + (off))
#define WIN ((bf16_t*)WSP(WS_WIN))
#define WLR ((bf16_t*)WSP(WS_WLR))
#define WOUT ((bf16_t*)WSP(WS_WOUT))
#define WPOOL ((bf16_t*)WSP(WS_WPOOL))
#define WR ((bf16_t*)WSP(WS_WR))
#define WPG ((bf16_t*)WSP(WS_WPG))
#define WPP ((bf16_t*)WSP(WS_WPP))
#define WGU ((bf16_t*)WSP(WS_WGU))
#define WD ((bf16_t*)WSP(WS_WD))
#define PB ((bf16_t*)WSP(WS_PB))
#define HB ((bf16_t*)WSP(WS_HB))
#define PROJ ((bf16_t*)WSP(WS_PROJ))
#define OG ((bf16_t*)WSP(WS_OG))
#define PP ((bf16_t*)WSP(WS_PP))
#define H2 ((bf16_t*)WSP(WS_H2))
#define Y ((bf16_t*)WSP(WS_Y))
#define LIST ((int*)WSP(WS_LIST))
#define RS ((float*)WSP(WS_RS))
#define LR ((float*)WSP(WS_LR))
#define SSP ((float*)WSP(WS_SSP))
#define WTS ((float*)WSP(WS_WTS))
#define CNT ((unsigned*)WSP(WS_CTL) + CWX_CNT)

    if (PH_ON(0) && IN(0)) for (int rep = 0; rep < NREP(0); ++rep) { PHV prologue(KA, lds, vcu, G, wave, lane); BAR_AFTER(0); }

    for (int L = 0; L < 4; ++L) {
        const int base = 1 + 10 * L, j = L >> 1;
#define HCUR ((bf16_t*)WSP((L & 1) ? WS_HB1 : WS_HB))
#define HNXT ((bf16_t*)WSP((L & 1) ? WS_HB : WS_HB1))
        if ((L & 1) == 0) {
            if (PH_ON(1) && IN(base + 0)) for (int rep = 0; rep < NREP(1); ++rep) { PHV
                if (L == 0) np_pass<0, true>(lds, KA.in[0], HCUR, RS, WLR + (size_t)j * 2 * 16 * D, LR, nullptr, nullptr, nullptr, nullptr, nullptr, nullptr, G, wave, lane);
                else np_pass<0, false>(lds, HCUR, nullptr, RS, WLR + (size_t)j * 2 * 16 * D, LR, nullptr, nullptr, nullptr, nullptr, nullptr, nullptr, G, wave, lane);
                BAR_AFTER(base + 0); }
            if (PH_ON(2) && IN(base + 1)) for (int rep = 0; rep < NREP(2); ++rep) { PHV DenseSched S; S.init(HCUR, D, WIN + (size_t)j * NPROJ * D, T, NPROJ, D, G, bid, 0); EpiBf16Rs E{PROJ, NPROJ, RS}; gemm_phase(lds, D, D, S, E); BAR_AFTER(base + 1); }
            if (PH_ON(3) && IN(base + 2)) for (int rep = 0; rep < NREP(3); ++rep) { PHV
                for (int r2 = 0; r2 < NREP(15) && !FK_NOPRE; ++r2) { gla_pre(lds, PROJ, LR, KA.in[7] + (size_t)j * 16 * 512, KA.in[8] + j * 512, WSP(WS_GIMG), vcu, G, wave, lane); xcd_barrier(bar); }
                if (FK_DUP == 16) { gla_scan<0>(lds, PROJ, WSP(WS_GIMG), (bf16_t*)WSP(WS_DUM_B16), (float*)WSP(WS_DUM_RS), vcu, G, wave, lane); xcd_barrier(bar); }
                gla_scan<0>(lds, PROJ, WSP(WS_GIMG), OG, SSP, vcu, G, wave, lane);
                BAR_AFTER(base + 2); }
            if (PH_ON(4) && IN(base + 3)) for (int rep = 0; rep < NREP(4); ++rep) { PHV e1_pass(OG, DUMMY(4, rep) ? (bf16_t*)WSP(WS_DUM_B16) : OG, SSP, G); BAR_AFTER(base + 3); }
            if (PH_ON(5) && IN(base + 4)) for (int rep = 0; rep < NREP(5); ++rep) { PHV DenseSched S; S.init(OG, D, WOUT + (size_t)j * D * D, T, D, D, G, bid, 0);
                if (L == 0) { EpiResid<true> E{KA.in[0], DUMMY(5, rep) ? (bf16_t*)WSP(WS_DUM_B16) : HCUR}; gemm_phase(lds, D, D, S, E); }
                else { EpiResid<false> E{HCUR, DUMMY(5, rep) ? (bf16_t*)WSP(WS_DUM_B16) : HCUR}; gemm_phase(lds, D, D, S, E); }
                BAR_AFTER(base + 4); }
        } else {
            if (PH_ON(6) && IN(base + 0)) for (int rep = 0; rep < NREP(6); ++rep) { PHV pool_pass(lds, HCUR, PROJ, G, wave, lane); BAR_AFTER(base + 0); }
            if (PH_ON(7) && IN(base + 1)) { PHV DenseSched S; S.init(PROJ, D, WPOOL + (size_t)j * D * 256, T, D, 256, G, bid, 256); EpiPool E{HCUR, KA.in[12] + j * D, KA.in[13] + j * D}; gemm_phase(lds, 256, D, S, E); BAR_AFTER(base + 1); }
        }
        if (PH_ON(8) && IN(base + 5)) for (int rep = 0; rep < NREP(8); ++rep) { PHV np_pass<1, false>(lds, HCUR, nullptr, DUMMY(8, rep) ? (float*)WSP(WS_DUM_RS) : RS, WR + (size_t)L * 2 * 80 * D, nullptr, nullptr, KA.in[15] + L * 8, KA.in[17] + L * 64, CNT + L * 64, LIST, WTS, G, wave, lane, !DUMMY(8, rep)); BAR_AFTER(base + 5); }
        if (IN(base + 6)) {
            if (PH_ON(9)) for (int rep = 0; rep < NREP(9); ++rep) { PHV DenseSched S; S.init(PB + (size_t)L * T * PLE, PLE, WPP + (size_t)L * D * PLE, T, D, PLE, G, bid, 0); EpiBf16Rs E{PP, D, nullptr}; gemm_phase(lds, PLE, PLE, S, E); if (DUMMY(9, rep)) xcd_barrier(bar); }
            if (PH_ON(10)) for (int rep = 0; rep < NREP(10); ++rep) { PHV const int ntiles = moe_tables<true>(lds, CNT + L * 64, LIST, RS, WTS, G, vcu);
              MoeSched<true> S; S.A = HCUR; S.W = WGU + (size_t)L * NE * 768 * D; S.G = G; S.c = vcu; S.ntiles = ntiles; S.tpre = (const LAS int*)(lds + TAB_OFF);
              EpiUp E{H2}; gemm_phase(lds, D, D, S, E); if (DUMMY(10, rep)) xcd_barrier(bar); }
            BAR_AFTER(base + 6);
        }
        if (PH_ON(11) && IN(base + 7)) for (int rep = 0; rep < NREP(11); ++rep) { PHV
            const int ntiles = moe_tables<false>(lds, CNT + L * 64, LIST, RS, WTS, G, vcu);
            MoeSched<false> S; S.A = H2; S.W = WD + (size_t)L * NE * D * DFF; S.G = G; S.c = vcu; S.ntiles = ntiles; S.tpre = (const LAS int*)(lds + TAB_OFF);
            EpiDown E{Y}; gemm_phase(lds, DFF, DFF, S, E);
            BAR_AFTER(base + 7);
        }
        if (PH_ON(12) && IN(base + 8)) { PHV np_pass<2, false>(lds, nullptr, HCUR, RS, nullptr, nullptr, Y, nullptr, nullptr, nullptr, nullptr, nullptr, G, wave, lane); BAR_AFTER(base + 8); }
        if (PH_ON(13) && IN(base + 9)) for (int rep = 0; rep < NREP(13); ++rep) { PHV DenseSched S; S.init(HCUR, D, WPG + (size_t)L * D * D, T, D, D, G, bid, 0); EpiPle E{HCUR, DUMMY(13, rep) ? (bf16_t*)WSP(WS_DUM_B16) : HNXT, RS, PP}; gemm_phase(lds, D, D, S, E); BAR_AFTER(base + 9); }
    }
    if (PH_ON(14) && IN(SEQ_FINAL)) { PHV final_norm((const bf16_t*)WSP(WS_HB), KA.in[5], KA.out, G, wave, lane); }
#undef HCUR
#undef HNXT
#undef IN
#undef BAR_AFTER
}
}


#ifndef FK_DIAG
#define FK_DIAG 0
#endif
#if FK_DIAG
__global__ void __launch_bounds__(256) k_cksum(const unsigned* __restrict__ p, size_t nwords4, unsigned long long* slot) {
    unsigned long long s = 0;
    for (size_t i = (size_t)blockIdx.x * 256 + threadIdx.x; i < nwords4; i += (size_t)gridDim.x * 256) { const uint4 v = ((const uint4*)p)[i]; s += (unsigned long long)v.x + v.y + v.z + v.w; }
    for (int o = 32; o; o >>= 1) s += __shfl_xor(s, o);
    if ((threadIdx.x & 63) == 0) atomicAdd(slot, s);
}
__global__ void __launch_bounds__(256) k_verdict(const unsigned long long* cs, int nph, float* out, size_t n) {
    __shared__ float code;
    if (threadIdx.x == 0) { int first = -1; for (int s = 0; s < nph; ++s) if (cs[s] != cs[64 + s] && first < 0) first = s; code = (first < 0) ? 100.0f : (float)(3 + first); }
    __syncthreads();
    for (size_t i = (size_t)blockIdx.x * 256 + threadIdx.x; i < n; i += (size_t)gridDim.x * 256) out[i] = code;
}
#endif
#ifndef FK_PER_PHASE
#define FK_PER_PHASE 0
#endif
extern "C" void kernel_launch(void* const* d_in, const int* in_sizes, int n_in, void* d_out, int out_size, void* d_ws, size_t ws_size, hipStream_t stream) {
    using namespace fk;
    static int grid = 0;
    if (grid == 0) {
        if (n_in != 23 || in_sizes[0] != T * D || out_size != T * D || ws_size < 1534 * MiB) { fprintf(stderr, "kernel_launch: unexpected shapes (n_in %d, out %d, ws %zu)\n", n_in, out_size, ws_size); grid = -1; return; }
        int dev = 0, cus = 0, per_cu = 0;
        if (hipGetDevice(&dev) != hipSuccess || hipDeviceGetAttribute(&cus, hipDeviceAttributeMultiprocessorCount, dev) != hipSuccess) { grid = -1; return; }
        if (hipFuncSetAttribute((const void*)fwd, hipFuncAttributeMaxDynamicSharedMemorySize, LDS_BYTES) != hipSuccess) { fprintf(stderr, "kernel_launch: hipFuncSetAttribute failed\n"); grid = -1; return; }
        if (hipOccupancyMaxActiveBlocksPerMultiprocessor(&per_cu, (const void*)fwd, NTHREADS, LDS_BYTES) != hipSuccess || per_cu < 1) fprintf(stderr, "kernel_launch: occupancy query says %d\n", per_cu);
        (void)hipGetLastError();
        grid = cus;
    }
    if (grid < 0) return;
    (void)hipMemsetAsync((char*)d_ws + WS_CTL, 0, CTL_ZERO_BYTES, stream);
    Ptrs P; memset(&P, 0, sizeof(P));
    for (int i = 0; i < 23; ++i) P.in[i] = (const float*)d_in[i];
    P.out = (float*)d_out; P.ws = (unsigned char*)d_ws;
#if FK_PER_PHASE
    int li = 0;
#if FK_DIAG
    unsigned long long* cs = (unsigned long long*)((char*)d_ws + WS_END);
    (void)hipMemsetAsync(cs, 0, 2 * 64 * 8, stream);
    for (int run = 0; run < 2; ++run) {
    if (run == 0) (void)hipMemsetAsync((char*)d_ws + 2 * MiB, 0xAA, WS_END - 2 * MiB, stream);
    (void)hipMemsetAsync((char*)d_ws + WS_CTL, 0, CTL_ZERO_BYTES, stream);
    int nph = 0;
#endif
    for (int s = 0; s <= SEQ_FINAL; ++s) {
        const int L = (s - 1) / 10, k = (s - 1) % 10;
        if (s >= 1 && s < SEQ_FINAL && (L & 1) == 1 && k >= 2 && k <= 4) continue;
        P.ph_lo = s; P.ph_hi = s + 1;
        hipLaunchKernelGGL(fwd, dim3(grid), dim3(NTHREADS), LDS_BYTES, stream, P, li);
#if FK_DIAG
        {
            struct Reg { size_t off, bytes; int is_out; };
            Reg regs[4]; int nr = 0;
            auto W = [&](size_t off, size_t bytes) { regs[nr++] = Reg{off, bytes, 0}; };
            auto O = [&]() { regs[nr++] = Reg{0, (size_t)T * D * 4, 1}; };
            if (s == 0) W(WS_WIN, WS_HB - WS_WIN);
            else if (s == SEQ_FINAL) O();
            else if ((L & 1) == 0 && k == 0) { W(WS_HB, 64 * MiB); W(WS_RS, MiB / 8); W(WS_LR, 2 * MiB); }
            else if ((L & 1) == 0 && k == 1) W(WS_PROJ, 192 * MiB);
            else if ((L & 1) == 0 && k == 2) { W(WS_OG, 64 * MiB); W(WS_SSP, 4 * MiB); }
            else if ((L & 1) == 0 && k == 3) W(WS_OG, 64 * MiB);
            else if ((L & 1) == 0 && k == 4) O();
            else if ((L & 1) == 1 && k == 0) W(WS_PROJ, 64 * MiB);
            else if ((L & 1) == 1 && k == 1) O();
            else if (k == 5) { W(WS_HB, 64 * MiB); W(WS_RS, MiB / 8); W(WS_WTS, MiB / 4); }
            else if (k == 6) W(WS_PP, 64 * MiB);
            else if (k == 7) W(WS_Y, 128 * MiB);
            else if (k == 8) { O(); W(WS_HB, 64 * MiB); W(WS_RS, MiB / 8); }
            else if (k == 9) O();
            for (int q = 0; q < nr; ++q)
                hipLaunchKernelGGL(k_cksum, dim3(2048), dim3(256), 0, stream, regs[q].is_out ? (const unsigned*)d_out : (const unsigned*)((char*)d_ws + regs[q].off), regs[q].bytes / 16, cs + run * 64 + nph);
        }
        ++nph;
#endif
    }
#if FK_DIAG
    if (run == 1) hipLaunchKernelGGL(k_verdict, dim3(1024), dim3(256), 0, stream, cs, nph, (float*)d_out, (size_t)T * D);
    }
#endif
#else
    P.ph_lo = 0; P.ph_hi = SEQ_FINAL + 1;
    hipLaunchKernelGGL(fwd, dim3(grid), dim3(NTHREADS), LDS_BYTES, stream, P, 0);
#endif
}
```

```cpp
#include <hip/hip_runtime.h>
#include <stdint.h>
#include <stdio.h>
#include <string.h>
namespace fk {
#define LAS __attribute__((address_space(3)))
#define GAS __attribute__((address_space(1)))
typedef unsigned short bf16_t;
typedef short bf16x8 __attribute__((ext_vector_type(8)));
typedef float f32x4 __attribute__((ext_vector_type(4)));
typedef float f32x2 __attribute__((ext_vector_type(2)));
typedef unsigned u32x4 __attribute__((ext_vector_type(4)));
typedef unsigned u32x2 __attribute__((ext_vector_type(2)));

constexpr int T = 32768, D = 1024, SEQ = 2048, NB = 16, DFF = 384, NE = 64, PLE = 256, GIN = 3088, NPROJ = 3072;
constexpr int CAP = 65536;
constexpr float EPS = 1e-6f;
constexpr int NWAVES = 8, NTHREADS = 512;

constexpr size_t MiB = (size_t)1 << 20;
constexpr size_t WS_CTL = 0, CTL_ZERO_BYTES = 1 * MiB;
constexpr size_t WS_WIN = 2 * MiB;
constexpr size_t WS_WLR = 14 * MiB;
constexpr size_t WS_WOUT = 15 * MiB;
constexpr size_t WS_WPOOL = 19 * MiB;
constexpr size_t WS_WR = 20 * MiB;
constexpr size_t WS_WPG = 22 * MiB;
constexpr size_t WS_WPP = 30 * MiB;
constexpr size_t WS_WGU = 32 * MiB;
constexpr size_t WS_WD = 416 * MiB;
constexpr size_t WS_PB = 608 * MiB;
constexpr size_t WS_HB = 672 * MiB;
constexpr size_t WS_PROJ = 736 * MiB;
constexpr size_t WS_OG = 928 * MiB;
constexpr size_t WS_PP = 992 * MiB;
constexpr size_t WS_H2 = 1056 * MiB;
constexpr size_t WS_Y = 1116 * MiB;
constexpr size_t WS_LIST = 1244 * MiB;
constexpr size_t WS_RS = 1260 * MiB;
constexpr size_t WS_LR = 1261 * MiB;
constexpr size_t WS_SSP = 1263 * MiB;
constexpr size_t WS_WTS = 1267 * MiB;
constexpr size_t WS_END = 1268 * MiB;
constexpr int CW_BAR = 4096;
constexpr int CW_CNT = 8192;

constexpr int STAGE_BYTES = 131072;
constexpr int TAB_OFF = STAGE_BYTES;
constexpr int MAXU = 6;
constexpr int TABA_OFF = TAB_OFF + 512, TABB_OFF = TABA_OFF + MAXU * 1024;
constexpr int MISC_OFF = TABB_OFF + MAXU * 1024;
constexpr int LDS_BYTES = MISC_OFF + 256;
static_assert(LDS_BYTES <= 160 * 1024, "LDS");

#define LDS_WAIT() asm volatile("s_waitcnt lgkmcnt(0)" ::: "memory")
#define VM_WAIT() asm volatile("s_waitcnt vmcnt(0)" ::: "memory")
typedef __bf16 bf16x2_t __attribute__((ext_vector_type(2)));
__device__ __forceinline__ unsigned cvt_pk_bf16(float lo, float hi) { const bf16x2_t b = __builtin_convertvector((f32x2){lo, hi}, bf16x2_t); return __builtin_bit_cast(unsigned, b); }
__device__ __forceinline__ float bf_lo(unsigned w) { return __uint_as_float(w << 16); }
__device__ __forceinline__ float bf_hi(unsigned w) { return __uint_as_float(w & 0xffff0000u); }
__device__ __forceinline__ float wave_sum(float v) {
#pragma unroll
    for (int o = 1; o < 64; o <<= 1) v += __shfl_xor(v, o);
    return v;
}
__device__ __forceinline__ float fsigmoid(float x) { return __builtin_amdgcn_rcpf(1.0f + __expf(-x)); }
__device__ __forceinline__ float fsilu(float x) { return x * fsigmoid(x); }

#define XB_TMO      128
#define XB_XCNT(j)  (256  + 64 * (j))
#define XB_XSUB(j)  (1280 + 64 * (j))
#define XB_XGEN(j)  (2304 + 64 * (j))
#define XB_TOP      3328
#define XB_TOPGEN   3392
#define XCD_BAR_WORDS 3456
#define XB_SPIN_CAP (1u << 18)
__device__ __forceinline__ unsigned xb_ld(unsigned* p)              { return __hip_atomic_load(p, __ATOMIC_RELAXED, __HIP_MEMORY_SCOPE_AGENT); }
__device__ __forceinline__ unsigned xb_add(unsigned* p, unsigned v) { return __hip_atomic_fetch_add(p, v, __ATOMIC_RELAXED, __HIP_MEMORY_SCOPE_AGENT); }
__device__ __forceinline__ unsigned xb_xcc_id() { return (unsigned)__builtin_amdgcn_s_getreg((3 << 11) | 20) & 0xFu; }
#define XB_SPIN(cond, bar) do { unsigned _sp = 0; while (cond) { __builtin_amdgcn_s_sleep(1); \
    if ((++_sp & 255u) == 0u) { if (xb_ld(&(bar)[XB_TMO])) break; if (_sp > XB_SPIN_CAP) { atomicAdd(&(bar)[XB_TMO], 1u); break; } } } } while (0)
struct XcdBarrier { unsigned* bar; unsigned x; volatile LAS unsigned* st; };
__device__ __forceinline__ XcdBarrier xcd_barrier_post(unsigned* bar, volatile LAS unsigned* st) {
    XcdBarrier b; b.bar = bar; b.x = xb_xcc_id(); b.st = st;
    if (threadIdx.x == 0) (void)xb_add(&bar[XB_XCNT(b.x)], 1u);
    return b;
}
__device__ __forceinline__ void xcd_barrier_complete(unsigned* bar, unsigned x, unsigned& nloc, unsigned& nx) {
    const unsigned G = gridDim.x * gridDim.y * gridDim.z;
    unsigned sum, cnt, mine, sp = 0u;
    for (;;) {
        sum = 0u; cnt = 0u; mine = 0u;
#pragma unroll
        for (unsigned j = 0; j < 16; ++j) { const unsigned c = xb_ld(&bar[XB_XCNT(j)]); sum += c; cnt += (c > 0u) ? 1u : 0u; mine = (j == x) ? c : mine; }
        if (sum == G) break;
        __builtin_amdgcn_s_sleep(1);
        if ((++sp & 255u) == 0u) { if (xb_ld(&bar[XB_TMO])) break; if (sp > XB_SPIN_CAP) { atomicAdd(&bar[XB_TMO], 1u); break; } }
    }
    nloc = mine > 0u ? mine : 1u; nx = cnt > 0u ? cnt : 1u;
}
__device__ __forceinline__ void xcd_barrier(const XcdBarrier& b) {
    asm volatile("s_waitcnt vmcnt(0)" ::: "memory");
    __syncthreads();
    if (threadIdx.x == 0) {
        unsigned* bar = b.bar;
        __builtin_amdgcn_s_waitcnt(0);
        unsigned nloc = b.st[0], nx = b.st[1];
        if (nloc == 0u) { xcd_barrier_complete(bar, b.x, nloc, nx); b.st[0] = nloc; b.st[1] = nx; }
        const unsigned old = xb_add(&bar[XB_XSUB(b.x)], 1u);
        const unsigned gen = old / nloc;
        if (old + 1u == (gen + 1u) * nloc) {
            __builtin_amdgcn_fence(__ATOMIC_RELEASE, "agent");
            asm volatile("s_waitcnt vmcnt(0)" ::: "memory");
            const unsigned og = xb_add(&bar[XB_TOP], 1u);
            const unsigned tg = og / nx;
            if (og + 1u == (tg + 1u) * nx) xb_add(&bar[XB_TOPGEN], 1u);
            else XB_SPIN(xb_ld(&bar[XB_TOPGEN]) == tg, bar);
            __builtin_amdgcn_fence(__ATOMIC_ACQUIRE, "agent");
            xb_add(&bar[XB_XGEN(b.x)], 1u);
            asm volatile("s_waitcnt vmcnt(0)" ::: "memory");
        } else {
            XB_SPIN(xb_ld(&bar[XB_XGEN(b.x)]) == gen, bar);
            __builtin_amdgcn_fence(__ATOMIC_ACQUIRE, "agent");
            asm volatile("s_waitcnt vmcnt(0)" ::: "memory");
        }
    }
    __syncthreads();
}

constexpr int BM = 256, BK = 64, HALF = 128, HTB = HALF * BK * 2, NXCD = 8, WGM = 8;
__device__ __forceinline__ int lds_byte(int r, int c) { const int st = (r >> 4) * 2 + (c >> 5), rr = r & 15, cc = c & 31, ob = rr * 64 + cc * 2; return st * 1024 + (ob ^ (((ob >> 9) & 1) << 5)); }
__device__ __forceinline__ void stage_rc(int b, int& R, int& C) { const int st = b / 1024, sb = b % 1024, swz = sb ^ (((sb >> 9) & 1) << 5); R = (st >> 1) * 16 + swz / 64; C = (st & 1) * 32 + (swz % 64) / 2; }
__device__ __forceinline__ int perm32(int rho) { const int n = rho >> 4, i = rho & 15; return 8 * (i >> 2) + 4 * n + (i & 3); }

struct Unit { int pm, pn, ui, aux; };

struct DenseSched {
    static constexpr bool GATHER = false;
    const bf16_t* A; const bf16_t* Bt; int lda, K, acol_per_pn;
    int nM, nN, nwg, G, c;
    __device__ __forceinline__ void init(const bf16_t* A_, int lda_, const bf16_t* Bt_, int M, int N, int K_, int G_, int c_, int acol_per_pn_) {
        A = A_; Bt = Bt_; lda = lda_; K = K_; acol_per_pn = acol_per_pn_; nM = M / BM; nN = N / BM; nwg = nM * nN; G = G_; c = c_; }
    __device__ __forceinline__ bool next(int i, Unit& u) const {
        const long L = (long)i * G + c; if (L >= nwg) return false;
        int wgid = (int)L; { const int q = nwg / NXCD, r = nwg % NXCD, xcd = wgid % NXCD, off = wgid / NXCD; wgid = (xcd < r ? xcd * (q + 1) : r * (q + 1) + (xcd - r) * q) + off; }
        const int nig = WGM * nN, gid = wgid / nig, fm = gid * WGM, gsz = (nM - fm) < WGM ? (nM - fm) : WGM;
        u.pm = fm + ((wgid % nig) % gsz); u.pn = (wgid % nig) / gsz; u.ui = i; u.aux = 0; return true;
    }
    __device__ __forceinline__ const char* a_base(const Unit& u) const { return (const char*)A + ((size_t)u.pm * BM * lda + (size_t)u.pn * acol_per_pn) * 2; }
    __device__ __forceinline__ const char* b_base(const Unit& u) const { return (const char*)Bt + (size_t)u.pn * BM * K * 2; }
    __device__ __forceinline__ void rows(const Unit&, LAS unsigned char*, unsigned (&)[4]) const {}
};
struct FillSched {
    static constexpr bool GATHER = false;
    const bf16_t* A; const bf16_t* Bt; int lda, K, nN, nwg, G, c, rem, KL;
    __device__ __forceinline__ bool next(int i, Unit& u) const {
        const int NA = G - rem, nl = KL * NA < nwg ? KL * NA : nwg;
        int s;
        if (c >= rem) { const int a = c - rem; const int mine = (nl - a + NA - 1) / NA;
            s = (i < mine) ? a + i * NA : nl + c + (i - mine) * G; }
        else s = nl + c + i * G;
        if (s >= nwg) return false;
        u.pm = s / nN; u.pn = s - u.pm * nN; u.ui = i; u.aux = 0; return true;
    }
    __device__ __forceinline__ const char* a_base(const Unit& u) const { return (const char*)A + (size_t)u.pm * BM * lda * 2; }
    __device__ __forceinline__ const char* b_base(const Unit& u) const { return (const char*)Bt + (size_t)u.pn * BM * K * 2; }
    __device__ __forceinline__ void rows(const Unit&, LAS unsigned char*, unsigned (&)[4]) const {}
};
template <bool UP> struct MoeSched {
    static constexpr bool GATHER = UP;
    static constexpr int NTN = UP ? 3 : 4;
    const bf16_t* A; const bf16_t* W; int G, c, ntiles;
    const LAS int* tpre;
    __device__ __forceinline__ bool next(int i, Unit& u) const {
        const int L = i * G + c; if (L >= ntiles * NTN || i >= MAXU) return false;
        const int tile = L / NTN;
        u.pm = tile; u.pn = L - tile * NTN; u.ui = i; u.aux = __builtin_amdgcn_readfirstlane(tpre[80 + i]); return true;
    }
    __device__ __forceinline__ bool next_search(int i, Unit& u) const {
        const int L = i * G + c; if (L >= ntiles * NTN || i >= MAXU) return false;
        const int tile = L / NTN; int e = 0;
        for (int x = 1; x < NE; ++x) e += (tpre[x] <= tile) ? 1 : 0;
        u.pm = tile; u.pn = L - tile * NTN; u.ui = i; u.aux = e; return true;
    }
    __device__ __forceinline__ const char* a_base(const Unit& u) const { return UP ? (const char*)A : (const char*)A + (size_t)u.pm * BM * DFF * 2; }
    __device__ __forceinline__ const char* b_base(const Unit& u) const {
        return UP ? (const char*)W + ((size_t)u.aux * 768 + (size_t)u.pn * BM) * D * 2 : (const char*)W + ((size_t)u.aux * D + (size_t)u.pn * BM) * DFF * 2; }
    __device__ __forceinline__ void rows(const Unit& u, LAS unsigned char* lds_all, unsigned (&v)[4]) const {
        if (UP) { const LAS unsigned* tab = (const LAS unsigned*)(lds_all + TABA_OFF) + u.ui * 256;
#pragma unroll
            for (int i = 0; i < 2; ++i) { int R, C; int tx = threadIdx.x; asm volatile("" : "+v"(tx)); stage_rc(tx * 16 + i * 8192, R, C);
                v[i] = tab[R] + (unsigned)C * 2u; v[2 + i] = tab[HALF + R] + (unsigned)C * 2u; } }
    }
};

#define PG8_SA(b, h) (((b) * 2 + (h)) * HTB)
#define PG8_SB(b, h) ((4 + (b) * 2 + (h)) * HTB)
__device__ __forceinline__ void glds16(const void* gbase, unsigned voff, unsigned lds_dst) {
    unsigned keep;
    asm volatile("s_mov_b32 %0, m0\n\ts_mov_b32 m0, %3\n\ts_nop 0\n\tglobal_load_lds_dwordx4 %1, %2\n\ts_mov_b32 m0, %0" : "=&s"(keep) : "v"(voff), "s"(gbase), "s"(lds_dst) : "memory");
}
#define PG8_STAGE2(bufoff, gbase, o0, o1) do { glds16((gbase), (o0), (unsigned)(bufoff) + ldsw); glds16((gbase), (o1), (unsigned)(bufoff) + ldsw + 8192u); } while (0)
#define PG8_LDA(dst, b, h) do { _Pragma("unroll") for (int m = 0; m < 4; ++m) _Pragma("unroll") for (int k = 0; k < 2; ++k) dst[m][k] = *(const LAS bf16x8*)(lds + PG8_SA(b, h) + aoff + m * 2048 + k * 1024); } while (0)
#define PG8_LDB(dst, b, h) do { _Pragma("unroll") for (int n = 0; n < 2; ++n) _Pragma("unroll") for (int k = 0; k < 2; ++k) dst[n][k] = *(const LAS bf16x8*)(lds + PG8_SB(b, h) + boff + n * 2048 + k * 1024); } while (0)
#define PG8_MMA(ai, bj, At, Bt) do { __builtin_amdgcn_s_setprio(1); _Pragma("unroll") for (int m = 0; m < 4; ++m) _Pragma("unroll") for (int n = 0; n < 2; ++n) _Pragma("unroll") for (int k = 0; k < 2; ++k) \
        acc[ai][bj][m][n] = __builtin_amdgcn_mfma_f32_16x16x32_bf16(Bt[n][k], At[m][k], acc[ai][bj][m][n], 0, 0, 0); __builtin_amdgcn_s_setprio(0); } while (0)
#define PG8_WAIT_V(n) asm volatile("s_waitcnt vmcnt(" #n ")" ::: "memory")
#define PG8_WAIT_L(n) asm volatile("s_waitcnt lgkmcnt(" #n ")" ::: "memory")
#define PG8_BAR __builtin_amdgcn_s_barrier()
#define PG8_SCHED __builtin_amdgcn_sched_barrier(0)

struct NoHook { static constexpr bool ACTIVE = false; };
struct HeadScaleHook {
    static constexpr bool ACTIVE = true;
    const float* ssp;
    __device__ __forceinline__ void fill(const Unit& u, LAS unsigned char* lds_all, int parity) const {
        int tx = threadIdx.x; asm volatile("" : "+v"(tx));
        if (tx < 256) { const size_t row = (size_t)u.pm * BM + tx; float rh[4];
#pragma unroll
            for (int hd = 0; hd < 4; ++hd) { const float sq = (ssp[(size_t)(hd * 4 + 0) * T + row] + ssp[(size_t)(hd * 4 + 1) * T + row]) + (ssp[(size_t)(hd * 4 + 2) * T + row] + ssp[(size_t)(hd * 4 + 3) * T + row]);
                rh[hd] = 1.0f / sqrtf(sq * (1.0f / 256.0f) + EPS); }
            ((LAS f32x4*)(lds_all + TABA_OFF))[parity * 256 + tx] = (f32x4){rh[0] / rh[1], rh[1] / rh[2], rh[2] / rh[3], rh[3]}; }
    }
    __device__ __forceinline__ void rescale(f32x4 (&acc)[2][2][4][2], int which, LAS unsigned char* lds_all, int parity, int wr, int fr) const {
        const LAS float* tab = (const LAS float*)(lds_all + TABA_OFF) + parity * 1024;
#pragma unroll
        for (int ai = 0; ai < 2; ++ai)
#pragma unroll
            for (int m = 0; m < 4; ++m) { const float f = tab[(ai * HALF + wr * 64 + m * 16 + fr) * 4 + which];
#pragma unroll
                for (int bj = 0; bj < 2; ++bj)
#pragma unroll
                    for (int n = 0; n < 2; ++n) acc[ai][bj][m][n] *= f; }
    }
};

template <class Epi, class Sched, class Hook = NoHook>
__device__ __forceinline__ void gemm_phase(LAS unsigned char* lds_all, const int K, const int lda, const Sched& S, const Epi& E, const Hook H = Hook()) {
    LAS unsigned char* lds = lds_all;
    int tid_ = threadIdx.x; asm volatile("" : "+v"(tid_));
    const int tid = tid_, wid = __builtin_amdgcn_readfirstlane(tid >> 6), lane = tid & 63, wr = wid >> 2, wc = wid & 3, fr = lane & 15, fq = lane >> 4;
    const int nt = K / BK;
    unsigned vB[2], vA[4];
#pragma unroll
    for (int i = 0; i < 2; ++i) { int Rr, Cc; stage_rc(tid * 16 + i * 8192, Rr, Cc); const int Rb = Epi::PERM ? ((Rr & ~31) + perm32(Rr & 31)) : Rr;
        vB[i] = (unsigned)(Rb * K + Cc) * 2u; vA[i] = (unsigned)(Rr * lda + Cc) * 2u; vA[2 + i] = vA[i] + (unsigned)(HALF * lda) * 2u; }
    const size_t kstep = (size_t)(BK * 2);
    const size_t hstepB = (size_t)HALF * K * 2;
    const unsigned ldsw = (unsigned)wid * 1024u;
    const int aoff = lds_byte(wr * 64 + fr, fq * 8), boff = lds_byte(wc * 32 + fr, fq * 8);
    Unit cur, nxt; int ui = 0;
    if (!S.next(0, cur)) return;
    f32x4 acc[2][2][4][2];
#pragma unroll
    for (int a = 0; a < 2; ++a)
#pragma unroll
        for (int b = 0; b < 2; ++b)
#pragma unroll
            for (int m = 0; m < 4; ++m)
#pragma unroll
                for (int n = 0; n < 2; ++n) acc[a][b][m][n] = (f32x4){0.f, 0.f, 0.f, 0.f};
    bf16x8 At[4][2], B0[2][2], B1[2][2];
    const char* cA = S.a_base(cur); const char* cB = S.b_base(cur);
    if constexpr (Sched::GATHER) S.rows(cur, lds_all, vA);
    if constexpr (Hook::ACTIVE) { H.fill(cur, lds_all, 0); Unit u1; if (S.next(1, u1)) H.fill(u1, lds_all, 1); PG8_WAIT_L(0); }
    PG8_STAGE2(PG8_SB(0, 0), cB, vB[0], vB[1]); PG8_STAGE2(PG8_SB(0, 1), cB + hstepB, vB[0], vB[1]); PG8_STAGE2(PG8_SA(0, 0), cA, vA[0], vA[1]); PG8_STAGE2(PG8_SA(0, 1), cA, vA[2], vA[3]);
    if (wr == 1) PG8_BAR;
    PG8_WAIT_V(2); PG8_BAR;
    PG8_STAGE2(PG8_SB(1, 0), cB + kstep, vB[0], vB[1]); PG8_STAGE2(PG8_SA(1, 0), cA + kstep, vA[0], vA[1]); PG8_STAGE2(PG8_SB(1, 1), cB + hstepB + kstep, vB[0], vB[1]);
    PG8_WAIT_V(6); PG8_BAR;
    for (;;) {
        const bool has_next = S.next(ui + 1, nxt);
        const char* nA = has_next ? S.a_base(nxt) : cA; const char* nB = has_next ? S.b_base(nxt) : cB;
#pragma unroll 1
        for (int t = 0; t < nt; t += 2) {
            const bool last = (t == nt - 2);
            const char* a1 = cA + (size_t)(t + 1) * kstep;
            const char* a2 = last ? nA : cA + (size_t)(t + 2) * kstep; const char* b2 = last ? nB : cB + (size_t)(t + 2) * kstep;
            const char* a3 = a2 + kstep; const char* b3 = b2 + kstep;
            if constexpr (Hook::ACTIVE) { if (t == 2 && has_next && ui + 1 >= 2) H.fill(nxt, lds_all, (ui + 1) & 1); if (t >= 4 && (t & 3) == 0) H.rescale(acc, (t >> 2) - 1, lds_all, ui & 1, wr, fr); }
            PG8_LDB(B0, 0, 0); PG8_LDB(B1, 0, 1); PG8_SCHED; PG8_LDA(At, 0, 0); PG8_STAGE2(PG8_SA(1, 1), a1, vA[2], vA[3]);
            PG8_WAIT_V(8); PG8_WAIT_L(0); PG8_BAR; PG8_MMA(0, 0, At, B0); PG8_MMA(0, 1, At, B1); PG8_BAR; PG8_SCHED;
            if constexpr (Sched::GATHER) { if (last && has_next) S.rows(nxt, lds_all, vA); }
            PG8_LDA(At, 0, 1); PG8_STAGE2(PG8_SB(0, 0), b2, vB[0], vB[1]); PG8_STAGE2(PG8_SB(0, 1), b2 + hstepB, vB[0], vB[1]); PG8_STAGE2(PG8_SA(0, 0), a2, vA[0], vA[1]);
            PG8_WAIT_V(8); PG8_WAIT_L(0); PG8_BAR; PG8_MMA(1, 0, At, B0); PG8_MMA(1, 1, At, B1); PG8_BAR; PG8_SCHED;
            PG8_LDB(B0, 1, 0); PG8_LDB(B1, 1, 1); PG8_SCHED; PG8_LDA(At, 1, 0); PG8_STAGE2(PG8_SA(0, 1), a2, vA[2], vA[3]);
            PG8_WAIT_V(8); PG8_WAIT_L(0); PG8_BAR; PG8_MMA(0, 0, At, B0); PG8_MMA(0, 1, At, B1); PG8_BAR; PG8_SCHED;
            PG8_LDA(At, 1, 1); PG8_STAGE2(PG8_SB(1, 0), b3, vB[0], vB[1]); PG8_STAGE2(PG8_SB(1, 1), b3 + hstepB, vB[0], vB[1]); PG8_STAGE2(PG8_SA(1, 0), a3, vA[0], vA[1]);
            PG8_WAIT_V(8); PG8_WAIT_L(0); PG8_BAR; PG8_MMA(1, 0, At, B0); PG8_MMA(1, 1, At, B1); PG8_BAR; PG8_SCHED;
        }
        if (wr == 0) PG8_BAR;
        E(acc, cur, wr, wc, fr, fq, lds_all);
        if (!has_next) break;
#pragma unroll
        for (int a = 0; a < 2; ++a)
#pragma unroll
            for (int b = 0; b < 2; ++b)
#pragma unroll
                for (int m = 0; m < 4; ++m)
#pragma unroll
                    for (int n = 0; n < 2; ++n) acc[a][b][m][n] = (f32x4){0.f, 0.f, 0.f, 0.f};
        cur = nxt; cA = nA; cB = nB; ++ui;
        if (wr == 1) PG8_BAR;
    }
    PG8_WAIT_V(0);
    PG8_BAR;
}

__device__ __forceinline__ u32x4 pack8(const f32x4 v0, const f32x4 v1) { u32x4 w; w.x = cvt_pk_bf16(v0[0], v0[1]); w.y = cvt_pk_bf16(v0[2], v0[3]); w.z = cvt_pk_bf16(v1[0], v1[1]); w.w = cvt_pk_bf16(v1[2], v1[3]); return w; }

struct EpiBf16Rs {
    static constexpr bool PERM = true;
    bf16_t* O; int ldc; const float* rs;
    __device__ __forceinline__ void operator()(const f32x4 (&acc)[2][2][4][2], const Unit& u, int wr, int wc, int fr, int fq, LAS unsigned char*) const {
        const int row0 = u.pm * BM + wr * 64 + fr, col0 = u.pn * BM + wc * 32 + 8 * fq;
#pragma unroll
        for (int ai = 0; ai < 2; ++ai)
#pragma unroll
            for (int m = 0; m < 4; ++m) { const int row = row0 + ai * HALF + m * 16; const float s = rs ? rs[row] : 1.0f; bf16_t* rowp = O + (size_t)row * ldc + col0;
#pragma unroll
                for (int bj = 0; bj < 2; ++bj) *(u32x4*)(rowp + bj * HALF) = pack8(acc[ai][bj][m][0] * s, acc[ai][bj][m][1] * s); }
    }
};
__device__ __forceinline__ void unpack8(const u32x4 w, f32x4& lo, f32x4& hi) { lo = (f32x4){bf_lo(w.x), bf_hi(w.x), bf_lo(w.y), bf_hi(w.y)}; hi = (f32x4){bf_lo(w.z), bf_hi(w.z), bf_lo(w.w), bf_hi(w.w)}; }
template <bool F32IN, bool HS = false> struct EpiResid {
    static constexpr bool PERM = true;
    const void* hin; bf16_t* hout;
    __device__ __forceinline__ void operator()(const f32x4 (&acc)[2][2][4][2], const Unit& u, int wr, int wc, int fr, int fq, LAS unsigned char* lds_all) const {
        const int row0 = u.pm * BM + wr * 64 + fr, col0 = u.pn * BM + wc * 32 + 8 * fq;
        const LAS float* tab = (const LAS float*)(lds_all + TABA_OFF) + (u.ui & 1) * 1024;
#pragma unroll
        for (int ai = 0; ai < 2; ++ai) {
            u32x4 hv[4][2][F32IN ? 2 : 1];
#pragma unroll
            for (int m = 0; m < 4; ++m)
#pragma unroll
                for (int bj = 0; bj < 2; ++bj) { const size_t off = (size_t)(row0 + ai * HALF + m * 16) * D + col0 + bj * HALF;
                    if (F32IN) { hv[m][bj][0] = *(const u32x4*)((const float*)hin + off); hv[m][bj][F32IN ? 1 : 0] = *(const u32x4*)((const float*)hin + off + 4); }
                    else hv[m][bj][0] = *(const u32x4*)((const bf16_t*)hin + off); }
            __builtin_amdgcn_sched_barrier(0);
#pragma unroll
            for (int m = 0; m < 4; ++m) { const float f = HS ? tab[(ai * HALF + wr * 64 + m * 16 + fr) * 4 + 3] : 1.0f;
#pragma unroll
                for (int bj = 0; bj < 2; ++bj) { f32x4 lo, hi;
                    if (F32IN) { lo = __builtin_bit_cast(f32x4, hv[m][bj][0]); hi = __builtin_bit_cast(f32x4, hv[m][bj][F32IN ? 1 : 0]); } else unpack8(hv[m][bj][0], lo, hi);
                    *(u32x4*)(hout + (size_t)(row0 + ai * HALF + m * 16) * D + col0 + bj * HALF) = pack8(lo + acc[ai][bj][m][0] * f, hi + acc[ai][bj][m][1] * f); } }
            __builtin_amdgcn_sched_barrier(0);
        }
    }
};
struct EpiPool {
    static constexpr bool PERM = true;
    bf16_t* h; const float* bias; const float* sc;
    __device__ __forceinline__ void operator()(const f32x4 (&acc)[2][2][4][2], const Unit& u, int wr, int wc, int fr, int fq, LAS unsigned char*) const {
        const int row0 = u.pm * BM + wr * 64 + fr, col0 = u.pn * BM + wc * 32 + 8 * fq;
        f32x4 bv[2][2], sv[2][2];
#pragma unroll
        for (int bj = 0; bj < 2; ++bj) { bv[bj][0] = *(const f32x4*)(bias + col0 + bj * HALF); bv[bj][1] = *(const f32x4*)(bias + col0 + bj * HALF + 4); sv[bj][0] = *(const f32x4*)(sc + col0 + bj * HALF); sv[bj][1] = *(const f32x4*)(sc + col0 + bj * HALF + 4); }
#pragma unroll
        for (int ai = 0; ai < 2; ++ai) {
            u32x4 hv[4][2];
#pragma unroll
            for (int m = 0; m < 4; ++m)
#pragma unroll
                for (int bj = 0; bj < 2; ++bj) hv[m][bj] = *(const u32x4*)(h + (size_t)(row0 + ai * HALF + m * 16) * D + col0 + bj * HALF);
            __builtin_amdgcn_sched_barrier(0);
#pragma unroll
            for (int m = 0; m < 4; ++m)
#pragma unroll
                for (int bj = 0; bj < 2; ++bj) { f32x4 lo, hi; unpack8(hv[m][bj], lo, hi);
                    *(u32x4*)(h + (size_t)(row0 + ai * HALF + m * 16) * D + col0 + bj * HALF) = pack8(lo + (acc[ai][bj][m][0] + bv[bj][0]) * sv[bj][0], hi + (acc[ai][bj][m][1] + bv[bj][1]) * sv[bj][1]); }
            __builtin_amdgcn_sched_barrier(0);
        }
    }
};
struct EpiPle {
    static constexpr bool PERM = true;
    const bf16_t* hin; bf16_t* hout; const float* rs; const bf16_t* pp;
    __device__ __forceinline__ void operator()(const f32x4 (&acc)[2][2][4][2], const Unit& u, int wr, int wc, int fr, int fq, LAS unsigned char*) const {
        const int row0 = u.pm * BM + wr * 64 + fr, col0 = u.pn * BM + wc * 32 + 8 * fq;
#pragma unroll
        for (int ai = 0; ai < 2; ++ai) {
            u32x4 hv[4][2], pv[4][2]; float sr[4];
#pragma unroll
            for (int m = 0; m < 4; ++m) { const int row = row0 + ai * HALF + m * 16; sr[m] = rs[row];
#pragma unroll
                for (int bj = 0; bj < 2; ++bj) { const size_t off = (size_t)row * D + col0 + bj * HALF; hv[m][bj] = *(const u32x4*)(hin + off); pv[m][bj] = *(const u32x4*)(pp + off); } }
            __builtin_amdgcn_sched_barrier(0);
#pragma unroll
            for (int m = 0; m < 4; ++m)
#pragma unroll
                for (int bj = 0; bj < 2; ++bj) { f32x4 lo, hi, plo, phi; unpack8(hv[m][bj], lo, hi); unpack8(pv[m][bj], plo, phi);
                    const f32x4 a0 = acc[ai][bj][m][0] * sr[m], a1 = acc[ai][bj][m][1] * sr[m];
#pragma unroll
                    for (int j = 0; j < 4; ++j) { lo[j] += fsigmoid(a0[j]) * plo[j]; hi[j] += fsigmoid(a1[j]) * phi[j]; }
                    *(u32x4*)(hout + (size_t)(row0 + ai * HALF + m * 16) * D + col0 + bj * HALF) = pack8(lo, hi); }
            __builtin_amdgcn_sched_barrier(0);
        }
    }
};
struct EpiNone { static constexpr bool PERM = true; bf16_t* Y;
    __device__ __forceinline__ void operator()(const f32x4 (&acc)[2][2][4][2], const Unit& u, int, int, int, int, LAS unsigned char*) const { float s = 0.f;
#pragma unroll
        for (int a = 0; a < 2; ++a)
#pragma unroll
            for (int b = 0; b < 2; ++b)
#pragma unroll
                for (int m = 0; m < 4; ++m)
#pragma unroll
                    for (int n = 0; n < 2; ++n) s += acc[a][b][m][n][0] + acc[a][b][m][n][1] + acc[a][b][m][n][2] + acc[a][b][m][n][3];
        if (s == 1.2345f) Y[u.pm] = 1; } };
struct EpiUp {
    static constexpr bool PERM = true;
    bf16_t* H;
    __device__ __forceinline__ void operator()(const f32x4 (&acc)[2][2][4][2], const Unit& u, int wr, int wc, int fr, int fq, LAS unsigned char* lds_all) const {
        const LAS float* rst = (const LAS float*)(lds_all + TABB_OFF) + u.ui * 256;
        const int r0 = wr * 64 + fr, col0 = u.pn * HALF + wc * 32 + 8 * fq;
#pragma unroll
        for (int ai = 0; ai < 2; ++ai)
#pragma unroll
            for (int m = 0; m < 4; ++m) { const int r = r0 + ai * HALF + m * 16; const float s = rst[r];
                f32x4 h0, h1;
#pragma unroll
                for (int j = 0; j < 4; ++j) { h0[j] = fsilu(acc[ai][0][m][0][j] * s) * (acc[ai][1][m][0][j] * s); h1[j] = fsilu(acc[ai][0][m][1][j] * s) * (acc[ai][1][m][1][j] * s); }
                *(u32x4*)(H + ((size_t)u.pm * BM + r) * DFF + col0) = pack8(h0, h1); }
    }
};
struct EpiDown {
    static constexpr bool PERM = true;
    bf16_t* Y;
    __device__ __forceinline__ void operator()(const f32x4 (&acc)[2][2][4][2], const Unit& u, int wr, int wc, int fr, int fq, LAS unsigned char* lds_all) const {
        const LAS int* at = (const LAS int*)(lds_all + TABA_OFF) + u.ui * 256; const LAS float* wt = (const LAS float*)(lds_all + TABB_OFF) + u.ui * 256;
        const int r0 = wr * 64 + fr, col0 = u.pn * BM + wc * 32 + 8 * fq;
#pragma unroll
        for (int ai = 0; ai < 2; ++ai)
#pragma unroll
            for (int m = 0; m < 4; ++m) { const int r = r0 + ai * HALF + m * 16; const int a = at[r]; const float w = wt[r];
                if (a >= 0) { bf16_t* rowp = Y + (size_t)a * D + col0;
#pragma unroll
                    for (int bj = 0; bj < 2; ++bj) *(u32x4*)(rowp + bj * HALF) = pack8(acc[ai][bj][m][0] * w, acc[ai][bj][m][1] * w); } }
    }
};
struct CvtRegs { f32x4 v[8]; float g[8]; };
template <bool TAIL>
__device__ __forceinline__ void cvt_load(CvtRegs& R, const float* __restrict__ src, int ldsrc, int col0, int N, const float* __restrict__ kscale, int kmod, float scalar, int k0, int n0, int lane) {
    const int lr = lane >> 3, lc = (lane & 7) * 4;
#pragma unroll
    for (int i = 0; i < 8; ++i) { const int kk = lr + 8 * i;
        if (!TAIL || n0 + lc + 3 < N) R.v[i] = __builtin_nontemporal_load((const f32x4*)(src + (size_t)(k0 + kk) * ldsrc + col0 + n0 + lc));
        else {
#pragma unroll
            for (int j = 0; j < 4; ++j) R.v[i][j] = (n0 + lc + j < N) ? src[(size_t)(k0 + kk) * ldsrc + col0 + n0 + lc + j] : 0.f; }
        R.g[i] = (kscale ? kscale[(k0 + kk) % kmod] : 1.0f) * scalar; }
}
template <int MODE>
__device__ __forceinline__ void cvt_finish(const CvtRegs& R, int K, int N, bf16_t* __restrict__ dst, int row0, size_t lo_off, LAS float* scr, int k0, int n0, int lane) {
    { const int lr = lane >> 3, lc = (lane & 7) * 4;
#pragma unroll
      for (int i = 0; i < 8; ++i) { const int kk = lr + 8 * i;
#pragma unroll
          for (int j = 0; j < 4; ++j) scr[kk * 33 + lc + j] = R.v[i][j] * R.g[i]; } }
    LDS_WAIT(); asm volatile("" ::: "memory");
    const int c = lane & 7;
#pragma unroll
    for (int j = 0; j < 4; ++j) { const int n = (lane >> 3) + 8 * j; const LAS float* sp = scr + (8 * c) * 33 + n;
        float f[8];
#pragma unroll
        for (int q = 0; q < 8; ++q) f[q] = sp[q * 33];
        if (n0 + n < N) {
            const int nn = n0 + n;
            int drow = row0 + nn;
            if (MODE == 1) drow = (nn >> 7) * 256 + (nn & 127);
            if (MODE == 2) drow = (nn >> 7) * 256 + 128 + (nn & 127);
            u32x4 o; o.x = cvt_pk_bf16(f[0], f[1]); o.y = cvt_pk_bf16(f[2], f[3]); o.z = cvt_pk_bf16(f[4], f[5]); o.w = cvt_pk_bf16(f[6], f[7]);
            *(u32x4*)(dst + (size_t)drow * K + k0 + 8 * c) = o;
            if (MODE == 3) { float l[8]; const unsigned ow[4] = {o.x, o.y, o.z, o.w};
#pragma unroll
                for (int q = 0; q < 4; ++q) { l[2 * q] = f[2 * q] - bf_lo(ow[q]); l[2 * q + 1] = f[2 * q + 1] - bf_hi(ow[q]); }
                u32x4 p; p.x = cvt_pk_bf16(l[0], l[1]); p.y = cvt_pk_bf16(l[2], l[3]); p.z = cvt_pk_bf16(l[4], l[5]); p.w = cvt_pk_bf16(l[6], l[7]);
                *(u32x4*)(dst + lo_off + (size_t)drow * K + k0 + 8 * c) = p; }
        }
    }
    LDS_WAIT(); asm volatile("" ::: "memory");
}
template <int MODE>
__device__ __forceinline__ void cvt_item(const float* __restrict__ src, int ldsrc, int col0, int K, int N, bf16_t* __restrict__ dst, int row0, const float* __restrict__ kscale, int kmod, float scalar,
                                         size_t lo_off, LAS float* scr, int item, int lane) {
    const int nblk = (N + 31) / 32, kb = item / nblk, nb = item - kb * nblk, k0 = 64 * kb, n0 = 32 * nb;
    CvtRegs R; cvt_load<true>(R, src, ldsrc, col0, N, kscale, kmod, scalar, k0, n0, lane);
    cvt_finish<MODE>(R, K, N, dst, row0, lo_off, scr, k0, n0, lane);
}
template <int MODE>
__device__ __forceinline__ void cvt_matrix(const float* src, int ldsrc, int col0, int K, int N, bf16_t* dst, int row0, const float* kscale, int kmod, float scalar, size_t lo_off,
                                           LAS float* scr, int gw, int NGW, int lane) {
    const int nitems = (K / 64) * ((N + 31) / 32);
    for (int it = gw; it < nitems; it += NGW) cvt_item<MODE>(src, ldsrc, col0, K, N, dst, row0, kscale, kmod, scalar, lo_off, scr, it, lane);
}

struct Ptrs {
    const float* in[23]; float* out; unsigned char* ws; int ph_lo, ph_hi;
};

typedef const __attribute__((address_space(4))) Ptrs CPtrs;
__device__ __forceinline__ CPtrs* kargs() { CPtrs* p = (CPtrs*)__builtin_amdgcn_kernarg_segment_ptr(); asm volatile("" : "+s"(p)); return p; }

template <int PART>
__device__ __forceinline__ void convert_moe_layer(CPtrs& P, LAS unsigned char* lds, int layer, int it0, int step, int end, int wave, int lane) {
    LAS float* scr = (LAS float*)(lds + wave * 8448);
    unsigned char* ws = P.ws;
    const float* nf = P.in[3] + layer * D;
    const float* wg = P.in[18] + (size_t)layer * NE * D * DFF; const float* wu = P.in[19] + (size_t)layer * NE * D * DFF; const float* wd = P.in[20] + (size_t)layer * NE * DFF * D;
    bf16_t* gu0 = (bf16_t*)(ws + WS_WGU) + (size_t)layer * NE * 768 * D; bf16_t* dn0 = (bf16_t*)(ws + WS_WD) + (size_t)layer * NE * D * DFF;
    constexpr int PER = PART ? 192 : 384;
    auto decode = [&](int it, int& e, int& which, int& k0, int& n0) { e = it / PER; const int r = it - e * PER; if (!PART) e = NE - 1 - e;
        which = PART ? 2 : r / 192; const int rr = PART ? r : r - which * 192;
        const int nblk = (which == 2) ? 32 : 12, kb = rr / nblk; k0 = 64 * kb; n0 = 32 * (rr - kb * nblk); };
    auto issue = [&](CvtRegs& R, int it) { int e, which, k0, n0; decode(it, e, which, k0, n0);
        if (which == 0) cvt_load<false>(R, wg + (size_t)e * D * DFF, DFF, 0, DFF, nf, D, 1.0f, k0, n0, lane);
        else if (which == 1) cvt_load<false>(R, wu + (size_t)e * D * DFF, DFF, 0, DFF, nf, D, 1.0f, k0, n0, lane);
        else cvt_load<false>(R, wd + (size_t)e * DFF * D, D, 0, D, nullptr, 1, 1.0f, k0, n0, lane); };
    auto finish = [&](const CvtRegs& R, int it) { int e, which, k0, n0; decode(it, e, which, k0, n0);
        bf16_t* gu = gu0 + (size_t)e * 768 * D; bf16_t* dn = dn0 + (size_t)e * D * DFF;
        if (which == 0) cvt_finish<1>(R, D, DFF, gu, 0, 0, scr, k0, n0, lane);
        else if (which == 1) cvt_finish<2>(R, D, DFF, gu, 0, 0, scr, k0, n0, lane);
        else cvt_finish<0>(R, DFF, D, dn, 0, 0, scr, k0, n0, lane); };
    CvtRegs Ra, Rb;
    int it = it0;
    if (it < end) issue(Ra, it);
    while (it < end) {
        const int n1 = it + step; if (n1 < end) issue(Rb, n1);
        finish(Ra, it);
        const int n2 = n1 + step; if (n1 < end) { if (n2 < end) issue(Ra, n2); finish(Rb, n1); }
        it = n2;
    }
}

__device__ __forceinline__ void prologue(CPtrs& P, LAS unsigned char* lds, int vcu, int G, int wave, int lane) {
    LAS float* scr = (LAS float*)(lds + wave * 8448);
    const int gw = vcu * NWAVES + wave, NGW = G * NWAVES;
    unsigned char* ws = P.ws;
    const float* norm_mix = P.in[2]; const float* norm_ffn = P.in[3]; const float* norm_ple = P.in[4];
    int rot = 0;
#define ROT() ((gw + NGW - (rot++ * 397) % NGW) % NGW)
    for (int j = 0; j < 2; ++j) {
        const float* win = P.in[6] + (size_t)j * D * GIN;
        bf16_t* wt = (bf16_t*)(ws + WS_WIN) + (size_t)j * NPROJ * D;
        cvt_matrix<0>(win, GIN, 0, D, 512, wt, 0, norm_mix + (2 * j) * D, D, 0.08838834764831845f, 0, scr, ROT(), NGW, lane);
        cvt_matrix<0>(win, GIN, 512, D, 2560, wt, 512, norm_mix + (2 * j) * D, D, 1.0f, 0, scr, ROT(), NGW, lane);
        cvt_matrix<3>(win, GIN, 3072, D, 16, (bf16_t*)(ws + WS_WLR) + (size_t)j * 2 * 16 * D, 0, norm_mix + (2 * j) * D, D, 1.0f, (size_t)16 * D, scr, ROT(), NGW, lane);
        cvt_matrix<0>(P.in[10] + (size_t)j * D * D, D, 0, D, D, (bf16_t*)(ws + WS_WOUT) + (size_t)j * D * D, 0, P.in[9] + j * 256, 256, 1.0f, 0, scr, ROT(), NGW, lane);
        for (int g = 0; g < 4; ++g)
            cvt_matrix<0>(P.in[11] + ((size_t)j * 4 + g) * 256 * 256, 256, 0, 256, 256, (bf16_t*)(ws + WS_WPOOL) + ((size_t)j * 4 + g) * 256 * 256, 0, norm_mix + (2 * j + 1) * D + g * 256, 256, 1.0f, 0, scr, ROT(), NGW, lane);
    }
    for (int i = 0; i < 4; ++i) {
        bf16_t* wr = (bf16_t*)(ws + WS_WR) + (size_t)i * 2 * 80 * D;
        cvt_matrix<3>(P.in[14] + (size_t)i * D * 8, 8, 0, D, 8, wr, 0, norm_ffn + i * D, D, 1.0f, (size_t)80 * D, scr, ROT(), NGW, lane);
        cvt_matrix<3>(P.in[16] + (size_t)i * D * 64, 64, 0, D, 64, wr, 8, norm_ffn + i * D, D, 1.0f, (size_t)80 * D, scr, ROT(), NGW, lane);
        cvt_matrix<0>(P.in[21] + (size_t)i * D * D, D, 0, D, D, (bf16_t*)(ws + WS_WPG) + (size_t)i * D * D, 0, norm_ple + i * D, D, 1.0f, 0, scr, ROT(), NGW, lane);
        cvt_matrix<0>(P.in[22] + (size_t)i * PLE * D, D, 0, PLE, D, (bf16_t*)(ws + WS_WPP) + (size_t)i * D * PLE, 0, nullptr, 1, 1.0f, 0, scr, ROT(), NGW, lane);
        for (int idx = gw * 64 + lane; idx < 2 * 8 * D / 8; idx += NGW * 64) { const int hl = idx / (8 * D / 8), rem = idx - hl * (8 * D / 8);
            *(u32x4*)(wr + (size_t)hl * 80 * D + (size_t)72 * D + (size_t)rem * 8) = (u32x4){0u, 0u, 0u, 0u}; }
    }
#undef ROT
    {
        const float* p = P.in[1]; bf16_t* pb = (bf16_t*)(ws + WS_PB);
        const size_t n8 = (size_t)4 * T * PLE / 8;
        for (size_t i = (size_t)gw * 64 + lane; i < n8; i += (size_t)NGW * 64) {
            const f32x4 a = *(const f32x4*)(p + i * 8), b = *(const f32x4*)(p + i * 8 + 4);
            *(u32x4*)(pb + i * 8) = pack8(a, b); }
    }
}

constexpr int NPB_STRIDE = 288;
template <int MODE, bool F32IN>
__device__ __forceinline__ void np_pass(LAS unsigned char* lds, const void* __restrict__ hin, bf16_t* __restrict__ hb, float* __restrict__ rs,
                                        const bf16_t* __restrict__ Wsm  , float* __restrict__ lr, const bf16_t* __restrict__ Y,
                                        const float* __restrict__ bc, const float* __restrict__ bfine, unsigned* cnt, int* __restrict__ list, float* __restrict__ wts,
                                        int G, int wave, int lane, bool do_lists = true, bf16_t* hout2 = nullptr) {
    constexpr int NR = (MODE == 1) ? 80 : 16, NT = NR / 16;
    constexpr int BUFB = 2 * NR * NPB_STRIDE;
    int tid_ = threadIdx.x; asm volatile("" : "+v"(tid_));
    const int tid = tid_, r = lane & 15, g = lane >> 4;
    for (int blk = ((G % 8 == 0) ? (int)(blockIdx.x % 8) * (G / 8) + (int)(blockIdx.x / 8) : (int)blockIdx.x); blk < T / 128; blk += G) {
        const int row0 = blk * 128 + wave * 16;
        float ss = 0.f;
        if constexpr (MODE == 2) {
            bf16_t* hrow = hb + (size_t)(row0 + r) * D + 8 * g; bf16_t* orow = (hout2 ? hout2 : hb) + (size_t)(row0 + r) * D + 8 * g;
            const bf16_t* y0 = Y + (size_t)(2 * (row0 + r)) * D + 8 * g; const bf16_t* y1 = y0 + D;
#pragma unroll 8
            for (int kk = 0; kk < 32; ++kk) {
                f32x4 a, b, p0, p1, q0, q1;
                unpack8(*(const u32x4*)(hrow + 32 * kk), a, b); unpack8(*(const u32x4*)(y0 + 32 * kk), p0, p1); unpack8(*(const u32x4*)(y1 + 32 * kk), q0, q1);
                a += p0 + q0; b += p1 + q1;
                const u32x4 w = pack8(a, b);
                *(u32x4*)(orow + 32 * kk) = w;
                unpack8(w, a, b);
                ss += (a[0] * a[0] + a[1] * a[1]) + (a[2] * a[2] + a[3] * a[3]) + (b[0] * b[0] + b[1] * b[1]) + (b[2] * b[2] + b[3] * b[3]);
            }
            ss += __shfl_xor(ss, 16); ss += __shfl_xor(ss, 32);
            if (lane < 16) rs[row0 + lane] = 1.0f / sqrtf(ss * (1.0f / D) + EPS);
        } else {
            f32x4 acc[NT];
#pragma unroll
            for (int i = 0; i < NT; ++i) acc[i] = (f32x4){0.f, 0.f, 0.f, 0.f};
            constexpr int PPT = (2 * NR * 16) / NTHREADS;
            static_assert(PPT * NTHREADS == 2 * NR * 16, "pieces");
            u32x4 breg[PPT];
            const unsigned goff0 = (unsigned)(tid >> 4) * (unsigned)(D * 2) + (unsigned)(tid & 15) * 16u, loff0 = (unsigned)(tid >> 4) * (unsigned)NPB_STRIDE + (unsigned)(tid & 15) * 16u;
            auto bload = [&](int c) {
                const char* gb = (const char*)Wsm + c * 256;
#pragma unroll
                for (int i = 0; i < PPT; ++i) breg[i] = *(const u32x4*)(gb + (goff0 + (unsigned)(i * 32 * D * 2)));
            };
            auto bstore = [&](int buf) {
#pragma unroll
                for (int i = 0; i < PPT; ++i) *(LAS u32x4*)(lds + buf * BUFB + loff0 + i * 32 * NPB_STRIDE) = breg[i];
            };
            constexpr int AW = F32IN ? 2 : 1;
            const char* hrow = F32IN ? (const char*)((const float*)hin + (size_t)(row0 + r) * D + 8 * g) : (const char*)((const bf16_t*)hin + (size_t)(row0 + r) * D + 8 * g);
            constexpr int KSB = F32IN ? 128 : 64;
            bf16_t* brow = hb + (size_t)(row0 + r) * D + 8 * g;
            auto kstep = [&](const u32x4 (&hv)[AW], int c, int kk, int cb) {
                bf16x8 ah, al;
                if constexpr (F32IN) {
                    const f32x4 a = __builtin_bit_cast(f32x4, hv[0]), b = __builtin_bit_cast(f32x4, hv[AW - 1]);
                    const u32x4 hi = pack8(a, b);
                    *(u32x4*)(brow + 128 * c + 32 * kk) = hi;
                    f32x4 ha, hb2; unpack8(hi, ha, hb2);
                    ss += (ha[0] * ha[0] + ha[1] * ha[1]) + (ha[2] * ha[2] + ha[3] * ha[3]) + (hb2[0] * hb2[0] + hb2[1] * hb2[1]) + (hb2[2] * hb2[2] + hb2[3] * hb2[3]);
                    ah = __builtin_bit_cast(bf16x8, hi); al = __builtin_bit_cast(bf16x8, pack8(a - ha, b - hb2));
                } else {
                    f32x4 ha, hb2; unpack8(hv[0], ha, hb2);
                    ss += (ha[0] * ha[0] + ha[1] * ha[1]) + (ha[2] * ha[2] + ha[3] * ha[3]) + (hb2[0] * hb2[0] + hb2[1] * hb2[1]) + (hb2[2] * hb2[2] + hb2[3] * hb2[3]);
                    ah = __builtin_bit_cast(bf16x8, hv[0]); al = ah;
                }
#pragma unroll
                for (int nt = 0; nt < NT; ++nt) {
                    const bf16x8 bh = *(const LAS bf16x8*)(lds + cb * BUFB + (nt * 16 + r) * NPB_STRIDE + (32 * kk + 8 * g) * 2);
                    const bf16x8 bl = *(const LAS bf16x8*)(lds + cb * BUFB + (NR + nt * 16 + r) * NPB_STRIDE + (32 * kk + 8 * g) * 2);
                    acc[nt] = __builtin_amdgcn_mfma_f32_16x16x32_bf16(ah, bh, acc[nt], 0, 0, 0);
                    if constexpr (F32IN) acc[nt] = __builtin_amdgcn_mfma_f32_16x16x32_bf16(al, bh, acc[nt], 0, 0, 0);
                    acc[nt] = __builtin_amdgcn_mfma_f32_16x16x32_bf16(ah, bl, acc[nt], 0, 0, 0);
                }
            };
            if constexpr (!F32IN) {
                u32x4 hall[32][1];
#pragma unroll
                for (int ks = 0; ks < 32; ++ks) hall[ks][0] = *(const u32x4*)(hrow + (size_t)ks * KSB);
                bload(0); bstore(0);
                __syncthreads();
#pragma unroll
                for (int c = 0; c < 8; ++c) {
                    const int cb = c & 1;
                    if (c < 7) bload(c + 1);
#pragma unroll
                    for (int kk = 0; kk < 4; ++kk) kstep(hall[4 * c + kk], c, kk, cb);
                    if (c < 7) bstore(cb ^ 1);
                    __syncthreads();
                }
            } else {
                u32x4 hva[4][AW], hvb[4][AW];
                auto aload = [&](u32x4 (&hv)[4][AW], int c) {
#pragma unroll
                    for (int kk = 0; kk < 4; ++kk)
#pragma unroll
                        for (int w = 0; w < AW; ++w) hv[kk][w] = *(const u32x4*)(hrow + (size_t)(4 * c + kk) * KSB + 16 * w);
                };
                bload(0); bstore(0);
                aload(hva, 0);
                __syncthreads();
#pragma unroll 1
                for (int c = 0; c < 8; c += 2) {
                    bload(c + 1); aload(hvb, c + 1);
#pragma unroll
                    for (int kk = 0; kk < 4; ++kk) kstep(hva[kk], c, kk, 0);
                    bstore(1);
                    __syncthreads();
                    if (c + 2 < 8) { bload(c + 2); aload(hva, c + 2); }
#pragma unroll
                    for (int kk = 0; kk < 4; ++kk) kstep(hvb[kk], c + 1, kk, 1);
                    if (c + 2 < 8) bstore(0);
                    __syncthreads();
                }
            }
            ss += __shfl_xor(ss, 16); ss += __shfl_xor(ss, 32);
            const float rsv = 1.0f / sqrtf(ss * (1.0f / D) + EPS);
            if (lane < 16) rs[row0 + lane] = rsv;
            float rsr[4];
#pragma unroll
            for (int j = 0; j < 4; ++j) rsr[j] = __shfl(rsv, 4 * g + j);
            if constexpr (MODE == 0) {
#pragma unroll
                for (int j = 0; j < 4; ++j) lr[(size_t)(row0 + 4 * g + j) * 16 + r] = acc[0][j] * rsr[j];
            } else {
                LAS float* slog = (LAS float*)(lds) + wave * 16 * 80;
                LAS int* hist = (LAS int*)(lds + 8 * 16 * 80 * 4);
#pragma unroll
                for (int nt = 0; nt < NT; ++nt) { const int n = nt * 16 + r; const float bias = (n < 8) ? bc[n] : ((n < 72) ? bfine[n - 8] : 0.f);
#pragma unroll
                    for (int j = 0; j < 4; ++j) slog[(4 * g + j) * 80 + n] = acc[nt][j] * rsr[j] + bias; }
                if (tid < 64) hist[tid] = 0;
                __syncthreads();
                if (do_lists) {
                int ea = 0, eb = 0, pa = 0, pb = 0; float w0 = 0.f, w1 = 0.f;
                if (lane < 16) {
                    const LAS float* L = slog + lane * 80;
                    int gq = 0; float m = L[0];
#pragma unroll
                    for (int j = 1; j < 8; ++j) { const float v = L[j]; if (v > m) { m = v; gq = j; } }
                    float den = 0.f;
#pragma unroll
                    for (int j = 0; j < 8; ++j) den += __expf(L[j] - m);
                    const float pg = 1.0f / den;
                    const LAS float* f = L + 8 + gq * 8;
                    int i0 = 0; float v0 = f[0];
#pragma unroll
                    for (int j = 1; j < 8; ++j) { const float v = f[j]; if (v > v0) { v0 = v; i0 = j; } }
                    int i1 = -1; float v1 = 0.f;
#pragma unroll
                    for (int j = 0; j < 8; ++j) { const float v = f[j]; if (j != i0 && (i1 < 0 || v > v1)) { v1 = v; i1 = j; } }
                    const float e1 = __expf(v1 - v0); w0 = pg / (1.0f + e1); w1 = pg * e1 / (1.0f + e1);
                    ea = gq * 8 + i0; eb = gq * 8 + i1;
                    pa = atomicAdd((int*)&hist[ea], 1); pb = atomicAdd((int*)&hist[eb], 1);
                }
                __syncthreads();
                if (tid < 64) { const int c = hist[tid]; hist[64 + tid] = c ? (int)atomicAdd(cnt + tid, (unsigned)c) : 0; }
                __syncthreads();
                if (lane < 16) { const int t = row0 + lane;
                    list[(size_t)ea * CAP + hist[64 + ea] + pa] = 2 * t; wts[2 * t] = w0;
                    list[(size_t)eb * CAP + hist[64 + eb] + pb] = 2 * t + 1; wts[2 * t + 1] = w1; }
                }
                __syncthreads();
            }
        }
    }
}

constexpr int GS128 = 288, GS64 = 160;
constexpr int G_QD = 0, G_KI = G_QD + 64 * GS128, G_KE = G_KI + 64 * GS128, G_BLOB = G_KE + 128 * GS64;
constexpr int G_VT = G_BLOB, G_AT = G_VT + 2 * 64 * GS64, G_ST = G_AT + 64 * GS64, G_OT = G_ST + 2 * 64 * GS128, G_SQ = G_OT + 64 * 144, G_END = G_SQ + 64 * 8;
static_assert(G_END <= MISC_OFF && G_BLOB % 16 == 0, "GLA LDS");
static_assert(G_BLOB == 7 * NTHREADS * 16, "blob pieces");
__device__ __forceinline__ bf16x8 ldfrag(const LAS unsigned char* img, int stride, int row, int kbyte) { return *(const LAS bf16x8*)(img + row * stride + kbyte); }
#define GLA_BAR() asm volatile("s_waitcnt lgkmcnt(0)\n\ts_barrier" ::: "memory")

__device__ __forceinline__ void gla_pre(LAS unsigned char* lds, const bf16_t* __restrict__ proj, const float* __restrict__ lr, const float* __restrict__ wgk, const float* __restrict__ bgk,
                                        unsigned char* __restrict__ gimg, int vcu, int G, int wave, int lane) {
    const int cp = lane, r = lane & 15, g = lane >> 4;
    int parity = 0, cur_hd = -1;
    f32x2 wgp[16]; f32x2 bg = (f32x2){0.f, 0.f};
    unsigned qv[8], kv[8], qn[8], kn[8]; float lrv[2], lrn[2]; bool first = true;
    auto load_item = [&](int item, unsigned (&q)[8], unsigned (&k)[8], float (&l)[2]) {
        const int b = item >> 7, hd = (item >> 5) & 3, n = item & 31; const size_t tb = (size_t)b * SEQ + 64 * n;
#pragma unroll
        for (int tt = 0; tt < 8; ++tt) { const bf16_t* rowp = proj + (tb + 8 * wave + tt) * NPROJ; q[tt] = *(const unsigned*)(rowp + hd * 128 + 2 * cp); k[tt] = *(const unsigned*)(rowp + 512 + hd * 128 + 2 * cp); }
#pragma unroll
        for (int x = 0; x < 2; ++x) l[x] = lr[(tb + 8 * wave + 4 * x + g) * 16 + r];
    };
    for (int item = vcu; item < NB * 4 * 32; item += G, parity ^= 1) {
        const int b = item >> 7, hd = (item >> 5) & 3, n = item & 31;
        if (hd != cur_hd) { cur_hd = hd;
#pragma unroll
            for (int q = 0; q < 16; ++q) wgp[q] = *(const f32x2*)(wgk + q * 512 + hd * 128 + 2 * cp);
            bg = *(const f32x2*)(bgk + hd * 128 + 2 * cp); }
        if (first) { first = false; load_item(item, qv, kv, lrv); }
        float b0[8], b1[8];
        {
            float c0 = 0.f, c1 = 0.f;
#pragma unroll
            for (int tt = 0; tt < 8; ++tt) {
                f32x2 z2 = bg;
#pragma unroll
                for (int q = 0; q < 16; ++q) { const float sv = __builtin_bit_cast(float, __builtin_amdgcn_readlane(__builtin_bit_cast(int, lrv[tt >> 2]), (tt & 3) * 16 + q)); z2 = __builtin_elementwise_fma((f32x2){sv, sv}, wgp[q], z2); }
                const float z0 = z2.x, z1 = z2.y;
                const float g0 = (fminf(z0, 0.f) - __logf(1.0f + __expf(-fabsf(z0)))) * 0.0625f, g1 = (fminf(z1, 0.f) - __logf(1.0f + __expf(-fabsf(z1)))) * 0.0625f;
                c0 += g0; c1 += g1; b0[tt] = c0; b1[tt] = c1;
            }
            *(LAS f32x2*)(lds + ((parity * 8 + wave) * 128 + 2 * cp) * 4) = (f32x2){c0, c1};
        }
        GLA_BAR();
        { const int nitem = item + G; load_item(nitem < NB * 4 * 32 ? nitem : item, qn, kn, lrn); }
        float off0 = 0.f, off1 = 0.f, tot0 = 0.f, tot1 = 0.f;
#pragma unroll
        for (int sg = 0; sg < 8; ++sg) { const f32x2 v = *(const LAS f32x2*)(lds + ((parity * 8 + sg) * 128 + 2 * cp) * 4); tot0 += v.x; tot1 += v.y; if (sg < wave) { off0 += v.x; off1 += v.y; } }
        unsigned char* blob = gimg + (size_t)item * G_BLOB;
        float e0[8], e1[8];
        const float et0 = __expf(tot0), et1 = __expf(tot1);
#pragma unroll
        for (int tt = 0; tt < 8; ++tt) {
            const float bb0 = off0 + b0[tt], bb1 = off1 + b1[tt];
            const float q0 = bf_lo(qv[tt]), q1 = bf_hi(qv[tt]), k0 = bf_lo(kv[tt]), k1 = bf_hi(kv[tt]);
            const int tok = 8 * wave + tt;
            const float x0 = __expf(bb0), x1 = __expf(bb1), i0 = __builtin_amdgcn_rcpf(x0), i1 = __builtin_amdgcn_rcpf(x1);
            *(unsigned*)(blob + G_QD + tok * GS128 + 4 * cp) = cvt_pk_bf16(q0 * x0, q1 * x1);
            *(unsigned*)(blob + G_KI + tok * GS128 + 4 * cp) = cvt_pk_bf16(k0 * i0, k1 * i1);
            e0[tt] = k0 * __expf(tot0 - bb0); e1[tt] = k1 * __expf(tot1 - bb1);
        }
        u32x4 ke0, ke1;
        ke0.x = cvt_pk_bf16(e0[0], e0[1]); ke0.y = cvt_pk_bf16(e0[2], e0[3]); ke0.z = cvt_pk_bf16(e0[4], e0[5]); ke0.w = cvt_pk_bf16(e0[6], e0[7]);
        ke1.x = cvt_pk_bf16(e1[0], e1[1]); ke1.y = cvt_pk_bf16(e1[2], e1[3]); ke1.z = cvt_pk_bf16(e1[4], e1[5]); ke1.w = cvt_pk_bf16(e1[6], e1[7]);
        *(u32x4*)(blob + G_KE + (2 * cp) * GS64 + 16 * wave) = ke0;
        *(u32x4*)(blob + G_KE + (2 * cp + 1) * GS64 + 16 * wave) = ke1;
        if (wave == 0) { *(float*)(blob + G_KE + (2 * cp) * GS64 + 128) = et0; *(float*)(blob + G_KE + (2 * cp + 1) * GS64 + 128) = et1; }
#pragma unroll
        for (int tt = 0; tt < 8; ++tt) { qv[tt] = qn[tt]; kv[tt] = kn[tt]; }
        lrv[0] = lrn[0]; lrv[1] = lrn[1];
    }
    __syncthreads();
}

template <int SMODE = 0>
__device__ __forceinline__ void gla_scan(LAS unsigned char* lds, const bf16_t* __restrict__ proj, const unsigned char* __restrict__ gimg, bf16_t* __restrict__ og, float* __restrict__ ssp,
                                         int vcu, int G, int wave, int lane) {
    int tid_ = threadIdx.x; asm volatile("" : "+v"(tid_));
    const int tid = tid_, r = lane & 15, g = lane >> 4;
    const int it = wave >> 1, half = wave & 1;
    constexpr int G_RT = G_SQ + 64 * 8;
    static_assert(G_RT + 64 * 144 <= MISC_OFF, "GLA LDS (RT)");
    constexpr int NLD = 448;
    for (int unit = vcu; unit < NB * 4 * 4; unit += G) {
        const int b = unit >> 4, hd = (unit >> 2) & 3, cs = unit & 3;
        const size_t t0 = (size_t)b * SEQ;
        const unsigned char* blob0 = gimg + (size_t)((b * 4 + hd) * 32) * G_BLOB;
        for (int i = tid; i < 64 * GS128 / 16; i += NTHREADS) *(LAS u32x4*)(lds + G_ST + i * 16) = (u32x4){0u, 0u, 0u, 0u};
        f32x4 S[4];
#pragma unroll
        for (int i = 0; i < 4; ++i) S[i] = (f32x4){0.f, 0.f, 0.f, 0.f};
        int pvr[3]; pvr[0] = tid; pvr[1] = tid + NLD; pvr[2] = (tid + 2 * NLD) & 1023;
        unsigned voff[3];
#pragma unroll
        for (int i = 0; i < 3; ++i) { const int p = pvr[i]; const bool isv = p < 512; const int q = p & 511; const int row = isv ? (q & 63) : (q >> 3), pc = isv ? (q >> 6) : (q & 7);
            voff[i] = (unsigned)(row * NPROJ + (isv ? 1024 : 2048) + hd * 256 + cs * 64 + pc * 8) * 2u; }
        const unsigned boff = (unsigned)tid * 16u, foff = (unsigned)((lane >> 3) * D + (lane & 7) * 8) * 2u;
        u32x4 pb[8], pv[3];
        auto prefetch = [&](int n) {
            const unsigned char* bl = blob0 + (size_t)n * G_BLOB; const char* pr = (const char*)(proj + (t0 + 64 * n) * NPROJ);
#pragma unroll
            for (int i = 0; i < 8; ++i) pb[i] = *(const u32x4*)((bl + (size_t)i * NLD * 16) + boff);
#pragma unroll
            for (int i = 0; i < 3; ++i) pv[i] = *(const u32x4*)(pr + voff[i]);
        };
        auto flush = [&](int n) {
            char* ob = (char*)(og + (t0 + 64 * n) * D + hd * 256 + cs * 64);
#pragma unroll
            for (int i = 0; i < 8; ++i) { const u32x4 w = *(const LAS u32x4*)(lds + G_OT + i * 8 * 144 + (lane >> 3) * 144 + (lane & 7) * 16);
                *(u32x4*)((ob + (size_t)i * 8 * D * 2) + foff) = w; }
            { const f32x2 q = *(const LAS f32x2*)(lds + G_SQ + lane * 8); ssp[(size_t)(hd * 4 + cs) * T + t0 + 64 * n + lane] = q.x + q.y; }
        };
        auto chunk = [&](int n) {
            const int par = n & 1;
            LAS unsigned char* VT = lds + G_VT + par * 64 * GS64;
            if (wave < 7) {
#pragma unroll
                for (int i = 0; i < 8; ++i) *(LAS u32x4*)(lds + (tid + i * NLD) * 16) = pb[i];
#pragma unroll
                for (int i = 0; i < 3; ++i) { const int p = pvr[i]; const int q = p & 511;
                    if (p < 512) { const int row = q & 63, pc = q >> 6; const unsigned vw[4] = {pv[i].x, pv[i].y, pv[i].z, pv[i].w};
#pragma unroll
                        for (int j = 0; j < 4; ++j) { *(LAS unsigned short*)(VT + (8 * pc + 2 * j) * GS64 + 2 * row) = (unsigned short)(vw[j] & 0xffffu);
                                                      *(LAS unsigned short*)(VT + (8 * pc + 2 * j + 1) * GS64 + 2 * row) = (unsigned short)(vw[j] >> 16); } }
                    else *(LAS u32x4*)(lds + G_RT + (q >> 3) * 144 + (q & 7) * 16) = pv[i]; }
                prefetch(n + 1 < SEQ / 64 ? n + 1 : n);
            }
            GLA_BAR();
            if (wave == 7) flush(n > 0 ? n - 1 : 0);
            const u32x2 rc0 = *(const LAS u32x2*)(lds + G_RT + (it * 16 + r) * 144 + ((2 * half) * 16 + 4 * g) * 2), rc1 = *(const LAS u32x2*)(lds + G_RT + (it * 16 + r) * 144 + ((2 * half + 1) * 16 + 4 * g) * 2);
            f32x4 at0 = (f32x4){0.f, 0.f, 0.f, 0.f}, at1 = at0, o0 = at0, o1 = at0;
            const bool do0 = (2 * half) <= it, do1 = (2 * half + 1) <= it;
            const LAS unsigned char* STc = lds + G_ST + par * 64 * GS128;
            bf16x8 fq[2], fk0[2], fk1[2], fs0[2], fs1[2];
#define GLA_LDK(ks, bufi) do { const int kb = (32 * (ks) + 8 * g) * 2; fq[bufi] = ldfrag(lds + G_QD, GS128, it * 16 + r, kb); fk0[bufi] = ldfrag(lds + G_KI, GS128, (2 * half) * 16 + r, kb); \
                fk1[bufi] = ldfrag(lds + G_KI, GS128, (2 * half + 1) * 16 + r, kb); fs0[bufi] = ldfrag(STc, GS128, (2 * half) * 16 + r, kb); fs1[bufi] = ldfrag(STc, GS128, (2 * half + 1) * 16 + r, kb); } while (0)
            GLA_LDK(0, 0);
#pragma unroll
            for (int ks = 0; ks < 4; ++ks) {
                const int cb = ks & 1;
                if (ks < 3) GLA_LDK(ks + 1, cb ^ 1);
                o0 = __builtin_amdgcn_mfma_f32_16x16x32_bf16(fs0[cb], fq[cb], o0, 0, 0, 0);
                o1 = __builtin_amdgcn_mfma_f32_16x16x32_bf16(fs1[cb], fq[cb], o1, 0, 0, 0);
                if (do0) at0 = __builtin_amdgcn_mfma_f32_16x16x32_bf16(fk0[cb], fq[cb], at0, 0, 0, 0);
                if (do1) at1 = __builtin_amdgcn_mfma_f32_16x16x32_bf16(fk1[cb], fq[cb], at1, 0, 0, 0);
            }
#undef GLA_LDK
            f32x4 dec;
#pragma unroll
            for (int x = 0; x < 4; ++x) dec[x] = *(const LAS float*)(lds + G_KE + (wave * 16 + 4 * g + x) * GS64 + 128);
            const bf16x8 kf0 = ldfrag(lds + G_KE, GS64, wave * 16 + r, (8 * g) * 2), kf1 = ldfrag(lds + G_KE, GS64, wave * 16 + r, (32 + 8 * g) * 2);
            if (2 * half == it) {
#pragma unroll
                for (int x = 0; x < 4; ++x) if (4 * g + x > r) at0[x] = 0.f; }
            if (2 * half + 1 == it) {
#pragma unroll
                for (int x = 0; x < 4; ++x) if (4 * g + x > r) at1[x] = 0.f; }
            *(LAS u32x2*)(lds + G_AT + (it * 16 + r) * GS64 + ((2 * half) * 16 + 4 * g) * 2) = (u32x2){cvt_pk_bf16(at0[0], at0[1]), cvt_pk_bf16(at0[2], at0[3])};
            *(LAS u32x2*)(lds + G_AT + (it * 16 + r) * GS64 + ((2 * half + 1) * 16 + 4 * g) * 2) = (u32x2){cvt_pk_bf16(at1[0], at1[1]), cvt_pk_bf16(at1[2], at1[3])};
            f32x4 o[2]; o[0] = o0; o[1] = o1;
            {
#pragma unroll
                for (int cp2 = 0; cp2 < 2; ++cp2) {
                    bf16x8 vf[2][2]; f32x4 sv[2];
#pragma unroll
                    for (int c = 0; c < 2; ++c) { const int ct = 2 * cp2 + c; vf[c][0] = ldfrag(VT, GS64, ct * 16 + r, (8 * g) * 2); vf[c][1] = ldfrag(VT, GS64, ct * 16 + r, (32 + 8 * g) * 2); sv[c] = S[ct] * dec; }
#pragma unroll
                    for (int c = 0; c < 2; ++c) sv[c] = __builtin_amdgcn_mfma_f32_16x16x32_bf16(kf0, vf[c][0], sv[c], 0, 0, 0);
#pragma unroll
                    for (int c = 0; c < 2; ++c) sv[c] = __builtin_amdgcn_mfma_f32_16x16x32_bf16(kf1, vf[c][1], sv[c], 0, 0, 0);
#pragma unroll
                    for (int c = 0; c < 2; ++c) { const int ct = 2 * cp2 + c; S[ct] = sv[c];
                        *(LAS u32x2*)(lds + G_ST + (par ^ 1) * 64 * GS128 + (ct * 16 + r) * GS128 + (wave * 16 + 4 * g) * 2) = (u32x2){cvt_pk_bf16(sv[c][0], sv[c][1]), cvt_pk_bf16(sv[c][2], sv[c][3])}; }
                }
            }
            GLA_BAR();
            {
                const bf16x8 af0 = ldfrag(lds + G_AT, GS64, it * 16 + r, (8 * g) * 2), af1 = ldfrag(lds + G_AT, GS64, it * 16 + r, (32 + 8 * g) * 2);
                float ssq = 0.f;
                const size_t trow = t0 + 64 * n + it * 16 + r;
                bf16x8 wf[2][2];
#pragma unroll
                for (int cc = 0; cc < 2; ++cc) { wf[cc][0] = ldfrag(VT, GS64, (2 * half + cc) * 16 + r, (8 * g) * 2); if (it >= 2) wf[cc][1] = ldfrag(VT, GS64, (2 * half + cc) * 16 + r, (32 + 8 * g) * 2); }
#pragma unroll
                for (int cc = 0; cc < 2; ++cc) o[cc] = __builtin_amdgcn_mfma_f32_16x16x32_bf16(wf[cc][0], af0, o[cc], 0, 0, 0);
                if (it >= 2) {
#pragma unroll
                    for (int cc = 0; cc < 2; ++cc) o[cc] = __builtin_amdgcn_mfma_f32_16x16x32_bf16(wf[cc][1], af1, o[cc], 0, 0, 0); }
#pragma unroll
                for (int cc = 0; cc < 2; ++cc) {
                    const int ct = 2 * half + cc;
                    const f32x4 v = o[cc];
                    ssq += (v[0] * v[0] + v[1] * v[1]) + (v[2] * v[2] + v[3] * v[3]);
                    const int col = hd * 256 + cs * 64 + ct * 16 + 4 * g;
                    const u32x2 rw = cc ? rc1 : rc0;
                    *(LAS u32x2*)(lds + G_OT + (it * 16 + r) * 144 + (ct * 16 + 4 * g) * 2) = (u32x2){cvt_pk_bf16(v[0] * fsilu(bf_lo(rw.x)), v[1] * fsilu(bf_hi(rw.x))), cvt_pk_bf16(v[2] * fsilu(bf_lo(rw.y)), v[3] * fsilu(bf_hi(rw.y)))};
                }
                ssq += __shfl_xor(ssq, 16); ssq += __shfl_xor(ssq, 32);
                if (g == 0) *(LAS float*)(lds + G_SQ + ((it * 16 + r) * 2 + half) * 4) = ssq;
            }
        };
        if (wave < 7) prefetch(0);
        __syncthreads();
#pragma unroll 1
        for (int n = 0; n < SEQ / 64; ++n) chunk(n);
        __syncthreads();
        if (wave == 7) flush(SEQ / 64 - 1);
        __syncthreads();
    }
}
#undef GLA_BAR

__device__ __forceinline__ void e1_pass(const bf16_t* og, bf16_t* ogo, const float* __restrict__ ssp, int G) {
    const size_t n8 = (size_t)T * D / 8;
    int tid_ = threadIdx.x; asm volatile("" : "+v"(tid_));
    for (size_t i = (size_t)blockIdx.x * NTHREADS + tid_; i < n8; i += (size_t)G * NTHREADS) {
        const size_t t = i >> 7; const int hd = (int)((i & 127) >> 5);
        const float s = (ssp[(size_t)(hd * 4 + 0) * T + t] + ssp[(size_t)(hd * 4 + 1) * T + t]) + (ssp[(size_t)(hd * 4 + 2) * T + t] + ssp[(size_t)(hd * 4 + 3) * T + t]);
        const float rsh = 1.0f / sqrtf(s * (1.0f / 256.0f) + EPS);
        const u32x4 w = *(const u32x4*)(og + i * 8);
        u32x4 o; o.x = cvt_pk_bf16(bf_lo(w.x) * rsh, bf_hi(w.x) * rsh); o.y = cvt_pk_bf16(bf_lo(w.y) * rsh, bf_hi(w.y) * rsh); o.z = cvt_pk_bf16(bf_lo(w.z) * rsh, bf_hi(w.z) * rsh); o.w = cvt_pk_bf16(bf_lo(w.w) * rsh, bf_hi(w.w) * rsh);
        *(u32x4*)(ogo + i * 8) = o;
    }
}

constexpr int PG_STRIDE = 544;
constexpr int PG_OFF = 1024;
template <int J> struct PoolRaw { static constexpr int W = 2 << J, NTK = 4, NRW = W + NTK - 1; u32x2 raw[NRW]; };
template <int J>
__device__ __forceinline__ void pool_group_load(PoolRaw<J>& R, const bf16_t* __restrict__ h, int tw, int seq0, int lane) {
    constexpr int W = PoolRaw<J>::W, NRW = PoolRaw<J>::NRW;
#pragma unroll
    for (int i = 0; i < NRW; ++i) { const int t = tw - (W - 1) + i, tc = t < seq0 ? seq0 : t; R.raw[i] = *((const u32x2*)(h + (size_t)tc * D + 256 * J) + lane); }
}
template <int J>
__device__ __forceinline__ void pool_group_reduce(const PoolRaw<J>& R, LAS unsigned char* pg, const LAS float* rsl, int tw, int tl  , int seq0, int ri0, int lane) {
    constexpr int W = PoolRaw<J>::W, NTK = PoolRaw<J>::NTK, NRW = PoolRaw<J>::NRW;
    f32x4 xs[NRW];
#pragma unroll
    for (int i = 0; i < NRW; ++i) { const float sc = rsl[ri0 - (W - 1) + i]; xs[i] = (f32x4){bf_lo(R.raw[i].x) * sc, bf_hi(R.raw[i].x) * sc, bf_lo(R.raw[i].y) * sc, bf_hi(R.raw[i].y) * sc}; }
    f32x4 sum = xs[0];
#pragma unroll
    for (int i = 1; i < W; ++i) sum += xs[i];
#pragma unroll
    for (int tt = 0; tt < NTK; ++tt) {
        const int ts = tw + tt - seq0; const float inv = 1.0f / (float)(ts + 1 < W ? ts + 1 : W);
        const f32x4 p = sum * inv - xs[tt + W - 1];
        *(LAS u32x2*)(pg + (tl + tt) * PG_STRIDE + 8 * lane) = (u32x2){cvt_pk_bf16(p[0], p[1]), cvt_pk_bf16(p[2], p[3])};
        if (tt < NTK - 1) sum += xs[tt + W] - xs[tt];
    }
}
template <int J>
__device__ __forceinline__ void pool_fused_group(LAS unsigned char* lds, const bf16_t* __restrict__ hin, bf16_t* __restrict__ hout, const bf16_t* __restrict__ Wt  ,
                                                 const float* __restrict__ bias, const float* __restrict__ sc, int t0, int seq0, int wave, int lane) {
    const LAS float* rsl = (const LAS float*)lds; LAS unsigned char* pg = lds + PG_OFF;
    const int r = lane & 15, g = lane >> 4;
    {
        PoolRaw<J> ra, rb;
        pool_group_load<J>(ra, hin, t0 + 16 * wave, seq0, lane);
        __builtin_amdgcn_sched_barrier(0);
#pragma unroll
        for (int q4 = 0; q4 < 4; q4 += 2) {
            pool_group_load<J>(rb, hin, t0 + 16 * wave + 4 * (q4 + 1), seq0, lane); __builtin_amdgcn_sched_barrier(0);
            pool_group_reduce<J>(ra, pg, rsl, t0 + 16 * wave + 4 * q4, 16 * wave + 4 * q4, seq0, 16 + 16 * wave + 4 * q4, lane); asm volatile("" ::: "memory"); __builtin_amdgcn_sched_barrier(0);
            if (q4 + 2 < 4) { pool_group_load<J>(ra, hin, t0 + 16 * wave + 4 * (q4 + 2), seq0, lane); __builtin_amdgcn_sched_barrier(0); }
            pool_group_reduce<J>(rb, pg, rsl, t0 + 16 * wave + 4 * (q4 + 1), 16 * wave + 4 * (q4 + 1), seq0, 16 + 16 * wave + 4 * (q4 + 1), lane); asm volatile("" ::: "memory"); __builtin_amdgcn_sched_barrier(0);
        }
    }
    __syncthreads();
    f32x4 acc[8][2];
#pragma unroll
    for (int mt = 0; mt < 8; ++mt) { acc[mt][0] = (f32x4){0.f, 0.f, 0.f, 0.f}; acc[mt][1] = acc[mt][0]; }
    const bf16_t* wrow = Wt + (size_t)(32 * wave + r) * 256 + 8 * g;
    asm volatile("" : "+v"(wrow));
    bf16x8 wf[2][2];
    wf[0][0] = *(const bf16x8*)(wrow); wf[0][1] = *(const bf16x8*)(wrow + 16 * 256);
#pragma unroll
    for (int ks = 0; ks < 8; ++ks) {
        const int cb = ks & 1;
        if (ks < 7) { wf[cb ^ 1][0] = *(const bf16x8*)(wrow + 32 * (ks + 1)); wf[cb ^ 1][1] = *(const bf16x8*)(wrow + 16 * 256 + 32 * (ks + 1)); }
        bf16x8 af[8];
#pragma unroll
        for (int mt = 0; mt < 8; ++mt) af[mt] = *(const LAS bf16x8*)(pg + (16 * mt + r) * PG_STRIDE + (32 * ks + 8 * g) * 2);
#pragma unroll
        for (int mt = 0; mt < 8; ++mt) { acc[mt][0] = __builtin_amdgcn_mfma_f32_16x16x32_bf16(wf[cb][0], af[mt], acc[mt][0], 0, 0, 0); acc[mt][1] = __builtin_amdgcn_mfma_f32_16x16x32_bf16(wf[cb][1], af[mt], acc[mt][1], 0, 0, 0); }
        __builtin_amdgcn_sched_barrier(0);
    }
    f32x4 bv[2], sv[2];
    asm volatile("" : "+s"(bias), "+s"(sc));
#pragma unroll
    for (int nt = 0; nt < 2; ++nt) { bv[nt] = *(const f32x4*)(bias + 256 * J + 32 * wave + 16 * nt + 4 * g); sv[nt] = *(const f32x4*)(sc + 256 * J + 32 * wave + 16 * nt + 4 * g); }
    u32x2 hv[8][2];
#pragma unroll
    for (int mt = 0; mt < 8; ++mt)
#pragma unroll
        for (int nt = 0; nt < 2; ++nt) hv[mt][nt] = *(const u32x2*)(hin + (size_t)(t0 + 16 * mt + r) * D + 256 * J + 32 * wave + 16 * nt + 4 * g);
#pragma unroll
    for (int mt = 0; mt < 8; ++mt)
#pragma unroll
        for (int nt = 0; nt < 2; ++nt) { const f32x4 o = (acc[mt][nt] + bv[nt]) * sv[nt]; const u32x2 w = hv[mt][nt];
            *(u32x2*)(hout + (size_t)(t0 + 16 * mt + r) * D + 256 * J + 32 * wave + 16 * nt + 4 * g) = (u32x2){cvt_pk_bf16(bf_lo(w.x) + o[0], bf_hi(w.x) + o[1]), cvt_pk_bf16(bf_lo(w.y) + o[2], bf_hi(w.y) + o[3])}; }
    __syncthreads();
}
__device__ __forceinline__ void pool_fused(LAS unsigned char* lds, const bf16_t* __restrict__ hin, bf16_t* __restrict__ hout, const bf16_t* __restrict__ Wt  ,
                                           const float* __restrict__ bias, const float* __restrict__ sc, int G, int wave, int lane) {
    LAS float* rsl = (LAS float*)lds;
    for (int tile = ((G % 8 == 0) ? (int)(blockIdx.x % 8) * (G / 8) + (int)(blockIdx.x / 8) : (int)blockIdx.x); tile < T / 128; tile += G) {
        const int t0 = tile * 128, seq0 = (t0 / SEQ) * SEQ;
#pragma unroll
        for (int bt = 0; bt < 2; ++bt) {
            u32x4 v[9][2];
#pragma unroll
            for (int q = 0; q < 9; ++q) { const int t = t0 - 16 + wave + 8 * (9 * bt + q), tc = t < seq0 ? seq0 : t; const u32x4* x = (const u32x4*)(hin + (size_t)tc * D) + 2 * lane; v[q][0] = x[0]; v[q][1] = x[1]; }
#pragma unroll
            for (int q = 0; q < 9; ++q) { const int rr = wave + 8 * (9 * bt + q), t = t0 - 16 + rr; float sq = 0.f;
#pragma unroll
                for (int w = 0; w < 2; ++w) { f32x4 a, b; unpack8(v[q][w], a, b); sq += (a[0] * a[0] + a[1] * a[1]) + (a[2] * a[2] + a[3] * a[3]) + (b[0] * b[0] + b[1] * b[1]) + (b[2] * b[2] + b[3] * b[3]); }
                const float rsv = (t >= seq0) ? 1.0f / sqrtf(wave_sum(sq) * (1.0f / D) + EPS) : 0.f;
                if (lane == 0) rsl[rr] = rsv; }
            __builtin_amdgcn_sched_barrier(0);
        }
        __syncthreads();
        pool_fused_group<0>(lds, hin, hout, Wt, bias, sc, t0, seq0, wave, lane);
        pool_fused_group<1>(lds, hin, hout, Wt + 65536, bias, sc, t0, seq0, wave, lane);
        pool_fused_group<2>(lds, hin, hout, Wt + 2 * 65536, bias, sc, t0, seq0, wave, lane);
        pool_fused_group<3>(lds, hin, hout, Wt + 3 * 65536, bias, sc, t0, seq0, wave, lane);
    }
}

__device__ __forceinline__ void final_norm(const bf16_t* __restrict__ h, const float* __restrict__ gfin, float* __restrict__ out, int G, int wave, int lane) {
    f32x4 gv[4];
#pragma unroll
    for (int j = 0; j < 4; ++j) gv[j] = *((const f32x4*)gfin + 4 * lane + j);
    const int nw = G * NWAVES, w0 = blockIdx.x * NWAVES + wave;
    for (int rb = w0 * 4; rb < T; rb += nw * 4) {
        u32x4 x[4][2];
#pragma unroll
        for (int q = 0; q < 4; ++q) { const u32x4* p = (const u32x4*)(h + (size_t)(rb + q) * D) + 2 * lane; x[q][0] = p[0]; x[q][1] = p[1]; }
#pragma unroll
        for (int q = 0; q < 4; ++q) { f32x4 v[4]; float s = 0.f;
            unpack8(x[q][0], v[0], v[1]); unpack8(x[q][1], v[2], v[3]);
#pragma unroll
            for (int j = 0; j < 4; ++j) s += (v[j][0] * v[j][0] + v[j][1] * v[j][1]) + (v[j][2] * v[j][2] + v[j][3] * v[j][3]);
            const float rsv = 1.0f / sqrtf(wave_sum(s) * (1.0f / D) + EPS);
            f32x4* o = (f32x4*)(out + (size_t)(rb + q) * D) + 4 * lane;
#pragma unroll
            for (int j = 0; j < 4; ++j) o[j] = v[j] * rsv * gv[j]; }
    }
}

__device__ __forceinline__ int moe_ntiles(const unsigned* cnt) {
    const int lane = threadIdx.x & 63;
    int nt = ((int)cnt[lane] + 255) >> 8;
#pragma unroll
    for (int o = 32; o; o >>= 1) nt += __shfl_xor(nt, o);
    return __builtin_amdgcn_readfirstlane(nt);
}
template <bool UP>
__device__ __forceinline__ int moe_tables(LAS unsigned char* lds_all, const unsigned* cnt, const int* __restrict__ list, const float* __restrict__ rs, const float* __restrict__ wts, int G, int c) {
    LAS int* tpre = (LAS int*)(lds_all + TAB_OFF);
    int tid_ = threadIdx.x; asm volatile("" : "+v"(tid_));
    const int tid = tid_;
    if (tid < 64) {
        const int nt = ((int)cnt[tid] + 255) >> 8; int incl = nt;
#pragma unroll
        for (int o = 1; o < 64; o <<= 1) { const int v = __shfl_up(incl, o); if (tid >= o) incl += v; }
        tpre[tid] = incl - nt; if (tid == 63) tpre[NE] = incl;
    }
    __syncthreads();
    const int ntiles = tpre[NE];
    MoeSched<UP> S; S.G = G; S.c = c; S.ntiles = ntiles; S.tpre = tpre; S.A = nullptr; S.W = nullptr;
    Unit u;
    int av[MAXU]; bool vv[MAXU]; int nu = 0;
#pragma unroll
    for (int i = 0; i < MAXU; ++i) { av[i] = -1; vv[i] = false;
        if (S.next_search(i, u)) { nu = i + 1; if (tid == 0) tpre[80 + i] = u.aux;
            if (tid < 256) { const int e = u.aux, idx = (u.pm - tpre[e]) * 256 + tid; vv[i] = idx < (int)cnt[e]; if (vv[i]) av[i] = list[(size_t)e * CAP + idx]; } } }
#pragma unroll
    for (int i = 0; i < MAXU; ++i) if (i < nu && tid < 256) {
        const int a = av[i]; const bool valid = vv[i];
        if (UP) { ((LAS unsigned*)(lds_all + TABA_OFF))[i * 256 + tid] = valid ? (unsigned)(a >> 1) * (unsigned)(D * 2) : 0u; ((LAS float*)(lds_all + TABB_OFF))[i * 256 + tid] = valid ? rs[a >> 1] : 0.f; }
        else { ((LAS int*)(lds_all + TABA_OFF))[i * 256 + tid] = a; ((LAS float*)(lds_all + TABB_OFF))[i * 256 + tid] = valid ? wts[a] : 0.f; }
    }
    __syncthreads();
    return ntiles;
}
constexpr int CWX_CNT = 1024;
constexpr int CWX_BAR = 4096;
constexpr int SEQ_FINAL = 41;
#ifndef FK_PHMASK
#define FK_PHMASK 0x7fff
#endif
#define PH_ON(k) (((FK_PHMASK) >> (k)) & 1)
#ifndef FK_NOPRE
#define FK_NOPRE 0
#endif
#ifndef FK_DUP
#define FK_DUP (-1)
#endif
#define NREP(k) ((FK_DUP == (k)) ? 2 : 1)
#define DUMMY(k, rep) (FK_DUP == (k) && (rep) == 0)
constexpr size_t WS_DUM_F32 = 1270 * MiB, WS_DUM_B16 = 1398 * MiB, WS_DUM_RS = 1527 * MiB;
constexpr size_t WS_HB1 = 1462 * MiB;
constexpr size_t WS_GIMG = 1270 * MiB;

__global__ void __launch_bounds__(NTHREADS, 2) fwd(Ptrs P, int li) {
    extern __shared__ __attribute__((aligned(16))) unsigned char lds_raw[];
    LAS unsigned char* lds = (LAS unsigned char*)lds_raw;
    const int tid = threadIdx.x, lane_k = tid & 63, wave_k = __builtin_amdgcn_readfirstlane(tid >> 6);
    const int G_k = gridDim.x, bid_k = blockIdx.x;
    const int vcu_k = (G_k % 8 == 0) ? (bid_k % 8) * (G_k / 8) + bid_k / 8 : bid_k;
#define PHV int lane = lane_k, wave = wave_k, G = G_k, bid = bid_k, vcu = vcu_k; asm volatile("" : "+v"(lane), "+s"(wave), "+s"(G), "+s"(bid), "+s"(vcu)); (void)lane; (void)wave; (void)G; (void)bid; (void)vcu;
    volatile LAS unsigned* MISC = (volatile LAS unsigned*)(lds + MISC_OFF);
    if (tid < 16) MISC[tid] = 0u;
    __syncthreads();
    const int lo = P.ph_lo, hi = P.ph_hi;
    XcdBarrier bar; bar.bar = (unsigned*)(P.ws + WS_CTL) + CWX_BAR + li * XCD_BAR_WORDS; bar.x = 0; bar.st = MISC + 8;
    if (hi - lo > 1) bar = xcd_barrier_post((unsigned*)(P.ws + WS_CTL) + CWX_BAR + li * XCD_BAR_WORDS, MISC + 8);
#define IN(s) (lo <= (s) && (s) < hi)
#define BAR_AFTER(s) do { if (hi > (s) + 1) xcd_barrier(bar); } while (0)
#define KA (*kargs())
#define WSP(off) (KA.ws + (off))
#define WIN ((bf16_t*)WSP(WS_WIN))
#define WLR ((bf16_t*)WSP(WS_WLR))
#define WOUT ((bf16_t*)WSP(WS_WOUT))
#define WPOOL ((bf16_t*)WSP(WS_WPOOL))
#define WR ((bf16_t*)WSP(WS_WR))
#define WPG ((bf16_t*)WSP(WS_WPG))
#define WPP ((bf16_t*)WSP(WS_WPP))
#define WGU ((bf16_t*)WSP(WS_WGU))
#define WD ((bf16_t*)WSP(WS_WD))
#define PB ((bf16_t*)WSP(WS_PB))
#define HB ((bf16_t*)WSP(WS_HB))
#define PROJ ((bf16_t*)WSP(WS_PROJ))
#define OG ((bf16_t*)WSP(WS_OG))
#define PP ((bf16_t*)WSP(WS_PP))
#define H2 ((bf16_t*)WSP(WS_H2))
#define Y ((bf16_t*)WSP(WS_Y))
#define LIST ((int*)WSP(WS_LIST))
#define RS ((float*)WSP(WS_RS))
#define LR ((float*)WSP(WS_LR))
#define SSP ((float*)WSP(WS_SSP))
#define WTS ((float*)WSP(WS_WTS))
#define CNT ((unsigned*)WSP(WS_CTL) + CWX_CNT)

    if (PH_ON(0) && IN(0)) for (int rep = 0; rep < NREP(0); ++rep) { PHV prologue(KA, lds, vcu, G, wave, lane); BAR_AFTER(0); }

    if (FK_DUP == 17 && IN(0)) { for (int q = 0; q < 20; ++q) xcd_barrier(bar); }
    for (int L = 0; L < 4; ++L) {
        const int base = 1 + 10 * L, j = L >> 1;
#define HCUR ((bf16_t*)WSP((L & 1) ? WS_HB1 : WS_HB))
#define HNXT ((bf16_t*)WSP((L & 1) ? WS_HB : WS_HB1))
#define HMID ((bf16_t*)WSP((L & 1) ? WS_PROJ : WS_HB))
        if ((L & 1) == 0) {
            if (PH_ON(1) && IN(base + 0)) for (int rep = 0; rep < NREP(1); ++rep) { PHV
                if (L == 0) np_pass<0, true>(lds, KA.in[0], HCUR, RS, WLR + (size_t)j * 2 * 16 * D, LR, nullptr, nullptr, nullptr, nullptr, nullptr, nullptr, G, wave, lane);
                else np_pass<0, false>(lds, HCUR, nullptr, RS, WLR + (size_t)j * 2 * 16 * D, LR, nullptr, nullptr, nullptr, nullptr, nullptr, nullptr, G, wave, lane);
                BAR_AFTER(base + 0); }
            if (PH_ON(2) && IN(base + 1)) for (int rep = 0; rep < NREP(2); ++rep) { PHV DenseSched S; S.init(HCUR, D, WIN + (size_t)j * NPROJ * D, T, NPROJ, D, G, bid, 0); EpiBf16Rs E{PROJ, NPROJ, RS}; gemm_phase(lds, D, D, S, E); BAR_AFTER(base + 1); }
            if (PH_ON(3) && IN(base + 2)) for (int rep = 0; rep < NREP(3); ++rep) { PHV
                for (int r2 = 0; r2 < NREP(15) && !FK_NOPRE; ++r2) { gla_pre(lds, PROJ, LR, KA.in[7] + (size_t)j * 16 * 512, KA.in[8] + j * 512, WSP(WS_GIMG), vcu, G, wave, lane); xcd_barrier(bar); }
                if (FK_DUP == 16) { gla_scan<0>(lds, PROJ, WSP(WS_GIMG), (bf16_t*)WSP(WS_DUM_B16), (float*)WSP(WS_DUM_RS), vcu, G, wave, lane); xcd_barrier(bar); }
                gla_scan<0>(lds, PROJ, WSP(WS_GIMG), OG, SSP, vcu, G, wave, lane);
                BAR_AFTER(base + 2); }
            if (PH_ON(5) && IN(base + 4)) for (int rep = 0; rep < NREP(5); ++rep) { PHV DenseSched S; S.init(OG, D, WOUT + (size_t)j * D * D, T, D, D, G, bid, 0);
                HeadScaleHook H{SSP};
                if (L == 0) { EpiResid<true, true> E{KA.in[0], DUMMY(5, rep) ? (bf16_t*)WSP(WS_DUM_B16) : HCUR}; gemm_phase(lds, D, D, S, E, H); }
                else { EpiResid<false, true> E{HCUR, DUMMY(5, rep) ? (bf16_t*)WSP(WS_DUM_B16) : HCUR}; gemm_phase(lds, D, D, S, E, H); }
                BAR_AFTER(base + 4); }
        } else {
            if (PH_ON(6) && IN(base + 0)) for (int rep = 0; rep < NREP(6); ++rep) { PHV pool_fused(lds, HCUR, DUMMY(6, rep) ? (bf16_t*)WSP(WS_DUM_B16) : HMID, WPOOL + (size_t)j * D * 256, KA.in[12] + j * D, KA.in[13] + j * D, G, wave, lane); BAR_AFTER(base + 0); }
        }
        if (PH_ON(8) && IN(base + 5)) for (int rep = 0; rep < NREP(8); ++rep) { PHV if (!DUMMY(8, rep)) { convert_moe_layer<0>(KA, lds, L, vcu * NWAVES + wave, G * NWAVES, NE * 384, wave, lane); __syncthreads(); }
            np_pass<1, false>(lds, HMID, nullptr, DUMMY(8, rep) ? (float*)WSP(WS_DUM_RS) : RS, WR + (size_t)L * 2 * 80 * D, nullptr, nullptr, KA.in[15] + L * 8, KA.in[17] + L * 64, CNT + L * 64, LIST, WTS, G, wave, lane, !DUMMY(8, rep));
            BAR_AFTER(base + 5); }
        if (IN(base + 6)) {
            if (PH_ON(10)) for (int rep = 0; rep < NREP(10); ++rep) { PHV const int ntiles = moe_tables<true>(lds, CNT + L * 64, LIST, RS, WTS, G, vcu);
              MoeSched<true> S; S.A = HMID; S.W = WGU + (size_t)L * NE * 768 * D; S.G = G; S.c = vcu; S.ntiles = ntiles; S.tpre = (const LAS int*)(lds + TAB_OFF);
              if (DUMMY(10, rep)) { EpiNone E{H2}; gemm_phase(lds, D, D, S, E); xcd_barrier(bar); } else { EpiUp E{H2}; gemm_phase(lds, D, D, S, E); } }
            { PHV __syncthreads();
              constexpr int TOTAL = NE * 192, CVU = 96;
              const int ntl = moe_ntiles(CNT + L * 64), rem = (ntl * 3) % G, NA = G - rem;
              int xh = (TOTAL - NA * CVU) / G; if (xh < 0) xh = 0;
              const int xl = (TOTAL - rem * xh + NA - 1) / NA;
              int st, en; if (vcu < rem) { st = vcu * xh; en = st + xh; } else { st = rem * xh + (vcu - rem) * xl; en = st + xl; if (en > TOTAL) en = TOTAL; }
              convert_moe_layer<1>(KA, lds, L, st + wave, NWAVES, en, wave, lane); }
            BAR_AFTER(base + 6);
        }
        if (PH_ON(11) && IN(base + 7)) for (int rep = 0; rep < NREP(11); ++rep) { PHV
            const int ntiles = moe_tables<false>(lds, CNT + L * 64, LIST, RS, WTS, G, vcu);
            MoeSched<false> S; S.A = H2; S.W = WD + (size_t)L * NE * D * DFF; S.G = G; S.c = vcu; S.ntiles = ntiles; S.tpre = (const LAS int*)(lds + TAB_OFF);
            if (DUMMY(11, rep)) { EpiNone E{Y}; gemm_phase(lds, DFF, DFF, S, E); } else { EpiDown E{Y}; gemm_phase(lds, DFF, DFF, S, E); } }
        if (IN(base + 7)) {
            if (PH_ON(9)) for (int rep = 0; rep < NREP(9); ++rep) { PHV
              const int ntl = moe_ntiles(CNT + L * 64), NU = ntl * 4;
              FillSched S; S.A = PB + (size_t)L * T * PLE; S.Bt = WPP + (size_t)L * D * PLE; S.lda = PLE; S.K = PLE; S.nN = D / BM; S.nwg = (T / BM) * (D / BM); S.G = G; S.c = vcu; S.rem = NU % G; S.KL = 4;
              EpiBf16Rs E{PP, D, nullptr}; gemm_phase(lds, PLE, PLE, S, E); if (DUMMY(9, rep)) xcd_barrier(bar); }
            BAR_AFTER(base + 7);
        }
        if (PH_ON(12) && IN(base + 8)) for (int rep = 0; rep < NREP(12); ++rep) { PHV np_pass<2, false>(lds, nullptr, HMID, DUMMY(12, rep) ? (float*)WSP(WS_DUM_RS) : RS, nullptr, nullptr, Y, nullptr, nullptr, nullptr, nullptr, nullptr, G, wave, lane, true, DUMMY(12, rep) ? (bf16_t*)WSP(WS_DUM_B16) : nullptr); BAR_AFTER(base + 8); }
        if (PH_ON(13) && IN(base + 9)) for (int rep = 0; rep < NREP(13); ++rep) { PHV DenseSched S; S.init(HMID, D, WPG + (size_t)L * D * D, T, D, D, G, bid, 0); if (DUMMY(13, rep)) { EpiNone E{(bf16_t*)WSP(WS_DUM_B16)}; gemm_phase(lds, D, D, S, E); } else { EpiPle E{HMID, HNXT, RS, PP}; gemm_phase(lds, D, D, S, E); } BAR_AFTER(base + 9); }
    }
    if (PH_ON(14) && IN(SEQ_FINAL)) { PHV final_norm((const bf16_t*)WSP(WS_HB), KA.in[5], KA.out, G, wave, lane); }
#undef HCUR
#undef HNXT
#undef HMID
#undef IN
#undef BAR_AFTER
}
}


#ifndef FK_DIAG
#define FK_DIAG 0
#endif
#if FK_DIAG
__global__ void __launch_bounds__(256) k_cksum(const unsigned* __restrict__ p, size_t nwords4, unsigned long long* slot) {
    unsigned long long s = 0;
    for (size_t i = (size_t)blockIdx.x * 256 + threadIdx.x; i < nwords4; i += (size_t)gridDim.x * 256) { const uint4 v = ((const uint4*)p)[i]; s += (unsigned long long)v.x + v.y + v.z + v.w; }
    for (int o = 32; o; o >>= 1) s += __shfl_xor(s, o);
    if ((threadIdx.x & 63) == 0) atomicAdd(slot, s);
}
__global__ void __launch_bounds__(256) k_verdict(const unsigned long long* cs, int nph, float* out, size_t n) {
    __shared__ float code;
    if (threadIdx.x == 0) { int first = -1; for (int s = 0; s < nph; ++s) if (cs[s] != cs[64 + s] && first < 0) first = s; code = (first < 0) ? 100.0f : (float)(3 + first); }
    __syncthreads();
    for (size_t i = (size_t)blockIdx.x * 256 + threadIdx.x; i < n; i += (size_t)gridDim.x * 256) out[i] = code;
}
#endif
#ifndef FK_PER_PHASE
#define FK_PER_PHASE 0
#endif
extern "C" void kernel_launch(void* const* d_in, const int* in_sizes, int n_in, void* d_out, int out_size, void* d_ws, size_t ws_size, hipStream_t stream) {
    using namespace fk;
    static int grid = 0;
    if (grid == 0) {
        if (n_in != 23 || in_sizes[0] != T * D || out_size != T * D || ws_size < 1534 * MiB) { fprintf(stderr, "kernel_launch: unexpected shapes (n_in %d, out %d, ws %zu)\n", n_in, out_size, ws_size); grid = -1; return; }
        int dev = 0, cus = 0, per_cu = 0;
        if (hipGetDevice(&dev) != hipSuccess || hipDeviceGetAttribute(&cus, hipDeviceAttributeMultiprocessorCount, dev) != hipSuccess) { grid = -1; return; }
        if (hipFuncSetAttribute((const void*)fwd, hipFuncAttributeMaxDynamicSharedMemorySize, LDS_BYTES) != hipSuccess) { fprintf(stderr, "kernel_launch: hipFuncSetAttribute failed\n"); grid = -1; return; }
        if (hipOccupancyMaxActiveBlocksPerMultiprocessor(&per_cu, (const void*)fwd, NTHREADS, LDS_BYTES) != hipSuccess || per_cu < 1) fprintf(stderr, "kernel_launch: occupancy query says %d\n", per_cu);
        (void)hipGetLastError();
        grid = cus;
    }
    if (grid < 0) return;
    (void)hipMemsetAsync((char*)d_ws + WS_CTL, 0, CTL_ZERO_BYTES, stream);
    Ptrs P; memset(&P, 0, sizeof(P));
    for (int i = 0; i < 23; ++i) P.in[i] = (const float*)d_in[i];
    P.out = (float*)d_out; P.ws = (unsigned char*)d_ws;
#if FK_PER_PHASE
    int li = 0;
#if FK_DIAG
    unsigned long long* cs = (unsigned long long*)((char*)d_ws + WS_END);
    (void)hipMemsetAsync(cs, 0, 2 * 64 * 8, stream);
    for (int run = 0; run < 2; ++run) {
    if (run == 0) (void)hipMemsetAsync((char*)d_ws + 2 * MiB, 0xAA, WS_END - 2 * MiB, stream);
    (void)hipMemsetAsync((char*)d_ws + WS_CTL, 0, CTL_ZERO_BYTES, stream);
    int nph = 0;
#endif
    for (int s = 0; s <= SEQ_FINAL; ++s) {
        const int L = (s - 1) / 10, k = (s - 1) % 10;
        if (s >= 1 && s < SEQ_FINAL && (L & 1) == 1 && k >= 2 && k <= 4) continue;
        P.ph_lo = s; P.ph_hi = s + 1;
        hipLaunchKernelGGL(fwd, dim3(grid), dim3(NTHREADS), LDS_BYTES, stream, P, li);
#if FK_DIAG
        {
            struct Reg { size_t off, bytes; int is_out; };
            Reg regs[4]; int nr = 0;
            auto W = [&](size_t off, size_t bytes) { regs[nr++] = Reg{off, bytes, 0}; };
            auto O = [&]() { regs[nr++] = Reg{0, (size_t)T * D * 4, 1}; };
            if (s == 0) W(WS_WIN, WS_HB - WS_WIN);
            else if (s == SEQ_FINAL) O();
            else if ((L & 1) == 0 && k == 0) { W(WS_HB, 64 * MiB); W(WS_RS, MiB / 8); W(WS_LR, 2 * MiB); }
            else if ((L & 1) == 0 && k == 1) W(WS_PROJ, 192 * MiB);
            else if ((L & 1) == 0 && k == 2) { W(WS_OG, 64 * MiB); W(WS_SSP, 4 * MiB); }
            else if ((L & 1) == 0 && k == 3) W(WS_OG, 64 * MiB);
            else if ((L & 1) == 0 && k == 4) O();
            else if ((L & 1) == 1 && k == 0) W(WS_PROJ, 64 * MiB);
            else if ((L & 1) == 1 && k == 1) O();
            else if (k == 5) { W(WS_HB, 64 * MiB); W(WS_RS, MiB / 8); W(WS_WTS, MiB / 4); }
            else if (k == 6) W(WS_PP, 64 * MiB);
            else if (k == 7) W(WS_Y, 128 * MiB);
            else if (k == 8) { O(); W(WS_HB, 64 * MiB); W(WS_RS, MiB / 8); }
            else if (k == 9) O();
            for (int q = 0; q < nr; ++q)
                hipLaunchKernelGGL(k_cksum, dim3(2048), dim3(256), 0, stream, regs[q].is_out ? (const unsigned*)d_out : (const unsigned*)((char*)d_ws + regs[q].off), regs[q].bytes / 16, cs + run * 64 + nph);
        }
        ++nph;
#endif
    }
#if FK_DIAG
    if (run == 1) hipLaunchKernelGGL(k_verdict, dim3(1024), dim3(256), 0, stream, cs, nph, (float*)d_out, (size_t)T * D);
    }
#endif
#else
    P.ph_lo = 0; P.ph_hi = SEQ_FINAL + 1;
    hipLaunchKernelGGL(fwd, dim3(grid), dim3(NTHREADS), LDS_BYTES, stream, P, 0);
#endif
}
```

```cpp
#include <hip/hip_runtime.h>
#include <stdint.h>
#include <stdio.h>
#include <string.h>
namespace fk {
#define LAS __attribute__((address_space(3)))
#define GAS __attribute__((address_space(1)))
typedef unsigned short bf16_t;
typedef short bf16x8 __attribute__((ext_vector_type(8)));
typedef float f32x4 __attribute__((ext_vector_type(4)));
typedef float f32x2 __attribute__((ext_vector_type(2)));
typedef unsigned u32x4 __attribute__((ext_vector_type(4)));
typedef unsigned u32x2 __attribute__((ext_vector_type(2)));

constexpr int T = 32768, D = 1024, SEQ = 2048, NB = 16, DFF = 384, NE = 64, PLE = 256, GIN = 3088, NPROJ = 3072;
constexpr int CAP = 65536;
constexpr float EPS = 1e-6f;
constexpr int NWAVES = 8, NTHREADS = 512;

constexpr size_t MiB = (size_t)1 << 20;
constexpr size_t WS_CTL = 0, CTL_ZERO_BYTES = 1 * MiB;
constexpr size_t WS_WIN = 2 * MiB;
constexpr size_t WS_WLR = 14 * MiB;
constexpr size_t WS_WOUT = 15 * MiB;
constexpr size_t WS_WPOOL = 19 * MiB;
constexpr size_t WS_WR = 20 * MiB;
constexpr size_t WS_WPG = 22 * MiB;
constexpr size_t WS_WPP = 30 * MiB;
constexpr size_t WS_WGU = 32 * MiB;
constexpr size_t WS_WD = 416 * MiB;
constexpr size_t WS_PB = 608 * MiB;
constexpr size_t WS_HB = 672 * MiB;
constexpr size_t WS_PROJ = 736 * MiB;
constexpr size_t WS_OG = 928 * MiB;
constexpr size_t WS_PP = 992 * MiB;
constexpr size_t WS_H2 = 1056 * MiB;
constexpr size_t WS_Y = 1116 * MiB;
constexpr size_t WS_LIST = 1244 * MiB;
constexpr size_t WS_RS = 1260 * MiB;
constexpr size_t WS_LR = 1261 * MiB;
constexpr size_t WS_SSP = 1263 * MiB;
constexpr size_t WS_WTS = 1267 * MiB;
constexpr size_t WS_END = 1268 * MiB;
constexpr int CW_BAR = 4096;
constexpr int CW_CNT = 8192;

constexpr int STAGE_BYTES = 131072;
constexpr int TAB_OFF = STAGE_BYTES;
constexpr int MAXU = 6;
constexpr int TABA_OFF = TAB_OFF + 512, TABB_OFF = TABA_OFF + MAXU * 1024;
constexpr int MISC_OFF = TABB_OFF + MAXU * 1024;
constexpr int LDS_BYTES = MISC_OFF + 256;
static_assert(LDS_BYTES <= 160 * 1024, "LDS");

#define LDS_WAIT() asm volatile("s_waitcnt lgkmcnt(0)" ::: "memory")
#define VM_WAIT() asm volatile("s_waitcnt vmcnt(0)" ::: "memory")
typedef __bf16 bf16x2_t __attribute__((ext_vector_type(2)));
__device__ __forceinline__ unsigned cvt_pk_bf16(float lo, float hi) { const bf16x2_t b = __builtin_convertvector((f32x2){lo, hi}, bf16x2_t); return __builtin_bit_cast(unsigned, b); }
__device__ __forceinline__ float bf_lo(unsigned w) { return __uint_as_float(w << 16); }
__device__ __forceinline__ float bf_hi(unsigned w) { return __uint_as_float(w & 0xffff0000u); }
__device__ __forceinline__ float wave_sum(float v) {
#pragma unroll
    for (int o = 1; o < 64; o <<= 1) v += __shfl_xor(v, o);
    return v;
}
__device__ __forceinline__ float fsigmoid(float x) { return __builtin_amdgcn_rcpf(1.0f + __expf(-x)); }
__device__ __forceinline__ float fsilu(float x) { return x * fsigmoid(x); }

#define XB_TMO      128
#define XB_XCNT(j)  (256  + 64 * (j))
#define XB_XSUB(j)  (1280 + 64 * (j))
#define XB_XGEN(j)  (2304 + 64 * (j))
#define XB_TOP      3328
#define XB_TOPGEN   3392
#define XCD_BAR_WORDS 3456
#define XB_SPIN_CAP (1u << 18)
__device__ __forceinline__ unsigned xb_ld(unsigned* p)              { return __hip_atomic_load(p, __ATOMIC_RELAXED, __HIP_MEMORY_SCOPE_AGENT); }
__device__ __forceinline__ unsigned xb_add(unsigned* p, unsigned v) { return __hip_atomic_fetch_add(p, v, __ATOMIC_RELAXED, __HIP_MEMORY_SCOPE_AGENT); }
__device__ __forceinline__ unsigned xb_xcc_id() { return (unsigned)__builtin_amdgcn_s_getreg((3 << 11) | 20) & 0xFu; }
#define XB_SPIN(cond, bar) do { unsigned _sp = 0; while (cond) { __builtin_amdgcn_s_sleep(1); \
    if ((++_sp & 255u) == 0u) { if (xb_ld(&(bar)[XB_TMO])) break; if (_sp > XB_SPIN_CAP) { atomicAdd(&(bar)[XB_TMO], 1u); break; } } } } while (0)
struct XcdBarrier { unsigned* bar; unsigned x; volatile LAS unsigned* st; };
__device__ __forceinline__ XcdBarrier xcd_barrier_post(unsigned* bar, volatile LAS unsigned* st) {
    XcdBarrier b; b.bar = bar; b.x = xb_xcc_id(); b.st = st;
    if (threadIdx.x == 0) (void)xb_add(&bar[XB_XCNT(b.x)], 1u);
    return b;
}
__device__ __forceinline__ void xcd_barrier_complete(unsigned* bar, unsigned x, unsigned& nloc, unsigned& nx) {
    const unsigned G = gridDim.x * gridDim.y * gridDim.z;
    unsigned sum, cnt, mine, sp = 0u;
    for (;;) {
        sum = 0u; cnt = 0u; mine = 0u;
#pragma unroll
        for (unsigned j = 0; j < 16; ++j) { const unsigned c = xb_ld(&bar[XB_XCNT(j)]); sum += c; cnt += (c > 0u) ? 1u : 0u; mine = (j == x) ? c : mine; }
        if (sum == G) break;
        __builtin_amdgcn_s_sleep(1);
        if ((++sp & 255u) == 0u) { if (xb_ld(&bar[XB_TMO])) break; if (sp > XB_SPIN_CAP) { atomicAdd(&bar[XB_TMO], 1u); break; } }
    }
    nloc = mine > 0u ? mine : 1u; nx = cnt > 0u ? cnt : 1u;
}
__device__ __forceinline__ void xcd_barrier(const XcdBarrier& b) {
    asm volatile("s_waitcnt vmcnt(0)" ::: "memory");
    __syncthreads();
    if (threadIdx.x == 0) {
        unsigned* bar = b.bar;
        __builtin_amdgcn_s_waitcnt(0);
        unsigned nloc = b.st[0], nx = b.st[1];
        if (nloc == 0u) { xcd_barrier_complete(bar, b.x, nloc, nx); b.st[0] = nloc; b.st[1] = nx; }
        const unsigned old = xb_add(&bar[XB_XSUB(b.x)], 1u);
        const unsigned gen = old / nloc;
        if (old + 1u == (gen + 1u) * nloc) {
            __builtin_amdgcn_fence(__ATOMIC_RELEASE, "agent");
            asm volatile("s_waitcnt vmcnt(0)" ::: "memory");
            const unsigned og = xb_add(&bar[XB_TOP], 1u);
            const unsigned tg = og / nx;
            if (og + 1u == (tg + 1u) * nx) xb_add(&bar[XB_TOPGEN], 1u);
            else XB_SPIN(xb_ld(&bar[XB_TOPGEN]) == tg, bar);
            __builtin_amdgcn_fence(__ATOMIC_ACQUIRE, "agent");
            xb_add(&bar[XB_XGEN(b.x)], 1u);
            asm volatile("s_waitcnt vmcnt(0)" ::: "memory");
        } else {
            XB_SPIN(xb_ld(&bar[XB_XGEN(b.x)]) == gen, bar);
            __builtin_amdgcn_fence(__ATOMIC_ACQUIRE, "agent");
            asm volatile("s_waitcnt vmcnt(0)" ::: "memory");
        }
    }
    __syncthreads();
}

constexpr int BM = 256, BK = 64, HALF = 128, HTB = HALF * BK * 2, NXCD = 8, WGM = 8;
__device__ __forceinline__ int lds_byte(int r, int c) { const int st = (r >> 4) * 2 + (c >> 5), rr = r & 15, cc = c & 31, ob = rr * 64 + cc * 2; return st * 1024 + (ob ^ (((ob >> 9) & 1) << 5)); }
__device__ __forceinline__ void stage_rc(int b, int& R, int& C) { const int st = b / 1024, sb = b % 1024, swz = sb ^ (((sb >> 9) & 1) << 5); R = (st >> 1) * 16 + swz / 64; C = (st & 1) * 32 + (swz % 64) / 2; }
__device__ __forceinline__ int perm32(int rho) { const int n = rho >> 4, i = rho & 15; return 8 * (i >> 2) + 4 * n + (i & 3); }

struct Unit { int pm, pn, ui, aux; };

struct DenseSched {
    static constexpr bool GATHER = false;
    const bf16_t* A; const bf16_t* Bt; int lda, K, acol_per_pn;
    int nM, nN, nwg, G, c;
    __device__ __forceinline__ void init(const bf16_t* A_, int lda_, const bf16_t* Bt_, int M, int N, int K_, int G_, int c_, int acol_per_pn_) {
        A = A_; Bt = Bt_; lda = lda_; K = K_; acol_per_pn = acol_per_pn_; nM = M / BM; nN = N / BM; nwg = nM * nN; G = G_; c = c_; }
    __device__ __forceinline__ bool next(int i, Unit& u) const {
        const long L = (long)i * G + c; if (L >= nwg) return false;
        int wgid = (int)L; { const int q = nwg / NXCD, r = nwg % NXCD, xcd = wgid % NXCD, off = wgid / NXCD; wgid = (xcd < r ? xcd * (q + 1) : r * (q + 1) + (xcd - r) * q) + off; }
        const int nig = WGM * nN, gid = wgid / nig, fm = gid * WGM, gsz = (nM - fm) < WGM ? (nM - fm) : WGM;
        u.pm = fm + ((wgid % nig) % gsz); u.pn = (wgid % nig) / gsz; u.ui = i; u.aux = 0; return true;
    }
    __device__ __forceinline__ const char* a_base(const Unit& u) const { return (const char*)A + ((size_t)u.pm * BM * lda + (size_t)u.pn * acol_per_pn) * 2; }
    __device__ __forceinline__ const char* b_base(const Unit& u) const { return (const char*)Bt + (size_t)u.pn * BM * K * 2; }
    __device__ __forceinline__ void rows(const Unit&, LAS unsigned char*, unsigned (&)[4]) const {}
};
struct FillSched {
    static constexpr bool GATHER = false;
    const bf16_t* A; const bf16_t* Bt; int lda, K, nN, nwg, G, c, rem, KL;
    __device__ __forceinline__ bool next(int i, Unit& u) const {
        const int NA = G - rem, nl = KL * NA < nwg ? KL * NA : nwg;
        int s;
        if (c >= rem) { const int a = c - rem; const int mine = (nl - a + NA - 1) / NA;
            s = (i < mine) ? a + i * NA : nl + c + (i - mine) * G; }
        else s = nl + c + i * G;
        if (s >= nwg) return false;
        u.pm = s / nN; u.pn = s - u.pm * nN; u.ui = i; u.aux = 0; return true;
    }
    __device__ __forceinline__ const char* a_base(const Unit& u) const { return (const char*)A + (size_t)u.pm * BM * lda * 2; }
    __device__ __forceinline__ const char* b_base(const Unit& u) const { return (const char*)Bt + (size_t)u.pn * BM * K * 2; }
    __device__ __forceinline__ void rows(const Unit&, LAS unsigned char*, unsigned (&)[4]) const {}
};
template <bool UP> struct MoeSched {
    static constexpr bool GATHER = UP;
    static constexpr int NTN = UP ? 3 : 4;
    const bf16_t* A; const bf16_t* W; int G, c, ntiles;
    const LAS int* tpre;
    __device__ __forceinline__ bool next(int i, Unit& u) const {
        const int L = i * G + c; if (L >= ntiles * NTN || i >= MAXU) return false;
        const int tile = L / NTN;
        u.pm = tile; u.pn = L - tile * NTN; u.ui = i; u.aux = __builtin_amdgcn_readfirstlane(tpre[80 + i]); return true;
    }
    __device__ __forceinline__ bool next_search(int i, Unit& u) const {
        const int L = i * G + c; if (L >= ntiles * NTN || i >= MAXU) return false;
        const int tile = L / NTN; int e = 0;
        for (int x = 1; x < NE; ++x) e += (tpre[x] <= tile) ? 1 : 0;
        u.pm = tile; u.pn = L - tile * NTN; u.ui = i; u.aux = e; return true;
    }
    __device__ __forceinline__ const char* a_base(const Unit& u) const { return UP ? (const char*)A : (const char*)A + (size_t)u.pm * BM * DFF * 2; }
    __device__ __forceinline__ const char* b_base(const Unit& u) const {
        return UP ? (const char*)W + ((size_t)u.aux * 768 + (size_t)u.pn * BM) * D * 2 : (const char*)W + ((size_t)u.aux * D + (size_t)u.pn * BM) * DFF * 2; }
    __device__ __forceinline__ void rows(const Unit& u, LAS unsigned char* lds_all, unsigned (&v)[4]) const {
        if (UP) { const LAS unsigned* tab = (const LAS unsigned*)(lds_all + TABA_OFF) + u.ui * 256;
#pragma unroll
            for (int i = 0; i < 2; ++i) { int R, C; int tx = threadIdx.x; asm volatile("" : "+v"(tx)); stage_rc(tx * 16 + i * 8192, R, C);
                v[i] = tab[R] + (unsigned)C * 2u; v[2 + i] = tab[HALF + R] + (unsigned)C * 2u; } }
    }
};

#define PG8_SA(b, h) (((b) * 2 + (h)) * HTB)
#define PG8_SB(b, h) ((4 + (b) * 2 + (h)) * HTB)
__device__ __forceinline__ void glds16(const void* gbase, unsigned voff, unsigned lds_dst) {
    unsigned keep;
    asm volatile("s_mov_b32 %0, m0\n\ts_mov_b32 m0, %3\n\ts_nop 0\n\tglobal_load_lds_dwordx4 %1, %2\n\ts_mov_b32 m0, %0" : "=&s"(keep) : "v"(voff), "s"(gbase), "s"(lds_dst) : "memory");
}
#define PG8_STAGE2(bufoff, gbase, o0, o1) do { glds16((gbase), (o0), (unsigned)(bufoff) + ldsw); glds16((gbase), (o1), (unsigned)(bufoff) + ldsw + 8192u); } while (0)
#define PG8_LDA(dst, b, h) do { _Pragma("unroll") for (int m = 0; m < 4; ++m) _Pragma("unroll") for (int k = 0; k < 2; ++k) dst[m][k] = *(const LAS bf16x8*)(lds + PG8_SA(b, h) + aoff + m * 2048 + k * 1024); } while (0)
#define PG8_LDB(dst, b, h) do { _Pragma("unroll") for (int n = 0; n < 2; ++n) _Pragma("unroll") for (int k = 0; k < 2; ++k) dst[n][k] = *(const LAS bf16x8*)(lds + PG8_SB(b, h) + boff + n * 2048 + k * 1024); } while (0)
#define PG8_MMA(ai, bj, At, Bt) do { __builtin_amdgcn_s_setprio(1); _Pragma("unroll") for (int m = 0; m < 4; ++m) _Pragma("unroll") for (int n = 0; n < 2; ++n) _Pragma("unroll") for (int k = 0; k < 2; ++k) \
        acc[ai][bj][m][n] = __builtin_amdgcn_mfma_f32_16x16x32_bf16(Bt[n][k], At[m][k], acc[ai][bj][m][n], 0, 0, 0); __builtin_amdgcn_s_setprio(0); } while (0)
#define PG8_WAIT_V(n) asm volatile("s_waitcnt vmcnt(" #n ")" ::: "memory")
#define PG8_WAIT_L(n) asm volatile("s_waitcnt lgkmcnt(" #n ")" ::: "memory")
#define PG8_BAR __builtin_amdgcn_s_barrier()
#define PG8_SCHED __builtin_amdgcn_sched_barrier(0)

struct NoHook { static constexpr bool ACTIVE = false; };
struct HeadScaleHook {
    static constexpr bool ACTIVE = true;
    const float* ssp;
    __device__ __forceinline__ void fill(const Unit& u, LAS unsigned char* lds_all, int parity) const {
        int tx = threadIdx.x; asm volatile("" : "+v"(tx));
        if (tx < 256) { const size_t row = (size_t)u.pm * BM + tx; float rh[4];
#pragma unroll
            for (int hd = 0; hd < 4; ++hd) { const float sq = (ssp[(size_t)(hd * 4 + 0) * T + row] + ssp[(size_t)(hd * 4 + 1) * T + row]) + (ssp[(size_t)(hd * 4 + 2) * T + row] + ssp[(size_t)(hd * 4 + 3) * T + row]);
                rh[hd] = 1.0f / sqrtf(sq * (1.0f / 256.0f) + EPS); }
            ((LAS f32x4*)(lds_all + TABA_OFF))[parity * 256 + tx] = (f32x4){rh[0] / rh[1], rh[1] / rh[2], rh[2] / rh[3], rh[3]}; }
    }
    __device__ __forceinline__ void rescale(f32x4 (&acc)[2][2][4][2], int which, LAS unsigned char* lds_all, int parity, int wr, int fr) const {
        const LAS float* tab = (const LAS float*)(lds_all + TABA_OFF) + parity * 1024;
#pragma unroll
        for (int ai = 0; ai < 2; ++ai)
#pragma unroll
            for (int m = 0; m < 4; ++m) { const float f = tab[(ai * HALF + wr * 64 + m * 16 + fr) * 4 + which];
#pragma unroll
                for (int bj = 0; bj < 2; ++bj)
#pragma unroll
                    for (int n = 0; n < 2; ++n) acc[ai][bj][m][n] *= f; }
    }
};

template <class Epi, class Sched, class Hook = NoHook>
__device__ __forceinline__ void gemm_phase(LAS unsigned char* lds_all, const int K, const int lda, const Sched& S, const Epi& E, const Hook H = Hook()) {
    LAS unsigned char* lds = lds_all;
    int tid_ = threadIdx.x; asm volatile("" : "+v"(tid_));
    const int tid = tid_, wid = __builtin_amdgcn_readfirstlane(tid >> 6), lane = tid & 63, wr = wid >> 2, wc = wid & 3, fr = lane & 15, fq = lane >> 4;
    const int nt = K / BK;
    unsigned vB[2], vA[4];
#pragma unroll
    for (int i = 0; i < 2; ++i) { int Rr, Cc; stage_rc(tid * 16 + i * 8192, Rr, Cc); const int Rb = Epi::PERM ? ((Rr & ~31) + perm32(Rr & 31)) : Rr;
        vB[i] = (unsigned)(Rb * K + Cc) * 2u; vA[i] = (unsigned)(Rr * lda + Cc) * 2u; vA[2 + i] = vA[i] + (unsigned)(HALF * lda) * 2u; }
    const size_t kstep = (size_t)(BK * 2);
    const size_t hstepB = (size_t)HALF * K * 2;
    const unsigned ldsw = (unsigned)wid * 1024u;
    const int aoff = lds_byte(wr * 64 + fr, fq * 8), boff = lds_byte(wc * 32 + fr, fq * 8);
    Unit cur, nxt; int ui = 0;
    if (!S.next(0, cur)) return;
    f32x4 acc[2][2][4][2];
#pragma unroll
    for (int a = 0; a < 2; ++a)
#pragma unroll
        for (int b = 0; b < 2; ++b)
#pragma unroll
            for (int m = 0; m < 4; ++m)
#pragma unroll
                for (int n = 0; n < 2; ++n) acc[a][b][m][n] = (f32x4){0.f, 0.f, 0.f, 0.f};
    bf16x8 At[4][2], B0[2][2], B1[2][2];
    const char* cA = S.a_base(cur); const char* cB = S.b_base(cur);
    if constexpr (Sched::GATHER) S.rows(cur, lds_all, vA);
    if constexpr (Hook::ACTIVE) { H.fill(cur, lds_all, 0); Unit u1; if (S.next(1, u1)) H.fill(u1, lds_all, 1); PG8_WAIT_L(0); }
    PG8_STAGE2(PG8_SB(0, 0), cB, vB[0], vB[1]); PG8_STAGE2(PG8_SB(0, 1), cB + hstepB, vB[0], vB[1]); PG8_STAGE2(PG8_SA(0, 0), cA, vA[0], vA[1]); PG8_STAGE2(PG8_SA(0, 1), cA, vA[2], vA[3]);
    if (wr == 1) PG8_BAR;
    PG8_WAIT_V(2); PG8_BAR;
    PG8_STAGE2(PG8_SB(1, 0), cB + kstep, vB[0], vB[1]); PG8_STAGE2(PG8_SA(1, 0), cA + kstep, vA[0], vA[1]); PG8_STAGE2(PG8_SB(1, 1), cB + hstepB + kstep, vB[0], vB[1]);
    PG8_WAIT_V(6); PG8_BAR;
    for (;;) {
        const bool has_next = S.next(ui + 1, nxt);
        const char* nA = has_next ? S.a_base(nxt) : cA; const char* nB = has_next ? S.b_base(nxt) : cB;
#pragma unroll 1
        for (int t = 0; t < nt; t += 2) {
            const bool last = (t == nt - 2);
            const char* a1 = cA + (size_t)(t + 1) * kstep;
            const char* a2 = last ? nA : cA + (size_t)(t + 2) * kstep; const char* b2 = last ? nB : cB + (size_t)(t + 2) * kstep;
            const char* a3 = a2 + kstep; const char* b3 = b2 + kstep;
            if constexpr (Hook::ACTIVE) { if (t == 2 && has_next && ui + 1 >= 2) H.fill(nxt, lds_all, (ui + 1) & 1); if (t >= 4 && (t & 3) == 0) H.rescale(acc, (t >> 2) - 1, lds_all, ui & 1, wr, fr); }
            PG8_LDB(B0, 0, 0); PG8_LDB(B1, 0, 1); PG8_SCHED; PG8_LDA(At, 0, 0); PG8_STAGE2(PG8_SA(1, 1), a1, vA[2], vA[3]);
            PG8_WAIT_V(8); PG8_WAIT_L(0); PG8_BAR; PG8_MMA(0, 0, At, B0); PG8_MMA(0, 1, At, B1); PG8_BAR; PG8_SCHED;
            if constexpr (Sched::GATHER) { if (last && has_next) S.rows(nxt, lds_all, vA); }
            PG8_LDA(At, 0, 1); PG8_STAGE2(PG8_SB(0, 0), b2, vB[0], vB[1]); PG8_STAGE2(PG8_SB(0, 1), b2 + hstepB, vB[0], vB[1]); PG8_STAGE2(PG8_SA(0, 0), a2, vA[0], vA[1]);
            PG8_WAIT_V(8); PG8_WAIT_L(0); PG8_BAR; PG8_MMA(1, 0, At, B0); PG8_MMA(1, 1, At, B1); PG8_BAR; PG8_SCHED;
            PG8_LDB(B0, 1, 0); PG8_LDB(B1, 1, 1); PG8_SCHED; PG8_LDA(At, 1, 0); PG8_STAGE2(PG8_SA(0, 1), a2, vA[2], vA[3]);
            PG8_WAIT_V(8); PG8_WAIT_L(0); PG8_BAR; PG8_MMA(0, 0, At, B0); PG8_MMA(0, 1, At, B1); PG8_BAR; PG8_SCHED;
            PG8_LDA(At, 1, 1); PG8_STAGE2(PG8_SB(1, 0), b3, vB[0], vB[1]); PG8_STAGE2(PG8_SB(1, 1), b3 + hstepB, vB[0], vB[1]); PG8_STAGE2(PG8_SA(1, 0), a3, vA[0], vA[1]);
            PG8_WAIT_V(8); PG8_WAIT_L(0); PG8_BAR; PG8_MMA(1, 0, At, B0); PG8_MMA(1, 1, At, B1); PG8_BAR; PG8_SCHED;
        }
        if (wr == 0) PG8_BAR;
        E(acc, cur, wr, wc, fr, fq, lds_all);
        if (!has_next) break;
#pragma unroll
        for (int a = 0; a < 2; ++a)
#pragma unroll
            for (int b = 0; b < 2; ++b)
#pragma unroll
                for (int m = 0; m < 4; ++m)
#pragma unroll
                    for (int n = 0; n < 2; ++n) acc[a][b][m][n] = (f32x4){0.f, 0.f, 0.f, 0.f};
        cur = nxt; cA = nA; cB = nB; ++ui;
        if (wr == 1) PG8_BAR;
    }
    PG8_WAIT_V(0);
    PG8_BAR;
}

__device__ __forceinline__ u32x4 pack8(const f32x4 v0, const f32x4 v1) { u32x4 w; w.x = cvt_pk_bf16(v0[0], v0[1]); w.y = cvt_pk_bf16(v0[2], v0[3]); w.z = cvt_pk_bf16(v1[0], v1[1]); w.w = cvt_pk_bf16(v1[2], v1[3]); return w; }

struct EpiBf16Rs {
    static constexpr bool PERM = true;
    bf16_t* O; int ldc; const float* rs;
    __device__ __forceinline__ void operator()(const f32x4 (&acc)[2][2][4][2], const Unit& u, int wr, int wc, int fr, int fq, LAS unsigned char*) const {
        const int row0 = u.pm * BM + wr * 64 + fr, col0 = u.pn * BM + wc * 32 + 8 * fq;
#pragma unroll
        for (int ai = 0; ai < 2; ++ai)
#pragma unroll
            for (int m = 0; m < 4; ++m) { const int row = row0 + ai * HALF + m * 16; const float s = rs ? rs[row] : 1.0f; bf16_t* rowp = O + (size_t)row * ldc + col0;
#pragma unroll
                for (int bj = 0; bj < 2; ++bj) *(u32x4*)(rowp + bj * HALF) = pack8(acc[ai][bj][m][0] * s, acc[ai][bj][m][1] * s); }
    }
};
__device__ __forceinline__ void unpack8(const u32x4 w, f32x4& lo, f32x4& hi) { lo = (f32x4){bf_lo(w.x), bf_hi(w.x), bf_lo(w.y), bf_hi(w.y)}; hi = (f32x4){bf_lo(w.z), bf_hi(w.z), bf_lo(w.w), bf_hi(w.w)}; }
template <bool F32IN, bool HS = false> struct EpiResid {
    static constexpr bool PERM = true;
    const void* hin; bf16_t* hout;
    __device__ __forceinline__ void operator()(const f32x4 (&acc)[2][2][4][2], const Unit& u, int wr, int wc, int fr, int fq, LAS unsigned char* lds_all) const {
        const int row0 = u.pm * BM + wr * 64 + fr, col0 = u.pn * BM + wc * 32 + 8 * fq;
        const LAS float* tab = (const LAS float*)(lds_all + TABA_OFF) + (u.ui & 1) * 1024;
#pragma unroll
        for (int ai = 0; ai < 2; ++ai) {
            u32x4 hv[4][2][F32IN ? 2 : 1];
#pragma unroll
            for (int m = 0; m < 4; ++m)
#pragma unroll
                for (int bj = 0; bj < 2; ++bj) { const size_t off = (size_t)(row0 + ai * HALF + m * 16) * D + col0 + bj * HALF;
                    if (F32IN) { hv[m][bj][0] = *(const u32x4*)((const float*)hin + off); hv[m][bj][F32IN ? 1 : 0] = *(const u32x4*)((const float*)hin + off + 4); }
                    else hv[m][bj][0] = *(const u32x4*)((const bf16_t*)hin + off); }
            __builtin_amdgcn_sched_barrier(0);
#pragma unroll
            for (int m = 0; m < 4; ++m) { const float f = HS ? tab[(ai * HALF + wr * 64 + m * 16 + fr) * 4 + 3] : 1.0f;
#pragma unroll
                for (int bj = 0; bj < 2; ++bj) { f32x4 lo, hi;
                    if (F32IN) { lo = __builtin_bit_cast(f32x4, hv[m][bj][0]); hi = __builtin_bit_cast(f32x4, hv[m][bj][F32IN ? 1 : 0]); } else unpack8(hv[m][bj][0], lo, hi);
                    *(u32x4*)(hout + (size_t)(row0 + ai * HALF + m * 16) * D + col0 + bj * HALF) = pack8(lo + acc[ai][bj][m][0] * f, hi + acc[ai][bj][m][1] * f); } }
            __builtin_amdgcn_sched_barrier(0);
        }
    }
};
struct EpiPool {
    static constexpr bool PERM = true;
    bf16_t* h; const float* bias; const float* sc;
    __device__ __forceinline__ void operator()(const f32x4 (&acc)[2][2][4][2], const Unit& u, int wr, int wc, int fr, int fq, LAS unsigned char*) const {
        const int row0 = u.pm * BM + wr * 64 + fr, col0 = u.pn * BM + wc * 32 + 8 * fq;
        f32x4 bv[2][2], sv[2][2];
#pragma unroll
        for (int bj = 0; bj < 2; ++bj) { bv[bj][0] = *(const f32x4*)(bias + col0 + bj * HALF); bv[bj][1] = *(const f32x4*)(bias + col0 + bj * HALF + 4); sv[bj][0] = *(const f32x4*)(sc + col0 + bj * HALF); sv[bj][1] = *(const f32x4*)(sc + col0 + bj * HALF + 4); }
#pragma unroll
        for (int ai = 0; ai < 2; ++ai) {
            u32x4 hv[4][2];
#pragma unroll
            for (int m = 0; m < 4; ++m)
#pragma unroll
                for (int bj = 0; bj < 2; ++bj) hv[m][bj] = *(const u32x4*)(h + (size_t)(row0 + ai * HALF + m * 16) * D + col0 + bj * HALF);
            __builtin_amdgcn_sched_barrier(0);
#pragma unroll
            for (int m = 0; m < 4; ++m)
#pragma unroll
                for (int bj = 0; bj < 2; ++bj) { f32x4 lo, hi; unpack8(hv[m][bj], lo, hi);
                    *(u32x4*)(h + (size_t)(row0 + ai * HALF + m * 16) * D + col0 + bj * HALF) = pack8(lo + (acc[ai][bj][m][0] + bv[bj][0]) * sv[bj][0], hi + (acc[ai][bj][m][1] + bv[bj][1]) * sv[bj][1]); }
            __builtin_amdgcn_sched_barrier(0);
        }
    }
};
struct EpiPle {
    static constexpr bool PERM = true;
    const bf16_t* hin; bf16_t* hout; const float* rs; const bf16_t* pp;
    __device__ __forceinline__ void operator()(const f32x4 (&acc)[2][2][4][2], const Unit& u, int wr, int wc, int fr, int fq, LAS unsigned char*) const {
        const int row0 = u.pm * BM + wr * 64 + fr, col0 = u.pn * BM + wc * 32 + 8 * fq;
#pragma unroll
        for (int ai = 0; ai < 2; ++ai) {
            u32x4 hv[4][2], pv[4][2]; float sr[4];
#pragma unroll
            for (int m = 0; m < 4; ++m) { const int row = row0 + ai * HALF + m * 16; sr[m] = rs[row];
#pragma unroll
                for (int bj = 0; bj < 2; ++bj) { const size_t off = (size_t)row * D + col0 + bj * HALF; hv[m][bj] = *(const u32x4*)(hin + off); pv[m][bj] = *(const u32x4*)(pp + off); } }
            __builtin_amdgcn_sched_barrier(0);
#pragma unroll
            for (int m = 0; m < 4; ++m)
#pragma unroll
                for (int bj = 0; bj < 2; ++bj) { f32x4 lo, hi, plo, phi; unpack8(hv[m][bj], lo, hi); unpack8(pv[m][bj], plo, phi);
                    const f32x4 a0 = acc[ai][bj][m][0] * sr[m], a1 = acc[ai][bj][m][1] * sr[m];
#pragma unroll
                    for (int j = 0; j < 4; ++j) { lo[j] += fsigmoid(a0[j]) * plo[j]; hi[j] += fsigmoid(a1[j]) * phi[j]; }
                    *(u32x4*)(hout + (size_t)(row0 + ai * HALF + m * 16) * D + col0 + bj * HALF) = pack8(lo, hi); }
            __builtin_amdgcn_sched_barrier(0);
        }
    }
};
struct EpiNone { static constexpr bool PERM = true; bf16_t* Y;
    __device__ __forceinline__ void operator()(const f32x4 (&acc)[2][2][4][2], const Unit& u, int, int, int, int, LAS unsigned char*) const { float s = 0.f;
#pragma unroll
        for (int a = 0; a < 2; ++a)
#pragma unroll
            for (int b = 0; b < 2; ++b)
#pragma unroll
                for (int m = 0; m < 4; ++m)
#pragma unroll
                    for (int n = 0; n < 2; ++n) s += acc[a][b][m][n][0] + acc[a][b][m][n][1] + acc[a][b][m][n][2] + acc[a][b][m][n][3];
        if (s == 1.2345f) Y[u.pm] = 1; } };
struct EpiUp {
    static constexpr bool PERM = true;
    bf16_t* H;
    __device__ __forceinline__ void operator()(const f32x4 (&acc)[2][2][4][2], const Unit& u, int wr, int wc, int fr, int fq, LAS unsigned char* lds_all) const {
        const LAS float* rst = (const LAS float*)(lds_all + TABB_OFF) + u.ui * 256;
        const int r0 = wr * 64 + fr, col0 = u.pn * HALF + wc * 32 + 8 * fq;
#pragma unroll
        for (int ai = 0; ai < 2; ++ai)
#pragma unroll
            for (int m = 0; m < 4; ++m) { const int r = r0 + ai * HALF + m * 16; const float s = rst[r];
                f32x4 h0, h1;
#pragma unroll
                for (int j = 0; j < 4; ++j) { h0[j] = fsilu(acc[ai][0][m][0][j] * s) * (acc[ai][1][m][0][j] * s); h1[j] = fsilu(acc[ai][0][m][1][j] * s) * (acc[ai][1][m][1][j] * s); }
                *(u32x4*)(H + ((size_t)u.pm * BM + r) * DFF + col0) = pack8(h0, h1); }
    }
};
struct EpiDown {
    static constexpr bool PERM = true;
    bf16_t* Y;
    __device__ __forceinline__ void operator()(const f32x4 (&acc)[2][2][4][2], const Unit& u, int wr, int wc, int fr, int fq, LAS unsigned char* lds_all) const {
        const LAS int* at = (const LAS int*)(lds_all + TABA_OFF) + u.ui * 256; const LAS float* wt = (const LAS float*)(lds_all + TABB_OFF) + u.ui * 256;
        const int r0 = wr * 64 + fr, col0 = u.pn * BM + wc * 32 + 8 * fq;
#pragma unroll
        for (int ai = 0; ai < 2; ++ai)
#pragma unroll
            for (int m = 0; m < 4; ++m) { const int r = r0 + ai * HALF + m * 16; const int a = at[r]; const float w = wt[r];
                if (a >= 0) { bf16_t* rowp = Y + (size_t)a * D + col0;
#pragma unroll
                    for (int bj = 0; bj < 2; ++bj) *(u32x4*)(rowp + bj * HALF) = pack8(acc[ai][bj][m][0] * w, acc[ai][bj][m][1] * w); } }
    }
};
struct CvtRegs { f32x4 v[8]; float g[8]; };
template <bool TAIL>
__device__ __forceinline__ void cvt_load(CvtRegs& R, const float* __restrict__ src, int ldsrc, int col0, int N, const float* __restrict__ kscale, int kmod, float scalar, int k0, int n0, int lane) {
    const int lr = lane >> 3, lc = (lane & 7) * 4;
#pragma unroll
    for (int i = 0; i < 8; ++i) { const int kk = lr + 8 * i;
        if (!TAIL || n0 + lc + 3 < N) R.v[i] = __builtin_nontemporal_load((const f32x4*)(src + (size_t)(k0 + kk) * ldsrc + col0 + n0 + lc));
        else {
#pragma unroll
            for (int j = 0; j < 4; ++j) R.v[i][j] = (n0 + lc + j < N) ? src[(size_t)(k0 + kk) * ldsrc + col0 + n0 + lc + j] : 0.f; }
        R.g[i] = (kscale ? kscale[(k0 + kk) % kmod] : 1.0f) * scalar; }
}
template <int MODE>
__device__ __forceinline__ void cvt_finish(const CvtRegs& R, int K, int N, bf16_t* __restrict__ dst, int row0, size_t lo_off, LAS float* scr, int k0, int n0, int lane) {
    { const int lr = lane >> 3, lc = (lane & 7) * 4;
#pragma unroll
      for (int i = 0; i < 8; ++i) { const int kk = lr + 8 * i;
#pragma unroll
          for (int j = 0; j < 4; ++j) scr[kk * 33 + lc + j] = R.v[i][j] * R.g[i]; } }
    LDS_WAIT(); asm volatile("" ::: "memory");
    const int c = lane & 7;
#pragma unroll
    for (int j = 0; j < 4; ++j) { const int n = (lane >> 3) + 8 * j; const LAS float* sp = scr + (8 * c) * 33 + n;
        float f[8];
#pragma unroll
        for (int q = 0; q < 8; ++q) f[q] = sp[q * 33];
        if (n0 + n < N) {
            const int nn = n0 + n;
            int drow = row0 + nn;
            if (MODE == 1) drow = (nn >> 7) * 256 + (nn & 127);
            if (MODE == 2) drow = (nn >> 7) * 256 + 128 + (nn & 127);
            u32x4 o; o.x = cvt_pk_bf16(f[0], f[1]); o.y = cvt_pk_bf16(f[2], f[3]); o.z = cvt_pk_bf16(f[4], f[5]); o.w = cvt_pk_bf16(f[6], f[7]);
            *(u32x4*)(dst + (size_t)drow * K + k0 + 8 * c) = o;
            if (MODE == 3) { float l[8]; const unsigned ow[4] = {o.x, o.y, o.z, o.w};
#pragma unroll
                for (int q = 0; q < 4; ++q) { l[2 * q] = f[2 * q] - bf_lo(ow[q]); l[2 * q + 1] = f[2 * q + 1] - bf_hi(ow[q]); }
                u32x4 p; p.x = cvt_pk_bf16(l[0], l[1]); p.y = cvt_pk_bf16(l[2], l[3]); p.z = cvt_pk_bf16(l[4], l[5]); p.w = cvt_pk_bf16(l[6], l[7]);
                *(u32x4*)(dst + lo_off + (size_t)drow * K + k0 + 8 * c) = p; }
        }
    }
    LDS_WAIT(); asm volatile("" ::: "memory");
}
template <int MODE>
__device__ __forceinline__ void cvt_item(const float* __restrict__ src, int ldsrc, int col0, int K, int N, bf16_t* __restrict__ dst, int row0, const float* __restrict__ kscale, int kmod, float scalar,
                                         size_t lo_off, LAS float* scr, int item, int lane) {
    const int nblk = (N + 31) / 32, kb = item / nblk, nb = item - kb * nblk, k0 = 64 * kb, n0 = 32 * nb;
    CvtRegs R; cvt_load<true>(R, src, ldsrc, col0, N, kscale, kmod, scalar, k0, n0, lane);
    cvt_finish<MODE>(R, K, N, dst, row0, lo_off, scr, k0, n0, lane);
}
template <int MODE>
__device__ __forceinline__ void cvt_matrix(const float* src, int ldsrc, int col0, int K, int N, bf16_t* dst, int row0, const float* kscale, int kmod, float scalar, size_t lo_off,
                                           LAS float* scr, int gw, int NGW, int lane) {
    const int nitems = (K / 64) * ((N + 31) / 32);
    for (int it = gw; it < nitems; it += NGW) cvt_item<MODE>(src, ldsrc, col0, K, N, dst, row0, kscale, kmod, scalar, lo_off, scr, it, lane);
}

struct Ptrs {
    const float* in[23]; float* out; unsigned char* ws; int ph_lo, ph_hi;
};

typedef const __attribute__((address_space(4))) Ptrs CPtrs;
__device__ __forceinline__ CPtrs* kargs() { CPtrs* p = (CPtrs*)__builtin_amdgcn_kernarg_segment_ptr(); asm volatile("" : "+s"(p)); return p; }

template <int PART>
__device__ __forceinline__ void convert_moe_layer(CPtrs& P, LAS unsigned char* lds, int layer, int it0, int step, int end, int wave, int lane) {
    LAS float* scr = (LAS float*)(lds + wave * 8448);
    unsigned char* ws = P.ws;
    const float* nf = P.in[3] + layer * D;
    const float* wg = P.in[18] + (size_t)layer * NE * D * DFF; const float* wu = P.in[19] + (size_t)layer * NE * D * DFF; const float* wd = P.in[20] + (size_t)layer * NE * DFF * D;
    bf16_t* gu0 = (bf16_t*)(ws + WS_WGU) + (size_t)layer * NE * 768 * D; bf16_t* dn0 = (bf16_t*)(ws + WS_WD) + (size_t)layer * NE * D * DFF;
    constexpr int PER = PART ? 192 : 384;
    auto decode = [&](int it, int& e, int& which, int& k0, int& n0) { e = it / PER; const int r = it - e * PER; which = PART ? 2 : r / 192; const int rr = PART ? r : r - which * 192;
        const int nblk = (which == 2) ? 32 : 12, kb = rr / nblk; k0 = 64 * kb; n0 = 32 * (rr - kb * nblk); };
    auto issue = [&](CvtRegs& R, int it) { int e, which, k0, n0; decode(it, e, which, k0, n0);
        if (which == 0) cvt_load<false>(R, wg + (size_t)e * D * DFF, DFF, 0, DFF, nf, D, 1.0f, k0, n0, lane);
        else if (which == 1) cvt_load<false>(R, wu + (size_t)e * D * DFF, DFF, 0, DFF, nf, D, 1.0f, k0, n0, lane);
        else cvt_load<false>(R, wd + (size_t)e * DFF * D, D, 0, D, nullptr, 1, 1.0f, k0, n0, lane); };
    auto finish = [&](const CvtRegs& R, int it) { int e, which, k0, n0; decode(it, e, which, k0, n0);
        bf16_t* gu = gu0 + (size_t)e * 768 * D; bf16_t* dn = dn0 + (size_t)e * D * DFF;
        if (which == 0) cvt_finish<1>(R, D, DFF, gu, 0, 0, scr, k0, n0, lane);
        else if (which == 1) cvt_finish<2>(R, D, DFF, gu, 0, 0, scr, k0, n0, lane);
        else cvt_finish<0>(R, DFF, D, dn, 0, 0, scr, k0, n0, lane); };
    CvtRegs Ra, Rb;
    int it = it0;
    if (it < end) issue(Ra, it);
    while (it < end) {
        const int n1 = it + step; if (n1 < end) issue(Rb, n1);
        finish(Ra, it);
        const int n2 = n1 + step; if (n1 < end) { if (n2 < end) issue(Ra, n2); finish(Rb, n1); }
        it = n2;
    }
}

__device__ __forceinline__ void prologue(CPtrs& P, LAS unsigned char* lds, int vcu, int G, int wave, int lane) {
    LAS float* scr = (LAS float*)(lds + wave * 8448);
    const int gw = vcu * NWAVES + wave, NGW = G * NWAVES;
    unsigned char* ws = P.ws;
    const float* norm_mix = P.in[2]; const float* norm_ffn = P.in[3]; const float* norm_ple = P.in[4];
    int rot = 0;
#define ROT() ((gw + NGW - (rot++ * 397) % NGW) % NGW)
    for (int j = 0; j < 2; ++j) {
        const float* win = P.in[6] + (size_t)j * D * GIN;
        bf16_t* wt = (bf16_t*)(ws + WS_WIN) + (size_t)j * NPROJ * D;
        cvt_matrix<0>(win, GIN, 0, D, 512, wt, 0, norm_mix + (2 * j) * D, D, 0.08838834764831845f, 0, scr, ROT(), NGW, lane);
        cvt_matrix<0>(win, GIN, 512, D, 2560, wt, 512, norm_mix + (2 * j) * D, D, 1.0f, 0, scr, ROT(), NGW, lane);
        cvt_matrix<3>(win, GIN, 3072, D, 16, (bf16_t*)(ws + WS_WLR) + (size_t)j * 2 * 16 * D, 0, norm_mix + (2 * j) * D, D, 1.0f, (size_t)16 * D, scr, ROT(), NGW, lane);
        cvt_matrix<0>(P.in[10] + (size_t)j * D * D, D, 0, D, D, (bf16_t*)(ws + WS_WOUT) + (size_t)j * D * D, 0, P.in[9] + j * 256, 256, 1.0f, 0, scr, ROT(), NGW, lane);
        for (int g = 0; g < 4; ++g)
            cvt_matrix<0>(P.in[11] + ((size_t)j * 4 + g) * 256 * 256, 256, 0, 256, 256, (bf16_t*)(ws + WS_WPOOL) + ((size_t)j * 4 + g) * 256 * 256, 0, norm_mix + (2 * j + 1) * D + g * 256, 256, 1.0f, 0, scr, ROT(), NGW, lane);
    }
    for (int i = 0; i < 4; ++i) {
        bf16_t* wr = (bf16_t*)(ws + WS_WR) + (size_t)i * 2 * 80 * D;
        cvt_matrix<3>(P.in[14] + (size_t)i * D * 8, 8, 0, D, 8, wr, 0, norm_ffn + i * D, D, 1.0f, (size_t)80 * D, scr, ROT(), NGW, lane);
        cvt_matrix<3>(P.in[16] + (size_t)i * D * 64, 64, 0, D, 64, wr, 8, norm_ffn + i * D, D, 1.0f, (size_t)80 * D, scr, ROT(), NGW, lane);
        cvt_matrix<0>(P.in[21] + (size_t)i * D * D, D, 0, D, D, (bf16_t*)(ws + WS_WPG) + (size_t)i * D * D, 0, norm_ple + i * D, D, 1.0f, 0, scr, ROT(), NGW, lane);
        cvt_matrix<0>(P.in[22] + (size_t)i * PLE * D, D, 0, PLE, D, (bf16_t*)(ws + WS_WPP) + (size_t)i * D * PLE, 0, nullptr, 1, 1.0f, 0, scr, ROT(), NGW, lane);
        for (int idx = gw * 64 + lane; idx < 2 * 8 * D / 8; idx += NGW * 64) { const int hl = idx / (8 * D / 8), rem = idx - hl * (8 * D / 8);
            *(u32x4*)(wr + (size_t)hl * 80 * D + (size_t)72 * D + (size_t)rem * 8) = (u32x4){0u, 0u, 0u, 0u}; }
    }
#undef ROT
    {
        const float* p = P.in[1]; bf16_t* pb = (bf16_t*)(ws + WS_PB);
        const size_t n8 = (size_t)4 * T * PLE / 8;
        for (size_t i = (size_t)gw * 64 + lane; i < n8; i += (size_t)NGW * 64) {
            const f32x4 a = *(const f32x4*)(p + i * 8), b = *(const f32x4*)(p + i * 8 + 4);
            *(u32x4*)(pb + i * 8) = pack8(a, b); }
    }
}

constexpr int NPB_STRIDE = 288;
template <int MODE, bool F32IN>
__device__ __forceinline__ void np_pass(LAS unsigned char* lds, const void* __restrict__ hin, bf16_t* __restrict__ hb, float* __restrict__ rs,
                                        const bf16_t* __restrict__ Wsm  , float* __restrict__ lr, const bf16_t* __restrict__ Y,
                                        const float* __restrict__ bc, const float* __restrict__ bfine, unsigned* cnt, int* __restrict__ list, float* __restrict__ wts,
                                        int G, int wave, int lane, bool do_lists = true, bf16_t* hout2 = nullptr) {
    constexpr int NR = (MODE == 1) ? 80 : 16, NT = NR / 16;
    constexpr int BUFB = 2 * NR * NPB_STRIDE;
    int tid_ = threadIdx.x; asm volatile("" : "+v"(tid_));
    const int tid = tid_, r = lane & 15, g = lane >> 4;
    for (int blk = ((G % 8 == 0) ? (int)(blockIdx.x % 8) * (G / 8) + (int)(blockIdx.x / 8) : (int)blockIdx.x); blk < T / 128; blk += G) {
        const int row0 = blk * 128 + wave * 16;
        float ss = 0.f;
        if constexpr (MODE == 2) {
            bf16_t* hrow = hb + (size_t)(row0 + r) * D + 8 * g; bf16_t* orow = (hout2 ? hout2 : hb) + (size_t)(row0 + r) * D + 8 * g;
            const bf16_t* y0 = Y + (size_t)(2 * (row0 + r)) * D + 8 * g; const bf16_t* y1 = y0 + D;
            u32x4 hA[8], yA[8], zA[8], hB[8], yB[8], zB[8];
            auto ldb = [&](u32x4 (&h)[8], u32x4 (&y)[8], u32x4 (&z)[8], int bt) {
#pragma unroll
                for (int i = 0; i < 8; ++i) { const int kk = 8 * bt + i; h[i] = *(const u32x4*)(hrow + 32 * kk); y[i] = *(const u32x4*)(y0 + 32 * kk); z[i] = *(const u32x4*)(y1 + 32 * kk); }
                __builtin_amdgcn_sched_barrier(0); };
            auto stb = [&](const u32x4 (&h)[8], const u32x4 (&y)[8], const u32x4 (&z)[8], int bt) {
#pragma unroll
                for (int i = 0; i < 8; ++i) { const int kk = 8 * bt + i;
                    f32x4 a, b, p0, p1, q0, q1;
                    unpack8(h[i], a, b); unpack8(y[i], p0, p1); unpack8(z[i], q0, q1);
                    a += p0 + q0; b += p1 + q1;
                    const u32x4 w = pack8(a, b);
                    *(u32x4*)(orow + 32 * kk) = w;
                    unpack8(w, a, b);
                    ss += (a[0] * a[0] + a[1] * a[1]) + (a[2] * a[2] + a[3] * a[3]) + (b[0] * b[0] + b[1] * b[1]) + (b[2] * b[2] + b[3] * b[3]); }
                __builtin_amdgcn_sched_barrier(0); };
            ldb(hA, yA, zA, 0); ldb(hB, yB, zB, 1);
            stb(hA, yA, zA, 0); ldb(hA, yA, zA, 2);
            stb(hB, yB, zB, 1); ldb(hB, yB, zB, 3);
            stb(hA, yA, zA, 2); stb(hB, yB, zB, 3);
            ss += __shfl_xor(ss, 16); ss += __shfl_xor(ss, 32);
            if (lane < 16) rs[row0 + lane] = 1.0f / sqrtf(ss * (1.0f / D) + EPS);
        } else {
            f32x4 acc[NT];
#pragma unroll
            for (int i = 0; i < NT; ++i) acc[i] = (f32x4){0.f, 0.f, 0.f, 0.f};
            constexpr int PPT = (2 * NR * 16) / NTHREADS;
            static_assert(PPT * NTHREADS == 2 * NR * 16, "pieces");
            u32x4 breg[PPT];
            const unsigned goff0 = (unsigned)(tid >> 4) * (unsigned)(D * 2) + (unsigned)(tid & 15) * 16u, loff0 = (unsigned)(tid >> 4) * (unsigned)NPB_STRIDE + (unsigned)(tid & 15) * 16u;
            auto bload = [&](int c) {
                const char* gb = (const char*)Wsm + c * 256;
#pragma unroll
                for (int i = 0; i < PPT; ++i) breg[i] = *(const u32x4*)(gb + (goff0 + (unsigned)(i * 32 * D * 2)));
            };
            auto bstore = [&](int buf) {
#pragma unroll
                for (int i = 0; i < PPT; ++i) *(LAS u32x4*)(lds + buf * BUFB + loff0 + i * 32 * NPB_STRIDE) = breg[i];
            };
            constexpr int AW = F32IN ? 2 : 1;
            const char* hrow = F32IN ? (const char*)((const float*)hin + (size_t)(row0 + r) * D + 8 * g) : (const char*)((const bf16_t*)hin + (size_t)(row0 + r) * D + 8 * g);
            constexpr int KSB = F32IN ? 128 : 64;
            bf16_t* brow = hb + (size_t)(row0 + r) * D + 8 * g;
            auto kstep = [&](const u32x4 (&hv)[AW], int c, int kk, int cb) {
                bf16x8 ah, al;
                if constexpr (F32IN) {
                    const f32x4 a = __builtin_bit_cast(f32x4, hv[0]), b = __builtin_bit_cast(f32x4, hv[AW - 1]);
                    const u32x4 hi = pack8(a, b);
                    *(u32x4*)(brow + 128 * c + 32 * kk) = hi;
                    f32x4 ha, hb2; unpack8(hi, ha, hb2);
                    ss += (ha[0] * ha[0] + ha[1] * ha[1]) + (ha[2] * ha[2] + ha[3] * ha[3]) + (hb2[0] * hb2[0] + hb2[1] * hb2[1]) + (hb2[2] * hb2[2] + hb2[3] * hb2[3]);
                    ah = __builtin_bit_cast(bf16x8, hi); al = __builtin_bit_cast(bf16x8, pack8(a - ha, b - hb2));
                } else {
                    f32x4 ha, hb2; unpack8(hv[0], ha, hb2);
                    ss += (ha[0] * ha[0] + ha[1] * ha[1]) + (ha[2] * ha[2] + ha[3] * ha[3]) + (hb2[0] * hb2[0] + hb2[1] * hb2[1]) + (hb2[2] * hb2[2] + hb2[3] * hb2[3]);
                    ah = __builtin_bit_cast(bf16x8, hv[0]); al = ah;
                }
#pragma unroll
                for (int nt = 0; nt < NT; ++nt) {
                    const bf16x8 bh = *(const LAS bf16x8*)(lds + cb * BUFB + (nt * 16 + r) * NPB_STRIDE + (32 * kk + 8 * g) * 2);
                    const bf16x8 bl = *(const LAS bf16x8*)(lds + cb * BUFB + (NR + nt * 16 + r) * NPB_STRIDE + (32 * kk + 8 * g) * 2);
                    acc[nt] = __builtin_amdgcn_mfma_f32_16x16x32_bf16(ah, bh, acc[nt], 0, 0, 0);
                    if constexpr (F32IN) acc[nt] = __builtin_amdgcn_mfma_f32_16x16x32_bf16(al, bh, acc[nt], 0, 0, 0);
                    acc[nt] = __builtin_amdgcn_mfma_f32_16x16x32_bf16(ah, bl, acc[nt], 0, 0, 0);
                }
            };
            if constexpr (!F32IN) {
                u32x4 hall[32][1];
#pragma unroll
                for (int ks = 0; ks < 32; ++ks) hall[ks][0] = *(const u32x4*)(hrow + (size_t)ks * KSB);
                bload(0); bstore(0);
                __syncthreads();
#pragma unroll
                for (int c = 0; c < 8; ++c) {
                    const int cb = c & 1;
                    if (c < 7) bload(c + 1);
#pragma unroll
                    for (int kk = 0; kk < 4; ++kk) kstep(hall[4 * c + kk], c, kk, cb);
                    if (c < 7) bstore(cb ^ 1);
                    __syncthreads();
                }
            } else {
                u32x4 hva[4][AW], hvb[4][AW];
                auto aload = [&](u32x4 (&hv)[4][AW], int c) {
#pragma unroll
                    for (int kk = 0; kk < 4; ++kk)
#pragma unroll
                        for (int w = 0; w < AW; ++w) hv[kk][w] = *(const u32x4*)(hrow + (size_t)(4 * c + kk) * KSB + 16 * w);
                };
                bload(0); bstore(0);
                aload(hva, 0);
                __syncthreads();
#pragma unroll 1
                for (int c = 0; c < 8; c += 2) {
                    bload(c + 1); aload(hvb, c + 1);
#pragma unroll
                    for (int kk = 0; kk < 4; ++kk) kstep(hva[kk], c, kk, 0);
                    bstore(1);
                    __syncthreads();
                    if (c + 2 < 8) { bload(c + 2); aload(hva, c + 2); }
#pragma unroll
                    for (int kk = 0; kk < 4; ++kk) kstep(hvb[kk], c + 1, kk, 1);
                    if (c + 2 < 8) bstore(0);
                    __syncthreads();
                }
            }
            ss += __shfl_xor(ss, 16); ss += __shfl_xor(ss, 32);
            const float rsv = 1.0f / sqrtf(ss * (1.0f / D) + EPS);
            if (lane < 16) rs[row0 + lane] = rsv;
            float rsr[4];
#pragma unroll
            for (int j = 0; j < 4; ++j) rsr[j] = __shfl(rsv, 4 * g + j);
            if constexpr (MODE == 0) {
#pragma unroll
                for (int j = 0; j < 4; ++j) lr[(size_t)(row0 + 4 * g + j) * 16 + r] = acc[0][j] * rsr[j];
            } else {
                LAS float* slog = (LAS float*)(lds) + wave * 16 * 80;
                LAS int* hist = (LAS int*)(lds + 8 * 16 * 80 * 4);
#pragma unroll
                for (int nt = 0; nt < NT; ++nt) { const int n = nt * 16 + r; const float bias = (n < 8) ? bc[n] : ((n < 72) ? bfine[n - 8] : 0.f);
#pragma unroll
                    for (int j = 0; j < 4; ++j) slog[(4 * g + j) * 80 + n] = acc[nt][j] * rsr[j] + bias; }
                if (tid < 64) hist[tid] = 0;
                __syncthreads();
                if (do_lists) {
                int ea = 0, eb = 0, pa = 0, pb = 0; float w0 = 0.f, w1 = 0.f;
                if (lane < 16) {
                    const LAS float* L = slog + lane * 80;
                    int gq = 0; float m = L[0];
#pragma unroll
                    for (int j = 1; j < 8; ++j) { const float v = L[j]; if (v > m) { m = v; gq = j; } }
                    float den = 0.f;
#pragma unroll
                    for (int j = 0; j < 8; ++j) den += __expf(L[j] - m);
                    const float pg = 1.0f / den;
                    const LAS float* f = L + 8 + gq * 8;
                    int i0 = 0; float v0 = f[0];
#pragma unroll
                    for (int j = 1; j < 8; ++j) { const float v = f[j]; if (v > v0) { v0 = v; i0 = j; } }
                    int i1 = -1; float v1 = 0.f;
#pragma unroll
                    for (int j = 0; j < 8; ++j) { const float v = f[j]; if (j != i0 && (i1 < 0 || v > v1)) { v1 = v; i1 = j; } }
                    const float e1 = __expf(v1 - v0); w0 = pg / (1.0f + e1); w1 = pg * e1 / (1.0f + e1);
                    ea = gq * 8 + i0; eb = gq * 8 + i1;
                    pa = atomicAdd((int*)&hist[ea], 1); pb = atomicAdd((int*)&hist[eb], 1);
                }
                __syncthreads();
                if (tid < 64) { const int c = hist[tid]; hist[64 + tid] = c ? (int)atomicAdd(cnt + tid, (unsigned)c) : 0; }
                __syncthreads();
                if (lane < 16) { const int t = row0 + lane;
                    list[(size_t)ea * CAP + hist[64 + ea] + pa] = 2 * t; wts[2 * t] = w0;
                    list[(size_t)eb * CAP + hist[64 + eb] + pb] = 2 * t + 1; wts[2 * t + 1] = w1; }
                }
                __syncthreads();
            }
        }
    }
}

constexpr int GS128 = 288, GS64 = 160;
constexpr int G_QD = 0, G_KI = G_QD + 64 * GS128, G_KE = G_KI + 64 * GS128, G_BLOB = G_KE + 128 * GS64;
constexpr int G_VT = G_BLOB, G_AT = G_VT + 2 * 64 * GS64, G_ST = G_AT + 64 * GS64, G_OT = G_ST + 2 * 64 * GS128, G_SQ = G_OT + 64 * 144, G_END = G_SQ + 64 * 8;
static_assert(G_END <= MISC_OFF && G_BLOB % 16 == 0, "GLA LDS");
static_assert(G_BLOB == 7 * NTHREADS * 16, "blob pieces");
__device__ __forceinline__ bf16x8 ldfrag(const LAS unsigned char* img, int stride, int row, int kbyte) { return *(const LAS bf16x8*)(img + row * stride + kbyte); }
#define GLA_BAR() asm volatile("s_waitcnt lgkmcnt(0)\n\ts_barrier" ::: "memory")

__device__ __forceinline__ void gla_pre(LAS unsigned char* lds, const bf16_t* __restrict__ proj, const float* __restrict__ lr, const float* __restrict__ wgk, const float* __restrict__ bgk,
                                        unsigned char* __restrict__ gimg, int vcu, int G, int wave, int lane) {
    const int cp = lane, r = lane & 15, g = lane >> 4;
    int parity = 0, cur_hd = -1;
    f32x2 wgp[16]; f32x2 bg = (f32x2){0.f, 0.f};
    unsigned qv[8], kv[8], qn[8], kn[8]; float lrv[2], lrn[2]; bool first = true;
    auto load_item = [&](int item, unsigned (&q)[8], unsigned (&k)[8], float (&l)[2]) {
        const int b = item >> 7, hd = (item >> 5) & 3, n = item & 31; const size_t tb = (size_t)b * SEQ + 64 * n;
#pragma unroll
        for (int tt = 0; tt < 8; ++tt) { const bf16_t* rowp = proj + (tb + 8 * wave + tt) * NPROJ; q[tt] = *(const unsigned*)(rowp + hd * 128 + 2 * cp); k[tt] = *(const unsigned*)(rowp + 512 + hd * 128 + 2 * cp); }
#pragma unroll
        for (int x = 0; x < 2; ++x) l[x] = lr[(tb + 8 * wave + 4 * x + g) * 16 + r];
    };
    for (int item = vcu; item < NB * 4 * 32; item += G, parity ^= 1) {
        const int b = item >> 7, hd = (item >> 5) & 3, n = item & 31;
        if (hd != cur_hd) { cur_hd = hd;
#pragma unroll
            for (int q = 0; q < 16; ++q) wgp[q] = *(const f32x2*)(wgk + q * 512 + hd * 128 + 2 * cp);
            bg = *(const f32x2*)(bgk + hd * 128 + 2 * cp); }
        if (first) { first = false; load_item(item, qv, kv, lrv); }
        float b0[8], b1[8];
        {
            float c0 = 0.f, c1 = 0.f;
#pragma unroll
            for (int tt = 0; tt < 8; ++tt) {
                f32x2 z2 = bg;
#pragma unroll
                for (int q = 0; q < 16; ++q) { const float sv = __builtin_bit_cast(float, __builtin_amdgcn_readlane(__builtin_bit_cast(int, lrv[tt >> 2]), (tt & 3) * 16 + q)); z2 = __builtin_elementwise_fma((f32x2){sv, sv}, wgp[q], z2); }
                const float z0 = z2.x, z1 = z2.y;
                const float g0 = (fminf(z0, 0.f) - __logf(1.0f + __expf(-fabsf(z0)))) * 0.0625f, g1 = (fminf(z1, 0.f) - __logf(1.0f + __expf(-fabsf(z1)))) * 0.0625f;
                c0 += g0; c1 += g1; b0[tt] = c0; b1[tt] = c1;
            }
            *(LAS f32x2*)(lds + ((parity * 8 + wave) * 128 + 2 * cp) * 4) = (f32x2){c0, c1};
        }
        GLA_BAR();
        { const int nitem = item + G; load_item(nitem < NB * 4 * 32 ? nitem : item, qn, kn, lrn); }
        float off0 = 0.f, off1 = 0.f, tot0 = 0.f, tot1 = 0.f;
#pragma unroll
        for (int sg = 0; sg < 8; ++sg) { const f32x2 v = *(const LAS f32x2*)(lds + ((parity * 8 + sg) * 128 + 2 * cp) * 4); tot0 += v.x; tot1 += v.y; if (sg < wave) { off0 += v.x; off1 += v.y; } }
        unsigned char* blob = gimg + (size_t)item * G_BLOB;
        float e0[8], e1[8];
        const float et0 = __expf(tot0), et1 = __expf(tot1);
#pragma unroll
        for (int tt = 0; tt < 8; ++tt) {
            const float bb0 = off0 + b0[tt], bb1 = off1 + b1[tt];
            const float q0 = bf_lo(qv[tt]), q1 = bf_hi(qv[tt]), k0 = bf_lo(kv[tt]), k1 = bf_hi(kv[tt]);
            const int tok = 8 * wave + tt;
            const float x0 = __expf(bb0), x1 = __expf(bb1), i0 = __builtin_amdgcn_rcpf(x0), i1 = __builtin_amdgcn_rcpf(x1);
            *(unsigned*)(blob + G_QD + tok * GS128 + 4 * cp) = cvt_pk_bf16(q0 * x0, q1 * x1);
            *(unsigned*)(blob + G_KI + tok * GS128 + 4 * cp) = cvt_pk_bf16(k0 * i0, k1 * i1);
            e0[tt] = k0 * __expf(tot0 - bb0); e1[tt] = k1 * __expf(tot1 - bb1);
        }
        u32x4 ke0, ke1;
        ke0.x = cvt_pk_bf16(e0[0], e0[1]); ke0.y = cvt_pk_bf16(e0[2], e0[3]); ke0.z = cvt_pk_bf16(e0[4], e0[5]); ke0.w = cvt_pk_bf16(e0[6], e0[7]);
        ke1.x = cvt_pk_bf16(e1[0], e1[1]); ke1.y = cvt_pk_bf16(e1[2], e1[3]); ke1.z = cvt_pk_bf16(e1[4], e1[5]); ke1.w = cvt_pk_bf16(e1[6], e1[7]);
        *(u32x4*)(blob + G_KE + (2 * cp) * GS64 + 16 * wave) = ke0;
        *(u32x4*)(blob + G_KE + (2 * cp + 1) * GS64 + 16 * wave) = ke1;
        if (wave == 0) { *(float*)(blob + G_KE + (2 * cp) * GS64 + 128) = et0; *(float*)(blob + G_KE + (2 * cp + 1) * GS64 + 128) = et1; }
#pragma unroll
        for (int tt = 0; tt < 8; ++tt) { qv[tt] = qn[tt]; kv[tt] = kn[tt]; }
        lrv[0] = lrn[0]; lrv[1] = lrn[1];
    }
    __syncthreads();
}

template <int SMODE = 0>
__device__ __forceinline__ void gla_scan(LAS unsigned char* lds, const bf16_t* __restrict__ proj, const unsigned char* __restrict__ gimg, bf16_t* __restrict__ og, float* __restrict__ ssp,
                                         int vcu, int G, int wave, int lane) {
    int tid_ = threadIdx.x; asm volatile("" : "+v"(tid_));
    const int tid = tid_, r = lane & 15, g = lane >> 4;
    const int it = wave >> 1, half = wave & 1;
    constexpr int G_RT = G_SQ + 64 * 8;
    static_assert(G_RT + 64 * 144 <= MISC_OFF, "GLA LDS (RT)");
    constexpr int NLD = 448;
    for (int unit = vcu; unit < NB * 4 * 4; unit += G) {
        const int b = unit >> 4, hd = (unit >> 2) & 3, cs = unit & 3;
        const size_t t0 = (size_t)b * SEQ;
        const unsigned char* blob0 = gimg + (size_t)((b * 4 + hd) * 32) * G_BLOB;
        for (int i = tid; i < 64 * GS128 / 16; i += NTHREADS) *(LAS u32x4*)(lds + G_ST + i * 16) = (u32x4){0u, 0u, 0u, 0u};
        f32x4 S[4];
#pragma unroll
        for (int i = 0; i < 4; ++i) S[i] = (f32x4){0.f, 0.f, 0.f, 0.f};
        int pvr[3]; pvr[0] = tid; pvr[1] = tid + NLD; pvr[2] = (tid + 2 * NLD) & 1023;
        unsigned voff[3];
#pragma unroll
        for (int i = 0; i < 3; ++i) { const int p = pvr[i]; const bool isv = p < 512; const int q = p & 511; const int row = isv ? (q & 63) : (q >> 3), pc = isv ? (q >> 6) : (q & 7);
            voff[i] = (unsigned)(row * NPROJ + (isv ? 1024 : 2048) + hd * 256 + cs * 64 + pc * 8) * 2u; }
        const unsigned boff = (unsigned)tid * 16u, foff = (unsigned)((lane >> 3) * D + (lane & 7) * 8) * 2u;
        u32x4 pb[8], pv[3];
        auto prefetch = [&](int n) {
            const unsigned char* bl = blob0 + (size_t)n * G_BLOB; const char* pr = (const char*)(proj + (t0 + 64 * n) * NPROJ);
#pragma unroll
            for (int i = 0; i < 8; ++i) pb[i] = *(const u32x4*)((bl + (size_t)i * NLD * 16) + boff);
#pragma unroll
            for (int i = 0; i < 3; ++i) pv[i] = *(const u32x4*)(pr + voff[i]);
        };
        auto flush = [&](int n) {
            char* ob = (char*)(og + (t0 + 64 * n) * D + hd * 256 + cs * 64);
#pragma unroll
            for (int i = 0; i < 8; ++i) { const u32x4 w = *(const LAS u32x4*)(lds + G_OT + i * 8 * 144 + (lane >> 3) * 144 + (lane & 7) * 16);
                *(u32x4*)((ob + (size_t)i * 8 * D * 2) + foff) = w; }
            { const f32x2 q = *(const LAS f32x2*)(lds + G_SQ + lane * 8); ssp[(size_t)(hd * 4 + cs) * T + t0 + 64 * n + lane] = q.x + q.y; }
        };
        auto chunk = [&](int n) {
            const int par = n & 1;
            LAS unsigned char* VT = lds + G_VT + par * 64 * GS64;
            if (wave < 7) {
#pragma unroll
                for (int i = 0; i < 8; ++i) *(LAS u32x4*)(lds + (tid + i * NLD) * 16) = pb[i];
#pragma unroll
                for (int i = 0; i < 3; ++i) { const int p = pvr[i]; const int q = p & 511;
                    if (p < 512) { const int row = q & 63, pc = q >> 6; const unsigned vw[4] = {pv[i].x, pv[i].y, pv[i].z, pv[i].w};
#pragma unroll
                        for (int j = 0; j < 4; ++j) { *(LAS unsigned short*)(VT + (8 * pc + 2 * j) * GS64 + 2 * row) = (unsigned short)(vw[j] & 0xffffu);
                                                      *(LAS unsigned short*)(VT + (8 * pc + 2 * j + 1) * GS64 + 2 * row) = (unsigned short)(vw[j] >> 16); } }
                    else *(LAS u32x4*)(lds + G_RT + (q >> 3) * 144 + (q & 7) * 16) = pv[i]; }
                prefetch(n + 1 < SEQ / 64 ? n + 1 : n);
            }
            GLA_BAR();
            if (wave == 7) flush(n > 0 ? n - 1 : 0);
            const u32x2 rc0 = *(const LAS u32x2*)(lds + G_RT + (it * 16 + r) * 144 + ((2 * half) * 16 + 4 * g) * 2), rc1 = *(const LAS u32x2*)(lds + G_RT + (it * 16 + r) * 144 + ((2 * half + 1) * 16 + 4 * g) * 2);
            f32x4 at0 = (f32x4){0.f, 0.f, 0.f, 0.f}, at1 = at0, o0 = at0, o1 = at0;
            const bool do0 = (2 * half) <= it, do1 = (2 * half + 1) <= it;
            const LAS unsigned char* STc = lds + G_ST + par * 64 * GS128;
            bf16x8 fq[2], fk0[2], fk1[2], fs0[2], fs1[2];
#define GLA_LDK(ks, bufi) do { const int kb = (32 * (ks) + 8 * g) * 2; fq[bufi] = ldfrag(lds + G_QD, GS128, it * 16 + r, kb); fk0[bufi] = ldfrag(lds + G_KI, GS128, (2 * half) * 16 + r, kb); \
                fk1[bufi] = ldfrag(lds + G_KI, GS128, (2 * half + 1) * 16 + r, kb); fs0[bufi] = ldfrag(STc, GS128, (2 * half) * 16 + r, kb); fs1[bufi] = ldfrag(STc, GS128, (2 * half + 1) * 16 + r, kb); } while (0)
            GLA_LDK(0, 0);
#pragma unroll
            for (int ks = 0; ks < 4; ++ks) {
                const int cb = ks & 1;
                if (ks < 3) GLA_LDK(ks + 1, cb ^ 1);
                o0 = __builtin_amdgcn_mfma_f32_16x16x32_bf16(fs0[cb], fq[cb], o0, 0, 0, 0);
                o1 = __builtin_amdgcn_mfma_f32_16x16x32_bf16(fs1[cb], fq[cb], o1, 0, 0, 0);
                if (do0) at0 = __builtin_amdgcn_mfma_f32_16x16x32_bf16(fk0[cb], fq[cb], at0, 0, 0, 0);
                if (do1) at1 = __builtin_amdgcn_mfma_f32_16x16x32_bf16(fk1[cb], fq[cb], at1, 0, 0, 0);
            }
#undef GLA_LDK
            f32x4 dec;
#pragma unroll
            for (int x = 0; x < 4; ++x) dec[x] = *(const LAS float*)(lds + G_KE + (wave * 16 + 4 * g + x) * GS64 + 128);
            const bf16x8 kf0 = ldfrag(lds + G_KE, GS64, wave * 16 + r, (8 * g) * 2), kf1 = ldfrag(lds + G_KE, GS64, wave * 16 + r, (32 + 8 * g) * 2);
            if (2 * half == it) {
#pragma unroll
                for (int x = 0; x < 4; ++x) if (4 * g + x > r) at0[x] = 0.f; }
            if (2 * half + 1 == it) {
#pragma unroll
                for (int x = 0; x < 4; ++x) if (4 * g + x > r) at1[x] = 0.f; }
            *(LAS u32x2*)(lds + G_AT + (it * 16 + r) * GS64 + ((2 * half) * 16 + 4 * g) * 2) = (u32x2){cvt_pk_bf16(at0[0], at0[1]), cvt_pk_bf16(at0[2], at0[3])};
            *(LAS u32x2*)(lds + G_AT + (it * 16 + r) * GS64 + ((2 * half + 1) * 16 + 4 * g) * 2) = (u32x2){cvt_pk_bf16(at1[0], at1[1]), cvt_pk_bf16(at1[2], at1[3])};
            f32x4 o[2]; o[0] = o0; o[1] = o1;
            {
#pragma unroll
                for (int cp2 = 0; cp2 < 2; ++cp2) {
                    bf16x8 vf[2][2]; f32x4 sv[2];
#pragma unroll
                    for (int c = 0; c < 2; ++c) { const int ct = 2 * cp2 + c; vf[c][0] = ldfrag(VT, GS64, ct * 16 + r, (8 * g) * 2); vf[c][1] = ldfrag(VT, GS64, ct * 16 + r, (32 + 8 * g) * 2); sv[c] = S[ct] * dec; }
#pragma unroll
                    for (int c = 0; c < 2; ++c) sv[c] = __builtin_amdgcn_mfma_f32_16x16x32_bf16(kf0, vf[c][0], sv[c], 0, 0, 0);
#pragma unroll
                    for (int c = 0; c < 2; ++c) sv[c] = __builtin_amdgcn_mfma_f32_16x16x32_bf16(kf1, vf[c][1], sv[c], 0, 0, 0);
#pragma unroll
                    for (int c = 0; c < 2; ++c) { const int ct = 2 * cp2 + c; S[ct] = sv[c];
                        *(LAS u32x2*)(lds + G_ST + (par ^ 1) * 64 * GS128 + (ct * 16 + r) * GS128 + (wave * 16 + 4 * g) * 2) = (u32x2){cvt_pk_bf16(sv[c][0], sv[c][1]), cvt_pk_bf16(sv[c][2], sv[c][3])}; }
                }
            }
            GLA_BAR();
            {
                const bf16x8 af0 = ldfrag(lds + G_AT, GS64, it * 16 + r, (8 * g) * 2), af1 = ldfrag(lds + G_AT, GS64, it * 16 + r, (32 + 8 * g) * 2);
                float ssq = 0.f;
                const size_t trow = t0 + 64 * n + it * 16 + r;
                bf16x8 wf[2][2];
#pragma unroll
                for (int cc = 0; cc < 2; ++cc) { wf[cc][0] = ldfrag(VT, GS64, (2 * half + cc) * 16 + r, (8 * g) * 2); if (it >= 2) wf[cc][1] = ldfrag(VT, GS64, (2 * half + cc) * 16 + r, (32 + 8 * g) * 2); }
#pragma unroll
                for (int cc = 0; cc < 2; ++cc) o[cc] = __builtin_amdgcn_mfma_f32_16x16x32_bf16(wf[cc][0], af0, o[cc], 0, 0, 0);
                if (it >= 2) {
#pragma unroll
                    for (int cc = 0; cc < 2; ++cc) o[cc] = __builtin_amdgcn_mfma_f32_16x16x32_bf16(wf[cc][1], af1, o[cc], 0, 0, 0); }
#pragma unroll
                for (int cc = 0; cc < 2; ++cc) {
                    const int ct = 2 * half + cc;
                    const f32x4 v = o[cc];
                    ssq += (v[0] * v[0] + v[1] * v[1]) + (v[2] * v[2] + v[3] * v[3]);
                    const int col = hd * 256 + cs * 64 + ct * 16 + 4 * g;
                    const u32x2 rw = cc ? rc1 : rc0;
                    *(LAS u32x2*)(lds + G_OT + (it * 16 + r) * 144 + (ct * 16 + 4 * g) * 2) = (u32x2){cvt_pk_bf16(v[0] * fsilu(bf_lo(rw.x)), v[1] * fsilu(bf_hi(rw.x))), cvt_pk_bf16(v[2] * fsilu(bf_lo(rw.y)), v[3] * fsilu(bf_hi(rw.y)))};
                }
                ssq += __shfl_xor(ssq, 16); ssq += __shfl_xor(ssq, 32);
                if (g == 0) *(LAS float*)(lds + G_SQ + ((it * 16 + r) * 2 + half) * 4) = ssq;
            }
        };
        if (wave < 7) prefetch(0);
        __syncthreads();
#pragma unroll 1
        for (int n = 0; n < SEQ / 64; ++n) chunk(n);
        __syncthreads();
        if (wave == 7) flush(SEQ / 64 - 1);
        __syncthreads();
    }
}
#undef GLA_BAR

__device__ __forceinline__ void e1_pass(const bf16_t* og, bf16_t* ogo, const float* __restrict__ ssp, int G) {
    const size_t n8 = (size_t)T * D / 8;
    int tid_ = threadIdx.x; asm volatile("" : "+v"(tid_));
    for (size_t i = (size_t)blockIdx.x * NTHREADS + tid_; i < n8; i += (size_t)G * NTHREADS) {
        const size_t t = i >> 7; const int hd = (int)((i & 127) >> 5);
        const float s = (ssp[(size_t)(hd * 4 + 0) * T + t] + ssp[(size_t)(hd * 4 + 1) * T + t]) + (ssp[(size_t)(hd * 4 + 2) * T + t] + ssp[(size_t)(hd * 4 + 3) * T + t]);
        const float rsh = 1.0f / sqrtf(s * (1.0f / 256.0f) + EPS);
        const u32x4 w = *(const u32x4*)(og + i * 8);
        u32x4 o; o.x = cvt_pk_bf16(bf_lo(w.x) * rsh, bf_hi(w.x) * rsh); o.y = cvt_pk_bf16(bf_lo(w.y) * rsh, bf_hi(w.y) * rsh); o.z = cvt_pk_bf16(bf_lo(w.z) * rsh, bf_hi(w.z) * rsh); o.w = cvt_pk_bf16(bf_lo(w.w) * rsh, bf_hi(w.w) * rsh);
        *(u32x4*)(ogo + i * 8) = o;
    }
}

constexpr int PG_STRIDE = 544;
constexpr int PG_OFF = 1024;
template <int J> struct PoolRaw { static constexpr int W = 2 << J, NTK = 4, NRW = W + NTK - 1; u32x2 raw[NRW]; };
template <int J>
__device__ __forceinline__ void pool_group_load(PoolRaw<J>& R, const bf16_t* __restrict__ h, int tw, int seq0, int lane) {
    constexpr int W = PoolRaw<J>::W, NRW = PoolRaw<J>::NRW;
#pragma unroll
    for (int i = 0; i < NRW; ++i) { const int t = tw - (W - 1) + i, tc = t < seq0 ? seq0 : t; R.raw[i] = *((const u32x2*)(h + (size_t)tc * D + 256 * J) + lane); }
}
template <int J>
__device__ __forceinline__ void pool_group_reduce(const PoolRaw<J>& R, LAS unsigned char* pg, const LAS float* rsl, int tw, int tl  , int seq0, int ri0, int lane) {
    constexpr int W = PoolRaw<J>::W, NTK = PoolRaw<J>::NTK, NRW = PoolRaw<J>::NRW;
    f32x4 xs[NRW];
#pragma unroll
    for (int i = 0; i < NRW; ++i) { const float sc = rsl[ri0 - (W - 1) + i]; xs[i] = (f32x4){bf_lo(R.raw[i].x) * sc, bf_hi(R.raw[i].x) * sc, bf_lo(R.raw[i].y) * sc, bf_hi(R.raw[i].y) * sc}; }
    f32x4 sum = xs[0];
#pragma unroll
    for (int i = 1; i < W; ++i) sum += xs[i];
#pragma unroll
    for (int tt = 0; tt < NTK; ++tt) {
        const int ts = tw + tt - seq0; const float inv = 1.0f / (float)(ts + 1 < W ? ts + 1 : W);
        const f32x4 p = sum * inv - xs[tt + W - 1];
        *(LAS u32x2*)(pg + (tl + tt) * PG_STRIDE + 8 * lane) = (u32x2){cvt_pk_bf16(p[0], p[1]), cvt_pk_bf16(p[2], p[3])};
        if (tt < NTK - 1) sum += xs[tt + W] - xs[tt];
    }
}
template <int J>
__device__ __forceinline__ void pool_fused_group(LAS unsigned char* lds, const bf16_t* __restrict__ hin, bf16_t* __restrict__ hout, const bf16_t* __restrict__ Wt  ,
                                                 const float* __restrict__ bias, const float* __restrict__ sc, int t0, int seq0, int wave, int lane) {
    const LAS float* rsl = (const LAS float*)lds; LAS unsigned char* pg = lds + PG_OFF;
    const int r = lane & 15, g = lane >> 4;
    {
        PoolRaw<J> ra, rb;
        pool_group_load<J>(ra, hin, t0 + 16 * wave, seq0, lane);
        __builtin_amdgcn_sched_barrier(0);
#pragma unroll
        for (int q4 = 0; q4 < 4; q4 += 2) {
            pool_group_load<J>(rb, hin, t0 + 16 * wave + 4 * (q4 + 1), seq0, lane); __builtin_amdgcn_sched_barrier(0);
            pool_group_reduce<J>(ra, pg, rsl, t0 + 16 * wave + 4 * q4, 16 * wave + 4 * q4, seq0, 16 + 16 * wave + 4 * q4, lane); asm volatile("" ::: "memory"); __builtin_amdgcn_sched_barrier(0);
            if (q4 + 2 < 4) { pool_group_load<J>(ra, hin, t0 + 16 * wave + 4 * (q4 + 2), seq0, lane); __builtin_amdgcn_sched_barrier(0); }
            pool_group_reduce<J>(rb, pg, rsl, t0 + 16 * wave + 4 * (q4 + 1), 16 * wave + 4 * (q4 + 1), seq0, 16 + 16 * wave + 4 * (q4 + 1), lane); asm volatile("" ::: "memory"); __builtin_amdgcn_sched_barrier(0);
        }
    }
    __syncthreads();
    f32x4 acc[8][2];
#pragma unroll
    for (int mt = 0; mt < 8; ++mt) { acc[mt][0] = (f32x4){0.f, 0.f, 0.f, 0.f}; acc[mt][1] = acc[mt][0]; }
    const bf16_t* wrow = Wt + (size_t)(32 * wave + r) * 256 + 8 * g;
    asm volatile("" : "+v"(wrow));
    bf16x8 wf[2][2];
    wf[0][0] = *(const bf16x8*)(wrow); wf[0][1] = *(const bf16x8*)(wrow + 16 * 256);
#pragma unroll
    for (int ks = 0; ks < 8; ++ks) {
        const int cb = ks & 1;
        if (ks < 7) { wf[cb ^ 1][0] = *(const bf16x8*)(wrow + 32 * (ks + 1)); wf[cb ^ 1][1] = *(const bf16x8*)(wrow + 16 * 256 + 32 * (ks + 1)); }
        bf16x8 af[8];
#pragma unroll
        for (int mt = 0; mt < 8; ++mt) af[mt] = *(const LAS bf16x8*)(pg + (16 * mt + r) * PG_STRIDE + (32 * ks + 8 * g) * 2);
#pragma unroll
        for (int mt = 0; mt < 8; ++mt) { acc[mt][0] = __builtin_amdgcn_mfma_f32_16x16x32_bf16(wf[cb][0], af[mt], acc[mt][0], 0, 0, 0); acc[mt][1] = __builtin_amdgcn_mfma_f32_16x16x32_bf16(wf[cb][1], af[mt], acc[mt][1], 0, 0, 0); }
        __builtin_amdgcn_sched_barrier(0);
    }
    f32x4 bv[2], sv[2];
    asm volatile("" : "+s"(bias), "+s"(sc));
#pragma unroll
    for (int nt = 0; nt < 2; ++nt) { bv[nt] = *(const f32x4*)(bias + 256 * J + 32 * wave + 16 * nt + 4 * g); sv[nt] = *(const f32x4*)(sc + 256 * J + 32 * wave + 16 * nt + 4 * g); }
    u32x2 hv[8][2];
#pragma unroll
    for (int mt = 0; mt < 8; ++mt)
#pragma unroll
        for (int nt = 0; nt < 2; ++nt) hv[mt][nt] = *(const u32x2*)(hin + (size_t)(t0 + 16 * mt + r) * D + 256 * J + 32 * wave + 16 * nt + 4 * g);
#pragma unroll
    for (int mt = 0; mt < 8; ++mt)
#pragma unroll
        for (int nt = 0; nt < 2; ++nt) { const f32x4 o = (acc[mt][nt] + bv[nt]) * sv[nt]; const u32x2 w = hv[mt][nt];
            *(u32x2*)(hout + (size_t)(t0 + 16 * mt + r) * D + 256 * J + 32 * wave + 16 * nt + 4 * g) = (u32x2){cvt_pk_bf16(bf_lo(w.x) + o[0], bf_hi(w.x) + o[1]), cvt_pk_bf16(bf_lo(w.y) + o[2], bf_hi(w.y) + o[3])}; }
    __syncthreads();
}
__device__ __forceinline__ void pool_fused(LAS unsigned char* lds, const bf16_t* __restrict__ hin, bf16_t* __restrict__ hout, const bf16_t* __restrict__ Wt  ,
                                           const float* __restrict__ bias, const float* __restrict__ sc, int G, int wave, int lane) {
    LAS float* rsl = (LAS float*)lds;
    for (int tile = ((G % 8 == 0) ? (int)(blockIdx.x % 8) * (G / 8) + (int)(blockIdx.x / 8) : (int)blockIdx.x); tile < T / 128; tile += G) {
        const int t0 = tile * 128, seq0 = (t0 / SEQ) * SEQ;
#pragma unroll
        for (int bt = 0; bt < 2; ++bt) {
            u32x4 v[9][2];
#pragma unroll
            for (int q = 0; q < 9; ++q) { const int t = t0 - 16 + wave + 8 * (9 * bt + q), tc = t < seq0 ? seq0 : t; const u32x4* x = (const u32x4*)(hin + (size_t)tc * D) + 2 * lane; v[q][0] = x[0]; v[q][1] = x[1]; }
#pragma unroll
            for (int q = 0; q < 9; ++q) { const int rr = wave + 8 * (9 * bt + q), t = t0 - 16 + rr; float sq = 0.f;
#pragma unroll
                for (int w = 0; w < 2; ++w) { f32x4 a, b; unpack8(v[q][w], a, b); sq += (a[0] * a[0] + a[1] * a[1]) + (a[2] * a[2] + a[3] * a[3]) + (b[0] * b[0] + b[1] * b[1]) + (b[2] * b[2] + b[3] * b[3]); }
                const float rsv = (t >= seq0) ? 1.0f / sqrtf(wave_sum(sq) * (1.0f / D) + EPS) : 0.f;
                if (lane == 0) rsl[rr] = rsv; }
            __builtin_amdgcn_sched_barrier(0);
        }
        __syncthreads();
        pool_fused_group<0>(lds, hin, hout, Wt, bias, sc, t0, seq0, wave, lane);
        pool_fused_group<1>(lds, hin, hout, Wt + 65536, bias, sc, t0, seq0, wave, lane);
        pool_fused_group<2>(lds, hin, hout, Wt + 2 * 65536, bias, sc, t0, seq0, wave, lane);
        pool_fused_group<3>(lds, hin, hout, Wt + 3 * 65536, bias, sc, t0, seq0, wave, lane);
    }
}

__device__ __forceinline__ void final_norm(const bf16_t* __restrict__ h, const float* __restrict__ gfin, float* __restrict__ out, int G, int wave, int lane) {
    f32x4 gv[4];
#pragma unroll
    for (int j = 0; j < 4; ++j) gv[j] = *((const f32x4*)gfin + 4 * lane + j);
    const int nw = G * NWAVES, w0 = blockIdx.x * NWAVES + wave;
    for (int rb = w0 * 4; rb < T; rb += nw * 4) {
        u32x4 x[4][2];
#pragma unroll
        for (int q = 0; q < 4; ++q) { const u32x4* p = (const u32x4*)(h + (size_t)(rb + q) * D) + 2 * lane; x[q][0] = p[0]; x[q][1] = p[1]; }
#pragma unroll
        for (int q = 0; q < 4; ++q) { f32x4 v[4]; float s = 0.f;
            unpack8(x[q][0], v[0], v[1]); unpack8(x[q][1], v[2], v[3]);
#pragma unroll
            for (int j = 0; j < 4; ++j) s += (v[j][0] * v[j][0] + v[j][1] * v[j][1]) + (v[j][2] * v[j][2] + v[j][3] * v[j][3]);
            const float rsv = 1.0f / sqrtf(wave_sum(s) * (1.0f / D) + EPS);
            f32x4* o = (f32x4*)(out + (size_t)(rb + q) * D) + 4 * lane;
#pragma unroll
            for (int j = 0; j < 4; ++j) o[j] = v[j] * rsv * gv[j]; }
    }
}

__device__ __forceinline__ int moe_ntiles(const unsigned* cnt) {
    const int lane = threadIdx.x & 63;
    int nt = ((int)cnt[lane] + 255) >> 8;
#pragma unroll
    for (int o = 32; o; o >>= 1) nt += __shfl_xor(nt, o);
    return __builtin_amdgcn_readfirstlane(nt);
}
template <bool UP>
__device__ __forceinline__ int moe_tables(LAS unsigned char* lds_all, const unsigned* cnt, const int* __restrict__ list, const float* __restrict__ rs, const float* __restrict__ wts, int G, int c) {
    LAS int* tpre = (LAS int*)(lds_all + TAB_OFF);
    int tid_ = threadIdx.x; asm volatile("" : "+v"(tid_));
    const int tid = tid_;
    if (tid < 64) {
        const int nt = ((int)cnt[tid] + 255) >> 8; int incl = nt;
#pragma unroll
        for (int o = 1; o < 64; o <<= 1) { const int v = __shfl_up(incl, o); if (tid >= o) incl += v; }
        tpre[tid] = incl - nt; if (tid == 63) tpre[NE] = incl;
    }
    __syncthreads();
    const int ntiles = tpre[NE];
    MoeSched<UP> S; S.G = G; S.c = c; S.ntiles = ntiles; S.tpre = tpre; S.A = nullptr; S.W = nullptr;
    Unit u;
    int av[MAXU]; bool vv[MAXU]; int nu = 0;
#pragma unroll
    for (int i = 0; i < MAXU; ++i) { av[i] = -1; vv[i] = false;
        if (S.next_search(i, u)) { nu = i + 1; if (tid == 0) tpre[80 + i] = u.aux;
            if (tid < 256) { const int e = u.aux, idx = (u.pm - tpre[e]) * 256 + tid; vv[i] = idx < (int)cnt[e]; if (vv[i]) av[i] = list[(size_t)e * CAP + idx]; } } }
#pragma unroll
    for (int i = 0; i < MAXU; ++i) if (i < nu && tid < 256) {
        const int a = av[i]; const bool valid = vv[i];
        if (UP) { ((LAS unsigned*)(lds_all + TABA_OFF))[i * 256 + tid] = valid ? (unsigned)(a >> 1) * (unsigned)(D * 2) : 0u; ((LAS float*)(lds_all + TABB_OFF))[i * 256 + tid] = valid ? rs[a >> 1] : 0.f; }
        else { ((LAS int*)(lds_all + TABA_OFF))[i * 256 + tid] = a; ((LAS float*)(lds_all + TABB_OFF))[i * 256 + tid] = valid ? wts[a] : 0.f; }
    }
    __syncthreads();
    return ntiles;
}
constexpr int CWX_CNT = 1024;
constexpr int CWX_BAR = 4096;
constexpr int SEQ_FINAL = 41;
#ifndef FK_PHMASK
#define FK_PHMASK 0x7fff
#endif
#define PH_ON(k) (((FK_PHMASK) >> (k)) & 1)
#ifndef FK_NOPRE
#define FK_NOPRE 0
#endif
#ifndef FK_DUP
#define FK_DUP (-1)
#endif
#define NREP(k) ((FK_DUP == (k)) ? 2 : 1)
#define DUMMY(k, rep) (FK_DUP == (k) && (rep) == 0)
constexpr size_t WS_DUM_F32 = 1270 * MiB, WS_DUM_B16 = 1398 * MiB, WS_DUM_RS = 1527 * MiB;
constexpr size_t WS_HB1 = 1462 * MiB;
constexpr size_t WS_GIMG = 1270 * MiB;

__global__ void __launch_bounds__(NTHREADS, 2) fwd(Ptrs P, int li) {
    extern __shared__ __attribute__((aligned(16))) unsigned char lds_raw[];
    LAS unsigned char* lds = (LAS unsigned char*)lds_raw;
    const int tid = threadIdx.x, lane_k = tid & 63, wave_k = __builtin_amdgcn_readfirstlane(tid >> 6);
    const int G_k = gridDim.x, bid_k = blockIdx.x;
    const int vcu_k = (G_k % 8 == 0) ? (bid_k % 8) * (G_k / 8) + bid_k / 8 : bid_k;
#define PHV int lane = lane_k, wave = wave_k, G = G_k, bid = bid_k, vcu = vcu_k; asm volatile("" : "+v"(lane), "+s"(wave), "+s"(G), "+s"(bid), "+s"(vcu)); (void)lane; (void)wave; (void)G; (void)bid; (void)vcu;
    volatile LAS unsigned* MISC = (volatile LAS unsigned*)(lds + MISC_OFF);
    if (tid < 16) MISC[tid] = 0u;
    __syncthreads();
    const int lo = P.ph_lo, hi = P.ph_hi;
    XcdBarrier bar; bar.bar = (unsigned*)(P.ws + WS_CTL) + CWX_BAR + li * XCD_BAR_WORDS; bar.x = 0; bar.st = MISC + 8;
    if (hi - lo > 1) bar = xcd_barrier_post((unsigned*)(P.ws + WS_CTL) + CWX_BAR + li * XCD_BAR_WORDS, MISC + 8);
#define IN(s) (lo <= (s) && (s) < hi)
#define BAR_AFTER(s) do { if (hi > (s) + 1) xcd_barrier(bar); } while (0)
#define KA (*kargs())
#define WSP(off) (KA.ws + (off))
#define WIN ((bf16_t*)WSP(WS_WIN))
#define WLR ((bf16_t*)WSP(WS_WLR))
#define WOUT ((bf16_t*)WSP(WS_WOUT))
#define WPOOL ((bf16_t*)WSP(WS_WPOOL))
#define WR ((bf16_t*)WSP(WS_WR))
#define WPG ((bf16_t*)WSP(WS_WPG))
#define WPP ((bf16_t*)WSP(WS_WPP))
#define WGU ((bf16_t*)WSP(WS_WGU))
#define WD ((bf16_t*)WSP(WS_WD))
#define PB ((bf16_t*)WSP(WS_PB))
#define HB ((bf16_t*)WSP(WS_HB))
#define PROJ ((bf16_t*)WSP(WS_PROJ))
#define OG ((bf16_t*)WSP(WS_OG))
#define PP ((bf16_t*)WSP(WS_PP))
#define H2 ((bf16_t*)WSP(WS_H2))
#define Y ((bf16_t*)WSP(WS_Y))
#define LIST ((int*)WSP(WS_LIST))
#define RS ((float*)WSP(WS_RS))
#define LR ((float*)WSP(WS_LR))
#define SSP ((float*)WSP(WS_SSP))
#define WTS ((float*)WSP(WS_WTS))
#define CNT ((unsigned*)WSP(WS_CTL) + CWX_CNT)

    if (PH_ON(0) && IN(0)) for (int rep = 0; rep < NREP(0); ++rep) { PHV prologue(KA, lds, vcu, G, wave, lane); BAR_AFTER(0); }

    if (FK_DUP == 17 && IN(0)) { for (int q = 0; q < 20; ++q) xcd_barrier(bar); }
    for (int L = 0; L < 4; ++L) {
        const int base = 1 + 10 * L, j = L >> 1;
#define HCUR ((bf16_t*)WSP((L & 1) ? WS_HB1 : WS_HB))
#define HNXT ((bf16_t*)WSP((L & 1) ? WS_HB : WS_HB1))
#define HMID ((bf16_t*)WSP((L & 1) ? WS_PROJ : WS_HB))
        if ((L & 1) == 0) {
            if (PH_ON(1) && IN(base + 0)) for (int rep = 0; rep < NREP(1); ++rep) { PHV
                if (L == 0) np_pass<0, true>(lds, KA.in[0], HCUR, RS, WLR + (size_t)j * 2 * 16 * D, LR, nullptr, nullptr, nullptr, nullptr, nullptr, nullptr, G, wave, lane);
                else np_pass<0, false>(lds, HCUR, nullptr, RS, WLR + (size_t)j * 2 * 16 * D, LR, nullptr, nullptr, nullptr, nullptr, nullptr, nullptr, G, wave, lane);
                BAR_AFTER(base + 0); }
            if (PH_ON(2) && IN(base + 1)) for (int rep = 0; rep < NREP(2); ++rep) { PHV DenseSched S; S.init(HCUR, D, WIN + (size_t)j * NPROJ * D, T, NPROJ, D, G, bid, 0); EpiBf16Rs E{PROJ, NPROJ, RS}; gemm_phase(lds, D, D, S, E); BAR_AFTER(base + 1); }
            if (PH_ON(3) && IN(base + 2)) for (int rep = 0; rep < NREP(3); ++rep) { PHV
                for (int r2 = 0; r2 < NREP(15) && !FK_NOPRE; ++r2) { gla_pre(lds, PROJ, LR, KA.in[7] + (size_t)j * 16 * 512, KA.in[8] + j * 512, WSP(WS_GIMG), vcu, G, wave, lane); xcd_barrier(bar); }
                if (FK_DUP == 16) { gla_scan<0>(lds, PROJ, WSP(WS_GIMG), (bf16_t*)WSP(WS_DUM_B16), (float*)WSP(WS_DUM_RS), vcu, G, wave, lane); xcd_barrier(bar); }
                gla_scan<0>(lds, PROJ, WSP(WS_GIMG), OG, SSP, vcu, G, wave, lane);
                BAR_AFTER(base + 2); }
            if (PH_ON(5) && IN(base + 4)) for (int rep = 0; rep < NREP(5); ++rep) { PHV DenseSched S; S.init(OG, D, WOUT + (size_t)j * D * D, T, D, D, G, bid, 0);
                HeadScaleHook H{SSP};
                if (L == 0) { EpiResid<true, true> E{KA.in[0], DUMMY(5, rep) ? (bf16_t*)WSP(WS_DUM_B16) : HCUR}; gemm_phase(lds, D, D, S, E, H); }
                else { EpiResid<false, true> E{HCUR, DUMMY(5, rep) ? (bf16_t*)WSP(WS_DUM_B16) : HCUR}; gemm_phase(lds, D, D, S, E, H); }
                BAR_AFTER(base + 4); }
        } else {
            if (PH_ON(6) && IN(base + 0)) for (int rep = 0; rep < NREP(6); ++rep) { PHV pool_fused(lds, HCUR, DUMMY(6, rep) ? (bf16_t*)WSP(WS_DUM_B16) : HMID, WPOOL + (size_t)j * D * 256, KA.in[12] + j * D, KA.in[13] + j * D, G, wave, lane); BAR_AFTER(base + 0); }
        }
        if (PH_ON(8) && IN(base + 5)) for (int rep = 0; rep < NREP(8); ++rep) { PHV if (!DUMMY(8, rep)) { convert_moe_layer<0>(KA, lds, L, vcu * NWAVES + wave, G * NWAVES, NE * 384, wave, lane); __syncthreads(); }
            np_pass<1, false>(lds, HMID, nullptr, DUMMY(8, rep) ? (float*)WSP(WS_DUM_RS) : RS, WR + (size_t)L * 2 * 80 * D, nullptr, nullptr, KA.in[15] + L * 8, KA.in[17] + L * 64, CNT + L * 64, LIST, WTS, G, wave, lane, !DUMMY(8, rep));
            BAR_AFTER(base + 5); }
        if (IN(base + 6)) {
            if (PH_ON(10)) for (int rep = 0; rep < NREP(10); ++rep) { PHV const int ntiles = moe_tables<true>(lds, CNT + L * 64, LIST, RS, WTS, G, vcu);
              MoeSched<true> S; S.A = HMID; S.W = WGU + (size_t)L * NE * 768 * D; S.G = G; S.c = vcu; S.ntiles = ntiles; S.tpre = (const LAS int*)(lds + TAB_OFF);
              if (DUMMY(10, rep)) { EpiNone E{H2}; gemm_phase(lds, D, D, S, E); xcd_barrier(bar); } else { EpiUp E{H2}; gemm_phase(lds, D, D, S, E); } }
            { PHV __syncthreads();
              constexpr int TOTAL = NE * 192, CVU = 96;
              const int ntl = moe_ntiles(CNT + L * 64), rem = (ntl * 3) % G, NA = G - rem;
              int xh = (TOTAL - NA * CVU) / G; if (xh < 0) xh = 0;
              const int xl = (TOTAL - rem * xh + NA - 1) / NA;
              int st, en; if (vcu < rem) { st = vcu * xh; en = st + xh; } else { st = rem * xh + (vcu - rem) * xl; en = st + xl; if (en > TOTAL) en = TOTAL; }
              convert_moe_layer<1>(KA, lds, L, st + wave, NWAVES, en, wave, lane); }
            BAR_AFTER(base + 6);
        }
        if (PH_ON(11) && IN(base + 7)) for (int rep = 0; rep < NREP(11); ++rep) { PHV
            const int ntiles = moe_tables<false>(lds, CNT + L * 64, LIST, RS, WTS, G, vcu);
            MoeSched<false> S; S.A = H2; S.W = WD + (size_t)L * NE * D * DFF; S.G = G; S.c = vcu; S.ntiles = ntiles; S.tpre = (const LAS int*)(lds + TAB_OFF);
            if (DUMMY(11, rep)) { EpiNone E{Y}; gemm_phase(lds, DFF, DFF, S, E); } else { EpiDown E{Y}; gemm_phase(lds, DFF, DFF, S, E); } }
        if (IN(base + 7)) {
            if (PH_ON(9)) for (int rep = 0; rep < NREP(9); ++rep) { PHV
              const int ntl = moe_ntiles(CNT + L * 64), NU = ntl * 4;
              FillSched S; S.A = PB + (size_t)L * T * PLE; S.Bt = WPP + (size_t)L * D * PLE; S.lda = PLE; S.K = PLE; S.nN = D / BM; S.nwg = (T / BM) * (D / BM); S.G = G; S.c = vcu; S.rem = NU % G; S.KL = 4;
              EpiBf16Rs E{PP, D, nullptr}; gemm_phase(lds, PLE, PLE, S, E); if (DUMMY(9, rep)) xcd_barrier(bar); }
            BAR_AFTER(base + 7);
        }
        if (PH_ON(12) && IN(base + 8)) for (int rep = 0; rep < NREP(12); ++rep) { PHV np_pass<2, false>(lds, nullptr, HMID, DUMMY(12, rep) ? (float*)WSP(WS_DUM_RS) : RS, nullptr, nullptr, Y, nullptr, nullptr, nullptr, nullptr, nullptr, G, wave, lane, true, DUMMY(12, rep) ? (bf16_t*)WSP(WS_DUM_B16) : nullptr); BAR_AFTER(base + 8); }
        if (PH_ON(13) && IN(base + 9)) for (int rep = 0; rep < NREP(13); ++rep) { PHV DenseSched S; S.init(HMID, D, WPG + (size_t)L * D * D, T, D, D, G, bid, 0); if (DUMMY(13, rep)) { EpiNone E{(bf16_t*)WSP(WS_DUM_B16)}; gemm_phase(lds, D, D, S, E); } else { EpiPle E{HMID, HNXT, RS, PP}; gemm_phase(lds, D, D, S, E); } BAR_AFTER(base + 9); }
    }
    if (PH_ON(14) && IN(SEQ_FINAL)) { PHV final_norm((const bf16_t*)WSP(WS_HB), KA.in[5], KA.out, G, wave, lane); }
#undef HCUR
#undef HNXT
#undef HMID
#undef IN
#undef BAR_AFTER
}
}


#ifndef FK_DIAG
#define FK_DIAG 0
#endif
#if FK_DIAG
__global__ void __launch_bounds__(256) k_cksum(const unsigned* __restrict__ p, size_t nwords4, unsigned long long* slot) {
    unsigned long long s = 0;
    for (size_t i = (size_t)blockIdx.x * 256 + threadIdx.x; i < nwords4; i += (size_t)gridDim.x * 256) { const uint4 v = ((const uint4*)p)[i]; s += (unsigned long long)v.x + v.y + v.z + v.w; }
    for (int o = 32; o; o >>= 1) s += __shfl_xor(s, o);
    if ((threadIdx.x & 63) == 0) atomicAdd(slot, s);
}
__global__ void __launch_bounds__(256) k_verdict(const unsigned long long* cs, int nph, float* out, size_t n) {
    __shared__ float code;
    if (threadIdx.x == 0) { int first = -1; for (int s = 0; s < nph; ++s) if (cs[s] != cs[64 + s] && first < 0) first = s; code = (first < 0) ? 100.0f : (float)(3 + first); }
    __syncthreads();
    for (size_t i = (size_t)blockIdx.x * 256 + threadIdx.x; i < n; i += (size_t)gridDim.x * 256) out[i] = code;
}
#endif
#ifndef FK_PER_PHASE
#define FK_PER_PHASE 0
#endif
extern "C" void kernel_launch(void* const* d_in, const int* in_sizes, int n_in, void* d_out, int out_size, void* d_ws, size_t ws_size, hipStream_t stream) {
    using namespace fk;
    static int grid = 0;
    if (grid == 0) {
        if (n_in != 23 || in_sizes[0] != T * D || out_size != T * D || ws_size < 1534 * MiB) { fprintf(stderr, "kernel_launch: unexpected shapes (n_in %d, out %d, ws %zu)\n", n_in, out_size, ws_size); grid = -1; return; }
        int dev = 0, cus = 0, per_cu = 0;
        if (hipGetDevice(&dev) != hipSuccess || hipDeviceGetAttribute(&cus, hipDeviceAttributeMultiprocessorCount, dev) != hipSuccess) { grid = -1; return; }
        if (hipFuncSetAttribute((const void*)fwd, hipFuncAttributeMaxDynamicSharedMemorySize, LDS_BYTES) != hipSuccess) { fprintf(stderr, "kernel_launch: hipFuncSetAttribute failed\n"); grid = -1; return; }
        if (hipOccupancyMaxActiveBlocksPerMultiprocessor(&per_cu, (const void*)fwd, NTHREADS, LDS_BYTES) != hipSuccess || per_cu < 1) fprintf(stderr, "kernel_launch: occupancy query says %d\n", per_cu);
        (void)hipGetLastError();
        grid = cus;
    }
    if (grid < 0) return;
    (void)hipMemsetAsync((char*)d_ws + WS_CTL, 0, CTL_ZERO_BYTES, stream);
    Ptrs P; memset(&P, 0, sizeof(P));
    for (int i = 0; i < 23; ++i) P.in[i] = (const float*)d_in[i];
    P.out = (float*)d_out; P.ws = (unsigned char*)d_ws;
#if FK_PER_PHASE
    int li = 0;
#if FK_DIAG
    unsigned long long* cs = (unsigned long long*)((char*)d_ws + WS_END);
    (void)hipMemsetAsync(cs, 0, 2 * 64 * 8, stream);
    for (int run = 0; run < 2; ++run) {
    if (run == 0) (void)hipMemsetAsync((char*)d_ws + 2 * MiB, 0xAA, WS_END - 2 * MiB, stream);
    (void)hipMemsetAsync((char*)d_ws + WS_CTL, 0, CTL_ZERO_BYTES, stream);
    int nph = 0;
#endif
    for (int s = 0; s <= SEQ_FINAL; ++s) {
        const int L = (s - 1) / 10, k = (s - 1) % 10;
        if (s >= 1 && s < SEQ_FINAL && (L & 1) == 1 && k >= 2 && k <= 4) continue;
        P.ph_lo = s; P.ph_hi = s + 1;
        hipLaunchKernelGGL(fwd, dim3(grid), dim3(NTHREADS), LDS_BYTES, stream, P, li);
#if FK_DIAG
        {
            struct Reg { size_t off, bytes; int is_out; };
            Reg regs[4]; int nr = 0;
            auto W = [&](size_t off, size_t bytes) { regs[nr++] = Reg{off, bytes, 0}; };
            auto O = [&]() { regs[nr++] = Reg{0, (size_t)T * D * 4, 1}; };
            if (s == 0) W(WS_WIN, WS_HB - WS_WIN);
            else if (s == SEQ_FINAL) O();
            else if ((L & 1) == 0 && k == 0) { W(WS_HB, 64 * MiB); W(WS_RS, MiB / 8); W(WS_LR, 2 * MiB); }
            else if ((L & 1) == 0 && k == 1) W(WS_PROJ, 192 * MiB);
            else if ((L & 1) == 0 && k == 2) { W(WS_OG, 64 * MiB); W(WS_SSP, 4 * MiB); }
            else if ((L & 1) == 0 && k == 3) W(WS_OG, 64 * MiB);
            else if ((L & 1) == 0 && k == 4) O();
            else if ((L & 1) == 1 && k == 0) W(WS_PROJ, 64 * MiB);
            else if ((L & 1) == 1 && k == 1) O();
            else if (k == 5) { W(WS_HB, 64 * MiB); W(WS_RS, MiB / 8); W(WS_WTS, MiB / 4); }
            else if (k == 6) W(WS_PP, 64 * MiB);
            else if (k == 7) W(WS_Y, 128 * MiB);
            else if (k == 8) { O(); W(WS_HB, 64 * MiB); W(WS_RS, MiB / 8); }
            else if (k == 9) O();
            for (int q = 0; q < nr; ++q)
                hipLaunchKernelGGL(k_cksum, dim3(2048), dim3(256), 0, stream, regs[q].is_out ? (const unsigned*)d_out : (const unsigned*)((char*)d_ws + regs[q].off), regs[q].bytes / 16, cs + run * 64 + nph);
        }
        ++nph;
#endif
    }
#if FK_DIAG
    if (run == 1) hipLaunchKernelGGL(k_verdict, dim3(1024), dim3(256), 0, stream, cs, nph, (float*)d_out, (size_t)T * D);
    }
#endif
#else
    P.ph_lo = 0; P.ph_hi = SEQ_FINAL + 1;
    hipLaunchKernelGGL(fwd, dim3(grid), dim3(NTHREADS), LDS_BYTES, stream, P, 0);
#endif
}
```
